# Optimizing an MI355X kernel written in HIP

```python
import jax, jax.numpy as jnp
from jax import lax
import numpy as np

D_MODEL = 1024
BATCH = 16
SEQ = 4096
DEPTH = 1

MLA_HEADS = 8
MLA_NOPE = 64
MLA_ROPE = 32
MLA_V = 64
Q_LORA = 256
KV_LORA = 128
ATTN_QBLOCK = 128
RET_HEADS = 4
RET_DK = 64
RET_DV = 128
RET_CHUNK = 128
ROPE_BASE = 10000.0
NORM_EPS = 1e-6
MIX_WIDTH = MLA_HEADS * MLA_V + RET_HEADS * RET_DV
IN_WIDTH = Q_LORA + KV_LORA + MLA_ROPE + 2 * RET_HEADS * RET_DK + 2 * RET_HEADS * RET_DV
N_GROUPS = 4
EXPERTS_PER_GROUP = 8
N_EXPERTS = N_GROUPS * EXPERTS_PER_GROUP
TOP_K = 2
D_EXPERT = 256
MOE_BLOCK = 256

kernel_name = "hybrid_mla_retention_hmoe_adaln"


def rmsnorm(x, g):
    xf = x.astype(jnp.float32)
    y = xf * lax.rsqrt(jnp.mean(xf * xf, axis=-1, keepdims=True) + NORM_EPS)
    return (y * g.astype(jnp.float32)).astype(x.dtype)


def rope(x, positions):
    half = x.shape[-1] // 2
    inv_freq = ROPE_BASE ** (-(jnp.arange(half, dtype=jnp.float32) / half))
    ang = positions.astype(jnp.float32)[..., None] * inv_freq
    cos = jnp.cos(ang)[:, :, None, :]
    sin = jnp.sin(ang)[:, :, None, :]
    x1 = x[..., :half].astype(jnp.float32)
    x2 = x[..., half:].astype(jnp.float32)
    return jnp.concatenate([x1 * cos - x2 * sin, x1 * sin + x2 * cos], axis=-1).astype(x.dtype)


def mla_causal_attention(q, k, v):
    B, S, H, dqk = q.shape
    nqb = S // ATTN_QBLOCK
    scale = dqk ** -0.5
    q_blocks = q.reshape(B, nqb, ATTN_QBLOCK, H, dqk).transpose(1, 0, 2, 3, 4)
    key_idx = jnp.arange(S)

    def block(args):
        qb, i = args
        s = jnp.einsum('bqhd,bkhd->bhqk', qb, k).astype(jnp.float32) * scale
        q_idx = i * ATTN_QBLOCK + jnp.arange(ATTN_QBLOCK)
        mask = key_idx[None, :] <= q_idx[:, None]
        s = jnp.where(mask[None, None], s, jnp.finfo(jnp.float32).min)
        p = jax.nn.softmax(s, axis=-1).astype(v.dtype)
        return jnp.einsum('bhqk,bkhe->bqhe', p, v)

    o = lax.map(block, (q_blocks, jnp.arange(nqb)))
    return o.transpose(1, 0, 2, 3, 4).reshape(B, S, H * v.shape[-1])


def chunkwise_retention(q, k, v):
    B, S, H, dk = q.shape
    dv = v.shape[-1]
    C = RET_CHUNK
    n = S // C
    gamma = 1.0 - jnp.power(2.0, -5.0 - jnp.arange(H, dtype=jnp.float32))
    log_g = jnp.log(gamma)
    idx = jnp.arange(C, dtype=jnp.float32)
    diff = idx[:, None] - idx[None, :]
    dmask = jnp.where(diff[None] >= 0, jnp.exp(jnp.maximum(diff, 0.0)[None] * log_g[:, None, None]), 0.0)
    zeta = jnp.exp((C - 1.0 - idx)[None, :] * log_g[:, None])
    xi = jnp.exp((idx + 1.0)[None, :] * log_g[:, None])
    chunk_decay = jnp.exp(C * log_g)

    qc = q.reshape(B, n, C, H, dk)
    kc = k.reshape(B, n, C, H, dk)
    vc = v.reshape(B, n, C, H, dv)
    s = jnp.einsum('bnqhd,bnkhd->bnhqk', qc, kc) * dmask[None, None]
    o_intra = jnp.einsum('bnhqk,bnkhe->bnqhe', s, vc)
    u = jnp.einsum('bnkhd,hk,bnkhe->nbhde', kc, zeta, vc)

    def step(state, u_n):
        return state * chunk_decay[None, :, None, None] + u_n, state

    _, prev_states = lax.scan(step, jnp.zeros((B, H, dk, dv), u.dtype), u)
    o_cross = jnp.einsum('bnqhd,hq,nbhde->bnqhe', qc, xi, prev_states)
    return (o_intra + o_cross).reshape(B, S, H, dv)


def head_groupnorm(o):
    of = o.astype(jnp.float32)
    mu = jnp.mean(of, axis=-1, keepdims=True)
    var = jnp.mean(jnp.square(of - mu), axis=-1, keepdims=True)
    return ((of - mu) * lax.rsqrt(var + NORM_EPS)).astype(o.dtype)


def hybrid_mixer(h, positions, w_in, q_norm_g, w_uq, kv_norm_g, w_ukv, w_o):
    B, S, _ = h.shape
    proj = h @ w_in
    sizes = [Q_LORA, KV_LORA, MLA_ROPE, RET_HEADS * RET_DK, RET_HEADS * RET_DK,
             RET_HEADS * RET_DV, RET_HEADS * RET_DV]
    splits = [int(s) for s in np.cumsum(sizes)[:-1]]
    c_q, c_kv, k_rope, r_q, r_k, r_v, r_g = jnp.split(proj, splits, axis=-1)

    q = (rmsnorm(c_q, q_norm_g) @ w_uq).reshape(B, S, MLA_HEADS, MLA_NOPE + MLA_ROPE)
    q = jnp.concatenate([q[..., :MLA_NOPE], rope(q[..., MLA_NOPE:], positions)], axis=-1)
    kv = (rmsnorm(c_kv, kv_norm_g) @ w_ukv).reshape(B, S, MLA_HEADS, MLA_NOPE + MLA_V)
    k_nope, v = kv[..., :MLA_NOPE], kv[..., MLA_NOPE:]
    k_pe = rope(k_rope[:, :, None, :], positions)
    k = jnp.concatenate([k_nope, jnp.broadcast_to(k_pe, (B, S, MLA_HEADS, MLA_ROPE))], axis=-1)
    o_mla = mla_causal_attention(q, k, v)

    rq = rope(r_q.reshape(B, S, RET_HEADS, RET_DK), positions)
    rk = rope(r_k.reshape(B, S, RET_HEADS, RET_DK), positions) * (RET_DK ** -0.5)
    rv = r_v.reshape(B, S, RET_HEADS, RET_DV)
    o_ret = head_groupnorm(chunkwise_retention(rq, rk, rv)).reshape(B, S, RET_HEADS * RET_DV)
    o_ret = jax.nn.silu(r_g) * o_ret

    return jnp.concatenate([o_mla, o_ret], axis=-1) @ w_o


def hierarchical_moe(h, w_gr, b_gr, w_er, b_er, w1, w3, w2):
    B, S, D = h.shape
    T = B * S
    xf = h.reshape(T, D)
    p_group = jax.nn.softmax((xf @ w_gr).astype(jnp.float32) + b_gr, axis=-1)
    p_top, g_top = lax.top_k(p_group, 1)
    le = jnp.einsum('td,dge->tge', xf, w_er).astype(jnp.float32) + b_er
    le_sel = jnp.take_along_axis(le, g_top[:, :, None], axis=1)[:, 0]
    e_val, e_idx = lax.top_k(le_sel, TOP_K)
    gate = jax.nn.softmax(e_val, axis=-1) * p_top

    expert_id = (g_top * EXPERTS_PER_GROUP + e_idx).reshape(-1).astype(jnp.int32)
    token_id = jnp.repeat(jnp.arange(T, dtype=jnp.int32), TOP_K)
    weight = gate.reshape(-1)
    A = T * TOP_K

    order = jnp.argsort(expert_id)
    e_sorted, t_sorted, w_sorted = expert_id[order], token_id[order], weight[order]
    counts = jnp.bincount(expert_id, length=N_EXPERTS)
    start = jnp.cumsum(counts) - counts
    padded = ((counts + MOE_BLOCK - 1) // MOE_BLOCK) * MOE_BLOCK
    pend = jnp.cumsum(padded)
    pstart = pend - padded
    dest = pstart[e_sorted] + (jnp.arange(A) - start[e_sorted])
    P = A + N_EXPERTS * MOE_BLOCK
    nb = P // MOE_BLOCK
    tok_buf = jnp.zeros((P,), jnp.int32).at[dest].set(t_sorted)
    w_buf = jnp.zeros((P,), jnp.float32).at[dest].set(w_sorted)
    blk_expert = jnp.minimum(jnp.searchsorted(pend, jnp.arange(nb) * MOE_BLOCK, side='right'), N_EXPERTS - 1)
    xin = xf[tok_buf].reshape(nb, MOE_BLOCK, D)

    def expert_ffn(args):
        xb, e = args
        return (jax.nn.silu(xb @ w1[e]) * (xb @ w3[e])) @ w2[e]

    y = lax.map(expert_ffn, (xin, blk_expert)).reshape(P, D)
    out = jnp.zeros((T, D), h.dtype).at[tok_buf].add((y * w_buf[:, None]).astype(h.dtype))
    return out.reshape(B, S, D)


def setup_inputs(seed: int = 0) -> dict:
    key = jax.random.key(seed)
    ks = jax.random.split(key, 24)
    D, L = D_MODEL, DEPTH
    nrm = lambda k, shape, fan: jax.random.normal(k, shape, jnp.float32) * (fan ** -0.5)
    offset = jax.random.randint(ks[2], (BATCH, 1), 0, 1024, dtype=jnp.int32)
    return {
        "x": jax.random.normal(ks[0], (BATCH, SEQ, D), jnp.float32),
        "c": jax.random.normal(ks[1], (BATCH, D), jnp.float32),
        "positions": offset + jnp.arange(SEQ, dtype=jnp.int32)[None, :],
        "w_ada": nrm(ks[3], (L, D, 6 * D), D) * 0.5,
        "b_ada": jax.random.normal(ks[4], (L, 6 * D), jnp.float32) * 0.01,
        "norm1_g": 1.0 + 0.02 * jax.random.normal(ks[5], (L, D), jnp.float32),
        "w_in": nrm(ks[6], (L, D, IN_WIDTH), D),
        "q_norm_g": 1.0 + 0.02 * jax.random.normal(ks[7], (L, Q_LORA), jnp.float32),
        "w_uq": nrm(ks[8], (L, Q_LORA, MLA_HEADS * (MLA_NOPE + MLA_ROPE)), Q_LORA),
        "kv_norm_g": 1.0 + 0.02 * jax.random.normal(ks[9], (L, KV_LORA), jnp.float32),
        "w_ukv": nrm(ks[10], (L, KV_LORA, MLA_HEADS * (MLA_NOPE + MLA_V)), KV_LORA),
        "w_o": nrm(ks[11], (L, MIX_WIDTH, D), MIX_WIDTH),
        "norm2_g": 1.0 + 0.02 * jax.random.normal(ks[12], (L, D), jnp.float32),
        "w_gr": nrm(ks[13], (L, D, N_GROUPS), D),
        "b_gr": jax.random.normal(ks[14], (L, N_GROUPS), jnp.float32) * 0.01,
        "w_er": nrm(ks[15], (L, D, N_GROUPS, EXPERTS_PER_GROUP), D),
        "b_er": jax.random.normal(ks[16], (L, N_GROUPS, EXPERTS_PER_GROUP), jnp.float32) * 0.01,
        "w1": nrm(ks[17], (L, N_EXPERTS, D, D_EXPERT), D),
        "w3": nrm(ks[18], (L, N_EXPERTS, D, D_EXPERT), D),
        "w2": nrm(ks[19], (L, N_EXPERTS, D_EXPERT, D), D_EXPERT),
        "final_g": 1.0 + 0.02 * jax.random.normal(ks[20], (D,), jnp.float32),
    }


def reference(x, c, positions, w_ada, b_ada, norm1_g, w_in, q_norm_g, w_uq, kv_norm_g, w_ukv, w_o,
              norm2_g, w_gr, b_gr, w_er, b_er, w1, w3, w2, final_g):
    for l in range(DEPTH):
        mod = jax.nn.silu(c) @ w_ada[l] + b_ada[l]
        sh1, sc1, g1, sh2, sc2, g2 = [m[:, None, :] for m in jnp.split(mod, 6, axis=-1)]
        h = rmsnorm(x, norm1_g[l]) * (1.0 + sc1) + sh1
        x = x + g1 * hybrid_mixer(h, positions, w_in[l], q_norm_g[l], w_uq[l], kv_norm_g[l], w_ukv[l], w_o[l])
        h = rmsnorm(x, norm2_g[l]) * (1.0 + sc2) + sh2
        x = x + g2 * hierarchical_moe(h, w_gr[l], b_gr[l], w_er[l], b_er[l], w1[l], w3[l], w2[l])
    return rmsnorm(x, final_g)
```

```cpp
#include <hip/hip_runtime.h>
#include <cstdio>
#include <cstdint>

#define GAS __attribute__((address_space(1)))
#define LAS __attribute__((address_space(3)))
typedef unsigned short bf16;
typedef unsigned v4u __attribute__((ext_vector_type(4)));
typedef unsigned v2u __attribute__((ext_vector_type(2)));
typedef float f32x2 __attribute__((ext_vector_type(2)));
typedef float f32x4 __attribute__((ext_vector_type(4)));
typedef float f32x16 __attribute__((ext_vector_type(16)));
typedef short bf16x8 __attribute__((ext_vector_type(8)));
typedef short s16x4 __attribute__((ext_vector_type(4)));
typedef GAS unsigned gu32;

constexpr int DM = 1024, NB = 16, SEQ = 4096, T = NB * SEQ;
constexpr int INW = 1952, INWP = 2048;
constexpr int C_CQ = 0, C_CKV = 256, C_KR = 384, C_RQ = 416, C_RK = 672, C_RV = 928, C_RG = 1440;
constexpr int QW = 768, KVW = 1024;
constexpr int NE = 32, DE = 256, CAP = 65536;
constexpr int MODW = 6 * DM;
constexpr float EPS = 1e-6f;
constexpr int NWAVES = 8, NTHR = 512;

constexpr size_t MiB = 1u << 20;
constexpr size_t WS_CTL = 0, CTL_ZERO_BYTES = 256 * 1024;
constexpr size_t WS_MOD = 1 * MiB;
constexpr size_t WS_WR = 1 * MiB + 512 * 1024;
constexpr size_t WS_WIN = 2 * MiB, WS_WUQ = 6 * MiB, WS_WUKV = 6 * MiB + 512 * 1024, WS_WO = 7 * MiB, WS_W13 = 9 * MiB, WS_W2 = 41 * MiB;
constexpr size_t WS_PQ = 70 * MiB;
constexpr size_t WS_PKV = 60 * MiB;
constexpr size_t WS_PART = 57 * MiB;
constexpr size_t WS_GATEW = 61 * MiB;
constexpr size_t WS_SLOT = 61 * MiB + 512 * 1024;
constexpr size_t WS_TOK = 62 * MiB;
constexpr size_t WS_A = 72 * MiB;
constexpr size_t WS_B = 328 * MiB;
constexpr size_t WS_C = 456 * MiB;
constexpr size_t WS_D = 584 * MiB;
constexpr size_t WS_END = 872 * MiB;
constexpr int CW_TMO = 0, CW_CODE = 1, CW_BAR = 4096, CW_CNT = 8192, CNT_STRIDE = 64, CW_CNT2 = 12288, CW_QUEUE = 16384;

constexpr int RING_BYTES = 149504;
constexpr int LDSCTL_OFF = 150528, MISC_OFF = LDSCTL_OFF;
constexpr int LDS_BYTES = 151552;

#define RLX_AGENT __ATOMIC_RELAXED, __HIP_MEMORY_SCOPE_AGENT
#define LDS_WAIT() asm volatile("s_waitcnt lgkmcnt(0)" ::: "memory")
#define VM_WAIT() asm volatile("s_waitcnt vmcnt(0)" ::: "memory")
#define WAIT_BAR0() asm volatile("s_waitcnt vmcnt(0) lgkmcnt(0)\n\ts_barrier" ::: "memory")
#define LGK_BAR() asm volatile("s_waitcnt lgkmcnt(0)\n\ts_barrier" ::: "memory")
__device__ __forceinline__ unsigned f2bf(float f) { unsigned u = __builtin_bit_cast(unsigned, f); return (u + 0x7fffu + ((u >> 16) & 1u)) >> 16; }
__device__ __forceinline__ unsigned pk2(float lo, float hi) { return f2bf(lo) | (f2bf(hi) << 16); }
typedef __bf16 bf16x2_t __attribute__((ext_vector_type(2)));
__device__ __forceinline__ unsigned cvtpk2(float lo, float hi) { f32x2 v = {lo, hi}; bf16x2_t b = __builtin_convertvector(v, bf16x2_t); return __builtin_bit_cast(unsigned, b); }
__device__ __forceinline__ float bf2f(unsigned b) { return __builtin_bit_cast(float, b << 16); }
__device__ __forceinline__ float bflo(unsigned w) { return __builtin_bit_cast(float, w << 16); }
__device__ __forceinline__ float bfhi(unsigned w) { return __builtin_bit_cast(float, w & 0xffff0000u); }
__device__ __forceinline__ float wave_sum(float v) {
#pragma unroll
    for (int o = 1; o < 64; o <<= 1) v += __shfl_xor(v, o);
    return v;
}
__device__ __forceinline__ float silu_f(float v) { return v / (1.0f + __expf(-v)); }

#define XB_TMO      128
#define XB_XCNT(j)  (256  + 64 * (j))
#define XB_XSUB(j)  (1280 + 64 * (j))
#define XB_XGEN(j)  (2304 + 64 * (j))
#define XB_TOP      3328
#define XB_TOPGEN   3392
#define XCD_BAR_WORDS 3456
#define XB_SPIN_CAP (1u << 22)
__device__ __forceinline__ unsigned xb_ld(unsigned* p)              { return __hip_atomic_load(p, __ATOMIC_RELAXED, __HIP_MEMORY_SCOPE_AGENT); }
__device__ __forceinline__ unsigned xb_add(unsigned* p, unsigned v) { return __hip_atomic_fetch_add(p, v, __ATOMIC_RELAXED, __HIP_MEMORY_SCOPE_AGENT); }
__device__ __forceinline__ unsigned xb_xcc_id() { return (unsigned)__builtin_amdgcn_s_getreg((3 << 11) | 20) & 0xFu; }
#define XB_SPIN(cond, bar) do { unsigned _sp = 0; while (cond) { __builtin_amdgcn_s_sleep(1); \
    if ((++_sp & 255u) == 0u) { if (xb_ld(&(bar)[XB_TMO])) break; if (_sp > XB_SPIN_CAP) { atomicAdd(&(bar)[XB_TMO], 1u); break; } } } } while (0)
struct XcdBarrier { unsigned* bar; unsigned x; volatile LAS unsigned* st; };
__device__ __forceinline__ XcdBarrier xcd_barrier_post(unsigned* bar, volatile LAS unsigned* st) {
    XcdBarrier b; b.bar = bar; b.x = xb_xcc_id(); b.st = st;
    if (threadIdx.x == 0) (void)xb_add(&bar[XB_XCNT(b.x)], 1u);
    return b;
}
__device__ __forceinline__ void xcd_barrier_complete(unsigned* bar, unsigned x, unsigned& nloc, unsigned& nx) {
    const unsigned G = gridDim.x * gridDim.y * gridDim.z;
    unsigned sum, cnt, mine, sp = 0u;
    for (;;) {
        sum = 0u; cnt = 0u; mine = 0u;
#pragma unroll
        for (unsigned j = 0; j < 16; ++j) { const unsigned c = xb_ld(&bar[XB_XCNT(j)]); sum += c; cnt += (c > 0u) ? 1u : 0u; mine = (j == x) ? c : mine; }
        if (sum == G) break;
        __builtin_amdgcn_s_sleep(1);
        if ((++sp & 255u) == 0u) { if (xb_ld(&bar[XB_TMO])) break; if (sp > XB_SPIN_CAP) { atomicAdd(&bar[XB_TMO], 1u); break; } }
    }
    nloc = mine > 0u ? mine : 1u; nx = cnt > 0u ? cnt : 1u;
}
__device__ __forceinline__ void xcd_barrier(const XcdBarrier& b) {
    asm volatile("s_waitcnt vmcnt(0)" ::: "memory");
    __syncthreads();
    if (threadIdx.x == 0) {
        unsigned* bar = b.bar;
        __builtin_amdgcn_s_waitcnt(0);
        unsigned nloc = b.st[0], nx = b.st[1];
        if (nloc == 0u) { xcd_barrier_complete(bar, b.x, nloc, nx); b.st[0] = nloc; b.st[1] = nx; }
        const unsigned old = xb_add(&bar[XB_XSUB(b.x)], 1u);
        const unsigned gen = old / nloc;
        if (old + 1u == (gen + 1u) * nloc) {
            __builtin_amdgcn_fence(__ATOMIC_RELEASE, "agent");
            asm volatile("s_waitcnt vmcnt(0)" ::: "memory");
            const unsigned og = xb_add(&bar[XB_TOP], 1u);
            const unsigned tg = og / nx;
            if (og + 1u == (tg + 1u) * nx) xb_add(&bar[XB_TOPGEN], 1u);
            else XB_SPIN(xb_ld(&bar[XB_TOPGEN]) == tg, bar);
            __builtin_amdgcn_fence(__ATOMIC_ACQUIRE, "agent");
            xb_add(&bar[XB_XGEN(b.x)], 1u);
            asm volatile("s_waitcnt vmcnt(0)" ::: "memory");
        } else {
            XB_SPIN(xb_ld(&bar[XB_XGEN(b.x)]) == gen, bar);
            __builtin_amdgcn_fence(__ATOMIC_ACQUIRE, "agent");
            asm volatile("s_waitcnt vmcnt(0)" ::: "memory");
        }
    }
    __syncthreads();
}
namespace pg8 {
constexpr int BM = 256, BK = 64, HALF = 128, HTB = HALF * BK * 2, STAGE_BYTES = 8 * HTB, NXCD = 8, WGM = 8;
__host__ __device__ __forceinline__ int lds_byte(int r, int c) { const int st = (r >> 4) * 2 + (c >> 5), rr = r & 15, cc = c & 31, ob = rr * 64 + cc * 2; return st * 1024 + (ob ^ (((ob >> 9) & 1) << 5)); }
__host__ __device__ __forceinline__ void stage_rc(int b, int& R, int& C) { const int st = b / 1024, sb = b % 1024, swz = sb ^ (((sb >> 9) & 1) << 5); R = (st >> 1) * 16 + swz / 64; C = (st & 1) * 32 + (swz % 64) / 2; }
__host__ __device__ __forceinline__ int perm32(int rho) { const int n = rho >> 4, i = rho & 15; return 8 * (i >> 2) + 4 * n + (i & 3); }

struct Unit { int pm, pn, e, rb, nv, pnl; };
struct Gemm { const bf16* A; const bf16* Bt; int lda, K; };

struct StaticOrder {
    int nM, nN, nwg, G, c;
    __device__ void init(int M, int N, int G_, int c_) { nM = M / BM; nN = N / BM; nwg = nM * nN; G = G_; c = c_; }
    __device__ bool next(int i, Unit& u) const {
        const long L = (long)i * G + c; if (L >= nwg) return false;
        int wgid = (int)L; { const int q = nwg / NXCD, r = nwg % NXCD, xcd = wgid % NXCD, off = wgid / NXCD; wgid = (xcd < r ? xcd * (q + 1) : r * (q + 1) + (xcd - r) * q) + off; }
        const int nig = WGM * nN, gid = wgid / nig, fm = gid * WGM, gsz = (nM - fm) < WGM ? (nM - fm) : WGM;
        u.pm = fm + ((wgid % nig) % gsz); u.pn = (wgid % nig) / gsz; u.e = 0; u.rb = 0; u.nv = 256; u.pnl = u.pn; return true;
    }
    __device__ __forceinline__ unsigned arow(const Unit& u, int r) const { return (unsigned)(u.pm * BM + r); }
};
struct MoeOrder {
    int G, c, ncol; const LAS int* pre; const int* cnt; const int* tok;
    __device__ bool next(int i, Unit& u) const {
        const int L = i * G + c, gb = L / ncol, pl = L % ncol;
        if (gb >= pre[NE]) return false;
        const int lj = threadIdx.x & 31;
        const unsigned long long bm = __ballot(pre[lj] <= gb) & 0xffffffffull;
        const int e = 31 - __builtin_clz((unsigned)bm);
        u.pm = gb; u.e = e; u.rb = gb - pre[e]; u.pnl = pl; u.pn = e * ncol + pl;
        const int left = cnt[e * CNT_STRIDE] - u.rb * 256; u.nv = left < 256 ? left : 256; return true;
    }
    __device__ __forceinline__ unsigned arow(const Unit& u, int r) const {
        if (tok) return (r < u.nv) ? (unsigned)(tok[(size_t)u.e * CAP + u.rb * 256 + r] >> 1) : 0u;
        return (unsigned)(u.pm * BM + r);
    }
};

__device__ __forceinline__ unsigned cvt_pk_bf16(float lo, float hi) { return cvtpk2(lo, hi); }

struct EpiBf16 {
    static constexpr bool PERM = true;
    bf16* O; int ldc;
    __device__ __forceinline__ void operator()(const f32x4 (&acc)[2][2][4][2], const Unit& u, int wr, int wc, int fr, int fq) const {
        const int row0 = u.pm * BM + wr * 64 + fr; const int col0 = u.pnl * BM + wc * 32 + 8 * fq;
#pragma unroll
        for (int ai = 0; ai < 2; ++ai)
#pragma unroll
            for (int m = 0; m < 4; ++m) { bf16* rowp = O + (size_t)(row0 + ai * HALF + m * 16) * ldc + col0;
#pragma unroll
                for (int bj = 0; bj < 2; ++bj) { const f32x4 v0 = acc[ai][bj][m][0], v1 = acc[ai][bj][m][1];
                    v4u w; w.x = cvt_pk_bf16(v0[0], v0[1]); w.y = cvt_pk_bf16(v0[2], v0[3]); w.z = cvt_pk_bf16(v1[0], v1[1]); w.w = cvt_pk_bf16(v1[2], v1[3]);
                    *(v4u*)(rowp + bj * HALF) = w; } }
    }
};
struct EpiProj {
    static constexpr bool PERM = true;
    bf16* O; const int* positions; float* pq; float* pkv;
    __device__ __forceinline__ void operator()(const f32x4 (&acc)[2][2][4][2], const Unit& u, int wr, int wc, int fr, int fq) const {
        const int row0 = u.pm * BM + wr * 64 + fr;
        const float L2B = 13.287712379549449f, I2PI = 0.15915494309189535f;
        float posr[2][4];
#pragma unroll
        for (int ai = 0; ai < 2; ++ai)
#pragma unroll
            for (int m = 0; m < 4; ++m) posr[ai][m] = (u.pnl >= 1 && u.pnl <= 3) ? (float)positions[row0 + ai * HALF + m * 16] : 0.f;
#pragma unroll
        for (int bj = 0; bj < 2; ++bj) {
            const int seg = u.pnl * BM + bj * HALF + wc * 32;
            const int kind = seg < 256 ? 0 : seg < 384 ? 1 : seg < 416 ? 2 : seg < 672 ? 3 : seg < 928 ? 4 : 5;
            float cf[4]; float lgh = 0.f;
            if (kind == 2) {
#pragma unroll
                for (int i = 0; i < 4; ++i) cf[i] = exp2f(-(float)(4 * fq + i) * (1.f / 16.f) * L2B) * I2PI;
            } else if (kind == 3 || kind == 4) { const int base = kind == 3 ? 416 : 672, hh = (seg - base) >> 6, off = ((seg - base) & 63) + 8 * fq;
                lgh = log2f(1.0f - exp2f(-5.0f - (float)hh));
#pragma unroll
                for (int i = 0; i < 4; ++i) cf[i] = exp2f(-(float)(off / 2 + i) * (1.f / 32.f) * L2B) * I2PI;
            } else {
#pragma unroll
                for (int i = 0; i < 4; ++i) cf[i] = 0.f; }
#pragma unroll
            for (int ai = 0; ai < 2; ++ai)
#pragma unroll
                for (int m = 0; m < 4; ++m) { const int row = row0 + ai * HALF + m * 16;
                    float v[8];
#pragma unroll
                    for (int i = 0; i < 4; ++i) { v[i] = acc[ai][bj][m][0][i]; v[4 + i] = acc[ai][bj][m][1][i]; }
                    if (kind <= 1) { float ss = 0.f;
#pragma unroll
                        for (int i = 0; i < 8; ++i) ss += v[i] * v[i];
                        ss += __shfl_xor(ss, 16); ss += __shfl_xor(ss, 32);
                        if (fq == 0) { if (kind == 0) pq[(size_t)row * 8 + bj * 4 + wc] = ss; else pkv[(size_t)row * 4 + wc] = ss; }
                    } else if (kind <= 4) { const float pos = posr[ai][m]; float scl = 1.0f;
                        if (kind >= 3) { const float lg = lgh * (float)((row & 127) + 1); scl = kind == 3 ? exp2f(lg) : 0.125f * exp2f(-lg); }
#pragma unroll
                        for (int i = 0; i < 4; ++i) { float t = pos * cf[i]; t -= floorf(t); const float sn = __builtin_amdgcn_sinf(t), cs = __builtin_amdgcn_cosf(t);
                            const float x1 = v[2 * i], x2 = v[2 * i + 1]; v[2 * i] = (x1 * cs - x2 * sn) * scl; v[2 * i + 1] = (x1 * sn + x2 * cs) * scl; } }
                    v4u w; w.x = cvt_pk_bf16(v[0], v[1]); w.y = cvt_pk_bf16(v[2], v[3]); w.z = cvt_pk_bf16(v[4], v[5]); w.w = cvt_pk_bf16(v[6], v[7]);
                    *(v4u*)(O + (size_t)row * INWP + seg + 8 * fq) = w; }
        }
    }
};
template <int NP, int NC> struct EpiScaled {
    static constexpr bool PERM = true;
    bf16* O; int ldc; const float* part;
    __device__ __forceinline__ void operator()(const f32x4 (&acc)[2][2][4][2], const Unit& u, int wr, int wc, int fr, int fq) const {
        const int row0 = u.pm * BM + wr * 64 + fr; const int col0 = u.pnl * BM + wc * 32 + 8 * fq;
#pragma unroll
        for (int ai = 0; ai < 2; ++ai)
#pragma unroll
            for (int m = 0; m < 4; ++m) { const int row = row0 + ai * HALF + m * 16; float ss = 0.f;
#pragma unroll
                for (int p = 0; p < NP; p += 4) { const f32x4 pv = *(const f32x4*)(part + (size_t)row * NP + p); ss += (pv.x + pv.y) + (pv.z + pv.w); }
                const float rstd = 1.0f / sqrtf(ss * (1.f / NC) + EPS);
                bf16* rowp = O + (size_t)row * ldc + col0;
#pragma unroll
                for (int bj = 0; bj < 2; ++bj) { const f32x4 v0 = acc[ai][bj][m][0] * rstd, v1 = acc[ai][bj][m][1] * rstd;
                    v4u w; w.x = cvt_pk_bf16(v0[0], v0[1]); w.y = cvt_pk_bf16(v0[2], v0[3]); w.z = cvt_pk_bf16(v1[0], v1[1]); w.w = cvt_pk_bf16(v1[2], v1[3]);
                    *(v4u*)(rowp + bj * HALF) = w; } }
    }
};
struct EpiResid {
    static constexpr bool PERM = true;
    const float* x; const float* mod; float* x1; float* part;
    __device__ __forceinline__ void operator()(const f32x4 (&acc)[2][2][4][2], const Unit& u, int wr, int wc, int fr, int fq) const {
        const int row0 = u.pm * BM + wr * 64 + fr; const int col0 = u.pnl * BM + wc * 32 + 8 * fq;
        const int b = (u.pm * BM) / SEQ;
        const float* g1 = mod + (size_t)b * MODW + 2 * DM;
        f32x4 gv[2][2];
#pragma unroll
        for (int bj = 0; bj < 2; ++bj)
#pragma unroll
            for (int n = 0; n < 2; ++n) gv[bj][n] = *(const f32x4*)(g1 + col0 + bj * HALF + 4 * n);
#pragma unroll
        for (int ai = 0; ai < 2; ++ai)
#pragma unroll
            for (int m = 0; m < 4; ++m) { const int row = row0 + ai * HALF + m * 16; const size_t off = (size_t)row * DM + col0; float ss = 0.f;
#pragma unroll
                for (int bj = 0; bj < 2; ++bj)
#pragma unroll
                    for (int n = 0; n < 2; ++n) { const f32x4 xv = *(const f32x4*)(x + off + bj * HALF + 4 * n); const f32x4 o = xv + gv[bj][n] * acc[ai][bj][m][n];
                        *(f32x4*)(x1 + off + bj * HALF + 4 * n) = o; ss += (o[0] * o[0] + o[1] * o[1]) + (o[2] * o[2] + o[3] * o[3]); }
                ss += __shfl_xor(ss, 16); ss += __shfl_xor(ss, 32);
                if (fq == 0) part[(size_t)row * 16 + u.pnl * 4 + wc] = ss; }
    }
};
struct EpiSwiGLU {
    static constexpr bool PERM = true;
    bf16* H;
    __device__ __forceinline__ void operator()(const f32x4 (&acc)[2][2][4][2], const Unit& u, int wr, int wc, int fr, int fq) const {
        const int row0 = u.pm * BM + wr * 64 + fr; const int col0 = u.pnl * 128 + wc * 16 + 4 * fq;
#pragma unroll
        for (int ai = 0; ai < 2; ++ai)
#pragma unroll
            for (int m = 0; m < 4; ++m) { bf16* rowp = H + (size_t)(row0 + ai * HALF + m * 16) * DE + col0;
#pragma unroll
                for (int bj = 0; bj < 2; ++bj) { const f32x4 g = acc[ai][bj][m][0], v = acc[ai][bj][m][1];
                    v2u w; w.x = cvt_pk_bf16(silu_f(g[0]) * v[0], silu_f(g[1]) * v[1]); w.y = cvt_pk_bf16(silu_f(g[2]) * v[2], silu_f(g[3]) * v[3]);
                    *(v2u*)(rowp + bj * 64) = w; } }
    }
};
struct EpiDown {
    static constexpr bool PERM = true;
    bf16* Y; const int* tok; const float* gatew;
    __device__ __forceinline__ void operator()(const f32x4 (&acc)[2][2][4][2], const Unit& u, int wr, int wc, int fr, int fq) const {
        const int col0 = u.pnl * BM + wc * 32 + 8 * fq;
#pragma unroll
        for (int ai = 0; ai < 2; ++ai)
#pragma unroll
            for (int m = 0; m < 4; ++m) { const int rl = ai * HALF + wr * 64 + m * 16 + fr;
                if (rl < u.nv) { const int entry = tok[(size_t)u.e * CAP + u.rb * 256 + rl]; const float w = gatew[entry]; bf16* rowp = Y + (size_t)entry * DM + col0;
#pragma unroll
                    for (int bj = 0; bj < 2; ++bj) { const f32x4 v0 = acc[ai][bj][m][0] * w, v1 = acc[ai][bj][m][1] * w;
                        v4u o; o.x = cvt_pk_bf16(v0[0], v0[1]); o.y = cvt_pk_bf16(v0[2], v0[3]); o.z = cvt_pk_bf16(v1[0], v1[1]); o.w = cvt_pk_bf16(v1[2], v1[3]);
                        *(v4u*)(rowp + bj * HALF) = o; } }
                asm volatile("" ::: "memory"); }
    }
};

template <class Epi, class Sched, bool ALIGN_EPI, bool GATHER = false>
__device__ __forceinline__ void gemm_phase(LAS unsigned char* lds, const Gemm g, const Sched& S, const Epi& E) {
    const int tid = threadIdx.x, wid = __builtin_amdgcn_readfirstlane(tid >> 6), lane = tid & 63, wr = wid >> 2, wc = wid & 3, fr = lane & 15, fq = lane >> 4;
    int K = g.K; asm volatile("" : "+s"(K));
    const int nt = K / BK;
    unsigned voffB[2], voffA[2]; int RA[2]; unsigned CA[2];
#pragma unroll
    for (int i = 0; i < 2; ++i) { int R, C; stage_rc(tid * 16 + i * 8192, R, C); const int Rb = Epi::PERM ? ((R & ~31) + perm32(R & 31)) : R;
        RA[i] = R; CA[i] = (unsigned)C * 2u; voffA[i] = (unsigned)(R * g.lda + C) * 2u; voffB[i] = (unsigned)(Rb * K + C) * 2u; }
    const unsigned kstep = (unsigned)(BK * 2);
    const size_t hstepB = (size_t)HALF * K * 2, tstepB = 2 * hstepB;
    const unsigned pitchA = (unsigned)g.lda * 2u; const size_t hstepA = (size_t)HALF * g.lda * 2, tstepA = 2 * hstepA;
    const unsigned ldsw = (unsigned)wid * 1024u;
    const int aoff = lds_byte(wr * 64 + fr, fq * 8), boff = lds_byte(wc * 32 + fr, fq * 8);
#define PG8_SA(b, h) (((b) * 2 + (h)) * HTB)
#define PG8_SB(b, h) ((4 + (b) * 2 + (h)) * HTB)
#define PG8_STAGE(bufoff, gbase, voff) do { _Pragma("unroll") for (int _i = 0; _i < 2; ++_i) \
        __builtin_amdgcn_global_load_lds((const unsigned*)((const char*)(gbase) + (voff)[_i]), (LAS unsigned*)(lds + (bufoff) + ldsw + _i * 8192), 16, 0, 0); } while (0)
#define PG8_STAGEA(bufoff, up, offs, h, kb) do { _Pragma("unroll") for (int _i = 0; _i < 2; ++_i) { \
        const char* _p = GATHER ? ((const char*)g.A + (size_t)(offs)[h][_i] + (kb)) : ((up) + (size_t)(h) * hstepA + voffA[_i] + (kb)); \
        __builtin_amdgcn_global_load_lds((const unsigned*)_p, (LAS unsigned*)(lds + (bufoff) + ldsw + _i * 8192), 16, 0, 0); } } while (0)
#define PG8_LDA(dst, b, h) do { _Pragma("unroll") for (int m = 0; m < 4; ++m) _Pragma("unroll") for (int k = 0; k < 2; ++k) dst[m][k] = *(const LAS bf16x8*)(lds + PG8_SA(b, h) + aoff + m * 2048 + k * 1024); } while (0)
#define PG8_LDB(dst, b, h) do { _Pragma("unroll") for (int n = 0; n < 2; ++n) _Pragma("unroll") for (int k = 0; k < 2; ++k) dst[n][k] = *(const LAS bf16x8*)(lds + PG8_SB(b, h) + boff + n * 2048 + k * 1024); } while (0)
#define PG8_MMA(ai, bj, At, Bt) do { __builtin_amdgcn_s_setprio(1); _Pragma("unroll") for (int m = 0; m < 4; ++m) _Pragma("unroll") for (int n = 0; n < 2; ++n) _Pragma("unroll") for (int k = 0; k < 2; ++k) \
        acc[ai][bj][m][n] = __builtin_amdgcn_mfma_f32_16x16x32_bf16(Bt[n][k], At[m][k], acc[ai][bj][m][n], 0, 0, 0); __builtin_amdgcn_s_setprio(0); } while (0)
#define PG8_WAIT_V(n) asm volatile("s_waitcnt vmcnt(" #n ")" ::: "memory")
#define PG8_WAIT_L(n) asm volatile("s_waitcnt lgkmcnt(" #n ")" ::: "memory")
#define PG8_BAR __builtin_amdgcn_s_barrier()
#define PG8_SCHED __builtin_amdgcn_sched_barrier(0)
#define PG8_AOFFS(dst, un) do { if constexpr (GATHER) _Pragma("unroll") for (int _h = 0; _h < 2; ++_h) _Pragma("unroll") for (int _i = 0; _i < 2; ++_i) dst[_h][_i] = S.arow(un, _h * HALF + RA[_i]) * pitchA + CA[_i]; } while (0)
    Unit cur, nxt; int ui = 0;
    if (!S.next(0, cur)) return;
    f32x4 acc[2][2][4][2];
#pragma unroll
    for (int a = 0; a < 2; ++a)
#pragma unroll
        for (int b = 0; b < 2; ++b)
#pragma unroll
            for (int m = 0; m < 4; ++m)
#pragma unroll
                for (int n = 0; n < 2; ++n) acc[a][b][m][n] = (f32x4){0.f, 0.f, 0.f, 0.f};
    bf16x8 At[4][2], B0[2][2], B1[2][2];
    unsigned oC[2][2], oN[2][2];
    PG8_AOFFS(oC, cur);
    const char* cA = (const char*)g.A + (size_t)cur.pm * tstepA;
    const char* cB = (const char*)g.Bt + (size_t)cur.pn * tstepB;
    PG8_STAGE(PG8_SB(0, 0), cB, voffB); PG8_STAGE(PG8_SB(0, 1), cB + hstepB, voffB); PG8_STAGEA(PG8_SA(0, 0), cA, oC, 0, 0u); PG8_STAGEA(PG8_SA(0, 1), cA, oC, 1, 0u);
    if (wr == 1) PG8_BAR;
    PG8_WAIT_V(2); PG8_BAR;
    PG8_STAGE(PG8_SB(1, 0), cB + kstep, voffB); PG8_STAGEA(PG8_SA(1, 0), cA, oC, 0, kstep); PG8_STAGE(PG8_SB(1, 1), cB + hstepB + kstep, voffB);
    PG8_WAIT_V(6); PG8_BAR;
    for (;;) {
        const bool has_next = S.next(ui + 1, nxt);
        if (has_next) { PG8_AOFFS(oN, nxt); } else {
#pragma unroll
            for (int _h = 0; _h < 2; ++_h)
#pragma unroll
                for (int _i = 0; _i < 2; ++_i) oN[_h][_i] = oC[_h][_i]; }
        const char* nA = has_next ? (const char*)g.A + (size_t)nxt.pm * tstepA : cA;
        const char* nB = has_next ? (const char*)g.Bt + (size_t)nxt.pn * tstepB : cB;
        for (int t = 0; t < nt; t += 2) {
            const bool last = (t == nt - 2);
            const unsigned ka1 = (unsigned)(t + 1) * kstep;
            const unsigned ka2 = last ? 0u : (unsigned)(t + 2) * kstep, ka3 = ka2 + kstep;
            unsigned o2[2][2];
#pragma unroll
            for (int _h = 0; _h < 2; ++_h)
#pragma unroll
                for (int _i = 0; _i < 2; ++_i) o2[_h][_i] = last ? oN[_h][_i] : oC[_h][_i];
            const char* a2 = last ? nA : cA;
            const char* b2 = last ? nB : cB + (size_t)(t + 2) * kstep; const char* b3 = b2 + kstep;
            PG8_LDB(B0, 0, 0); PG8_LDB(B1, 0, 1); PG8_SCHED; PG8_LDA(At, 0, 0); PG8_STAGEA(PG8_SA(1, 1), cA, oC, 1, ka1);
            PG8_WAIT_V(8); PG8_WAIT_L(0); PG8_BAR; PG8_MMA(0, 0, At, B0); PG8_MMA(0, 1, At, B1); PG8_BAR; PG8_SCHED;
            PG8_LDA(At, 0, 1); PG8_STAGE(PG8_SB(0, 0), b2, voffB); PG8_STAGE(PG8_SB(0, 1), b2 + hstepB, voffB); PG8_STAGEA(PG8_SA(0, 0), a2, o2, 0, ka2);
            PG8_WAIT_V(8); PG8_WAIT_L(0); PG8_BAR; PG8_MMA(1, 0, At, B0); PG8_MMA(1, 1, At, B1); PG8_BAR; PG8_SCHED;
            PG8_LDB(B0, 1, 0); PG8_LDB(B1, 1, 1); PG8_SCHED; PG8_LDA(At, 1, 0); PG8_STAGEA(PG8_SA(0, 1), a2, o2, 1, ka2);
            PG8_WAIT_V(8); PG8_WAIT_L(0); PG8_BAR; PG8_MMA(0, 0, At, B0); PG8_MMA(0, 1, At, B1); PG8_BAR; PG8_SCHED;
            PG8_LDA(At, 1, 1); PG8_STAGE(PG8_SB(1, 0), b3, voffB); PG8_STAGE(PG8_SB(1, 1), b3 + hstepB, voffB); PG8_STAGEA(PG8_SA(1, 0), a2, o2, 0, ka3);
            PG8_WAIT_V(8); PG8_WAIT_L(0); PG8_BAR; PG8_MMA(1, 0, At, B0); PG8_MMA(1, 1, At, B1); PG8_BAR; PG8_SCHED;
        }
        if constexpr (ALIGN_EPI) { if (wr == 0) PG8_BAR; }
        E(acc, cur, wr, wc, fr, fq);
        if (!has_next) break;
#pragma unroll
        for (int a = 0; a < 2; ++a)
#pragma unroll
            for (int b = 0; b < 2; ++b)
#pragma unroll
                for (int m = 0; m < 4; ++m)
#pragma unroll
                    for (int n = 0; n < 2; ++n) acc[a][b][m][n] = (f32x4){0.f, 0.f, 0.f, 0.f};
        cur = nxt; cA = nA; cB = nB; ++ui;
#pragma unroll
        for (int _h = 0; _h < 2; ++_h)
#pragma unroll
            for (int _i = 0; _i < 2; ++_i) oC[_h][_i] = oN[_h][_i];
        if constexpr (ALIGN_EPI) { if (wr == 1) PG8_BAR; }
    }
    PG8_WAIT_V(0);
    if constexpr (!ALIGN_EPI) { if (wr == 0) PG8_BAR; }
    PG8_BAR;
#undef PG8_SA
#undef PG8_SB
#undef PG8_STAGE
#undef PG8_STAGEA
#undef PG8_LDA
#undef PG8_LDB
#undef PG8_MMA
#undef PG8_WAIT_V
#undef PG8_WAIT_L
#undef PG8_BAR
#undef PG8_SCHED
#undef PG8_AOFFS
}
}
struct Frame {
    LAS unsigned char* lds;
    volatile LAS unsigned* MISC;
    gu32* ctl;
    int tid, lane, wave, G, bx;
};
struct Args { const void* in[21]; float* out; unsigned char* ws; int ph_lo, ph_hi; };

__device__ __forceinline__ int pair_map(int j, int half) { return j < half ? 2 * j : 2 * (j - half) + 1; }
__device__ __forceinline__ int row_map(int mode, int n) {
    if (mode == 0) return n;
    if (mode <= 2) return 8 * (n >> 2) + 4 * (mode - 1) + (n & 3);
    if (mode == 3) { if (n >= C_KR && n < C_RQ) return C_KR + pair_map(n - C_KR, 16);
                     if (n >= C_RQ && n < C_RV) { const int hb = C_RQ + ((n - C_RQ) & ~63); return hb + pair_map(n - hb, 32); }
                     return n; }
    { const int h = n / 96, d = n % 96; return d < 64 ? n : h * 96 + 64 + pair_map(d - 64, 16); }
}
__device__ __forceinline__ void transpose_item(const float* W, int K, int N, bf16* WT, int mode, const float* kscale, LAS float* scr, int item, int lane) {
    const int nblk = N / 32, kb = item / nblk, nb = item % nblk, k0 = 64 * kb, n0 = 32 * nb;
#pragma unroll 8
    for (int i = 0; i < 32; ++i) { const int kk = 2 * i + (lane >> 5); float w = W[(size_t)(k0 + kk) * N + n0 + (lane & 31)]; if (kscale) w *= kscale[k0 + kk]; scr[kk * 33 + (lane & 31)] = w; }
    LDS_WAIT(); asm volatile("" ::: "memory");
    const int c = lane & 7;
#pragma unroll
    for (int j = 0; j < 4; ++j) { const int n = (lane >> 3) + 8 * j; const LAS float* s = scr + (8 * c) * 33 + n;
        v4u o; o.x = pk2(s[0 * 33], s[1 * 33]); o.y = pk2(s[2 * 33], s[3 * 33]); o.z = pk2(s[4 * 33], s[5 * 33]); o.w = pk2(s[6 * 33], s[7 * 33]);
        const int row = row_map(mode, n0 + n);
        *(GAS v4u*)(WT + (size_t)row * K + k0 + 8 * c) = o; }
    LDS_WAIT(); asm volatile("" ::: "memory");
}
__device__ __forceinline__ void p0_prologue(Frame& F, const Args& a) {
    unsigned char* ws = a.ws;
    float* mod = (float*)(ws + WS_MOD);
    for (int cb = F.bx; cb < MODW / 32; cb += F.G) {
        const float* c = (const float*)a.in[1]; const float* w_ada = (const float*)a.in[3]; const float* b_ada = (const float*)a.in[4];
        LAS float* sc = (LAS float*)F.lds;
        LAS float* part = (LAS float*)(F.lds + 65536);
        for (int i = F.tid; i < NB * DM; i += NTHR) sc[i] = silu_f(c[i]);
        __syncthreads();
        const int cc = F.tid & 31, kq = F.tid >> 5, n = cb * 32 + cc;
        float acc[NB];
#pragma unroll
        for (int b = 0; b < NB; ++b) acc[b] = 0.f;
        for (int k = kq; k < DM; k += 16) { const float w = w_ada[(size_t)k * MODW + n];
#pragma unroll
            for (int b = 0; b < NB; ++b) acc[b] += sc[b * DM + k] * w; }
#pragma unroll
        for (int b = 0; b < NB; ++b) part[(kq * NB + b) * 32 + cc] = acc[b];
        __syncthreads();
        { const int b = F.tid >> 5; float s = b_ada[n];
#pragma unroll
          for (int q = 0; q < 16; ++q) s += part[(q * NB + b) * 32 + cc];
          mod[(size_t)b * MODW + n] = s; }
        __syncthreads();
    }
    LAS float* scr = (LAS float*)(F.lds + F.wave * 16384);
    const int gw = F.bx * NWAVES + F.wave, NGW = F.G * NWAVES;
    constexpr int I_IN = (DM / 64) * (INW / 32), I_UQ = (256 / 64) * (QW / 32), I_UKV = (128 / 64) * (KVW / 32), I_O = (DM / 64) * (DM / 32);
    constexpr int I_W1 = (DM / 64) * (DE / 32), I_W2 = (DE / 64) * (DM / 32);
    constexpr int NITEMS = I_IN + I_UQ + I_UKV + I_O + NE * (2 * I_W1 + I_W2);
    for (int it = gw; it < NITEMS; it += NGW) {
        int r = it;
        if (r < I_IN) { transpose_item((const float*)a.in[6], DM, INW, (bf16*)(ws + WS_WIN), 3, nullptr, scr, r, F.lane); continue; } r -= I_IN;
        if (r < I_UQ) { transpose_item((const float*)a.in[8], 256, QW, (bf16*)(ws + WS_WUQ), 4, (const float*)a.in[7], scr, r, F.lane); continue; } r -= I_UQ;
        if (r < I_UKV) { transpose_item((const float*)a.in[10], 128, KVW, (bf16*)(ws + WS_WUKV), 0, (const float*)a.in[9], scr, r, F.lane); continue; } r -= I_UKV;
        if (r < I_O) { transpose_item((const float*)a.in[11], DM, DM, (bf16*)(ws + WS_WO), 0, nullptr, scr, r, F.lane); continue; } r -= I_O;
        if (r < NE * I_W1) { const int e = r / I_W1; transpose_item((const float*)a.in[17] + (size_t)e * DM * DE, DM, DE, (bf16*)(ws + WS_W13) + (size_t)e * 512 * DM, 1, nullptr, scr, r % I_W1, F.lane); continue; } r -= NE * I_W1;
        if (r < NE * I_W1) { const int e = r / I_W1; transpose_item((const float*)a.in[18] + (size_t)e * DM * DE, DM, DE, (bf16*)(ws + WS_W13) + (size_t)e * 512 * DM, 2, nullptr, scr, r % I_W1, F.lane); continue; } r -= NE * I_W1;
        { const int e = r / I_W2; transpose_item((const float*)a.in[19] + (size_t)e * DE * DM, DE, DM, (bf16*)(ws + WS_W2) + (size_t)e * DM * DE, 0, nullptr, scr, r % I_W2, F.lane); }
    }
    const int gt = F.bx * NTHR + F.tid, NGT = F.G * NTHR;
    { v4u z = (v4u){0u, 0u, 0u, 0u}; GAS v4u* p = (GAS v4u*)((bf16*)(ws + WS_WIN) + (size_t)INW * DM);
      for (int i = gt; i < (INWP - INW) * DM / 8; i += NGT) p[i] = z; }
    { const float* w_gr = (const float*)a.in[13]; const float* w_er = (const float*)a.in[15]; float* wf = (float*)(ws + WS_WR);
      bf16* wb = (bf16*)wf;
      for (int i = gt; i < 32 * 3 * 64 * 8; i += NGT) { const int ii = i & 7, l = (i >> 3) & 63, ntl = (i >> 9) % 3, s8 = i / 1536;
          const int k = 32 * s8 + 8 * (l >> 4) + ii, nc = 16 * ntl + (l & 15);
          const float w = nc < 4 ? w_gr[k * 4 + nc] : (nc < 36 ? w_er[k * 32 + (nc - 4)] : 0.f);
          const unsigned hi = f2bf(w); const float lo = w - bf2f(hi);
          const size_t base = ((size_t)(s8 * 3 + ntl) * 64 + l) * 16; wb[base + ii] = (bf16)hi; wb[base + 8 + ii] = (bf16)f2bf(lo); }
      if (gt < 48) { const float* b_gr = (const float*)a.in[14]; const float* b_er = (const float*)a.in[16];
          wf[64 * 3 * 64 * 4 + gt] = gt < 4 ? b_gr[gt] : (gt < 36 ? b_er[gt - 4] : 0.f); } }
}

__device__ __forceinline__ void p1_norm1(Frame& F, const Args& a) {
    const float* x = (const float*)a.in[0]; const float* g = (const float*)a.in[5]; const float* mod = (const float*)(a.ws + WS_MOD); bf16* h1 = (bf16*)(a.ws + WS_B);
    const int gw = F.bx * NWAVES + F.wave, NGW = F.G * NWAVES;
    for (int m0 = 4 * gw; m0 < T; m0 += 4 * NGW) {
        const int b = m0 >> 12;
        f32x4 v[4][4];
#pragma unroll
        for (int r = 0; r < 4; ++r) { const GAS f32x4* xr = (const GAS f32x4*)(x + (size_t)(m0 + r) * DM) + F.lane;
#pragma unroll
            for (int j = 0; j < 4; ++j) v[r][j] = xr[64 * j]; }
        f32x4 gs[4], sh[4];
#pragma unroll
        for (int j = 0; j < 4; ++j) { const int col = 4 * F.lane + 256 * j;
            gs[j] = *(const f32x4*)(g + col) * (*(const f32x4*)(mod + (size_t)b * MODW + DM + col) + 1.0f); sh[j] = *(const f32x4*)(mod + (size_t)b * MODW + col); }
#pragma unroll
        for (int r = 0; r < 4; ++r) { float s = 0.f;
#pragma unroll
            for (int j = 0; j < 4; ++j) s += (v[r][j].x * v[r][j].x + v[r][j].y * v[r][j].y) + (v[r][j].z * v[r][j].z + v[r][j].w * v[r][j].w);
            const float rstd = 1.0f / sqrtf(wave_sum(s) * (1.f / DM) + EPS);
            GAS v2u* o8 = (GAS v2u*)(h1 + (size_t)(m0 + r) * DM) + F.lane;
#pragma unroll
            for (int j = 0; j < 4; ++j) { const f32x4 o = (v[r][j] * rstd) * gs[j] + sh[j]; v2u w; w.x = cvtpk2(o.x, o.y); w.y = cvtpk2(o.z, o.w); o8[64 * j] = w; } }
    }
}

__device__ __forceinline__ float ret_log2g(int h) { return log2f(1.0f - exp2f(-5.0f - (float)h)); }

__device__ __forceinline__ void p7_norm2_router(Frame& F, const Args& a, int rep) {
    unsigned char* ws = a.ws;
    const float* x1 = (const float*)(ws + WS_A); const float* part = (const float*)(ws + WS_PART); const float* mod = (const float*)(ws + WS_MOD);
    const float* g2n = (const float*)a.in[12]; const float* wf = (const float*)(ws + WS_WR); const float* bias = wf + 64 * 3 * 64 * 4;
    bf16* h2 = (bf16*)(ws + (rep ? WS_END : WS_B)); float* gatew = (float*)(ws + (rep ? WS_END + 130 * MiB : WS_GATEW)); int* tok = (int*)(ws + (rep ? WS_END + 132 * MiB : WS_TOK)); int* slotinfo = (int*)(ws + (rep ? WS_END + 131 * MiB : WS_SLOT)); gu32* cntg = F.ctl + (rep ? CW_CNT2 : CW_CNT);
    const int lane = F.lane, wv = F.wave, row = lane & 15, kq = lane >> 4;
    LAS float* lg = (LAS float*)(F.lds + wv * 4096);
    LAS int* as_e = (LAS int*)(F.lds + 32768);
    LAS int* as_rank = as_e + 256; LAS int* as_entry = as_rank + 256;
    LAS int* cntL = as_entry + 256; LAS int* baseL = cntL + 32;
    LAS float* mw = (LAS float*)(F.lds + 40960 + wv * 8192);
    const int ntiles = T / 16, nrounds = (ntiles + F.G * NWAVES - 1) / (F.G * NWAVES);
    if (F.tid < 32) cntL[F.tid] = 0;
    __syncthreads();
    for (int rd = 0; rd < nrounds; ++rd) {
        const int ti = F.bx + F.G * (rd * NWAVES + wv);
        const bool tv = ti < ntiles;
        if (lane < 32) as_entry[wv * 32 + lane] = -1;
        if (tv) {
            const int t = ti * 16 + row, b = t >> 12;
            const float* mb = mod + (size_t)b * MODW;
#pragma unroll
            for (int j = 0; j < 4; ++j) { const int col = 4 * lane + 256 * j;
                *(LAS f32x4*)(mw + col) = *(const f32x4*)(g2n + col) * (*(const f32x4*)(mb + 4 * DM + col) + 1.0f); *(LAS f32x4*)(mw + DM + col) = *(const f32x4*)(mb + 3 * DM + col); }
            float rstd; { const f32x4* pp = (const f32x4*)(part + (size_t)t * 16); const f32x4 p0 = pp[0], p1 = pp[1], p2 = pp[2], p3 = pp[3];
                const float ss = ((p0.x + p0.y) + (p0.z + p0.w)) + ((p1.x + p1.y) + (p1.z + p1.w)) + ((p2.x + p2.y) + (p2.z + p2.w)) + ((p3.x + p3.y) + (p3.z + p3.w));
                rstd = 1.0f / sqrtf(ss * (1.f / DM) + EPS); }
            f32x4 acc[3]; acc[0] = (f32x4){0.f, 0.f, 0.f, 0.f}; acc[1] = acc[0]; acc[2] = acc[0];
            const float* xr = x1 + (size_t)t * DM + 8 * kq; bf16* hr = h2 + (size_t)t * DM + 8 * kq;
            const LAS float* mg = mw + 8 * kq; const v4u* wl = (const v4u*)wf + (size_t)lane * 2;
            LDS_WAIT(); asm volatile("" ::: "memory");
            f32x4 xq[4][2]; v4u wq[2][3][2];
#pragma unroll
            for (int u = 0; u < 4; ++u) { xq[u][0] = *(const f32x4*)(xr + 32 * u); xq[u][1] = *(const f32x4*)(xr + 32 * u + 4); }
#pragma unroll
            for (int u = 0; u < 2; ++u)
#pragma unroll
                for (int ntl = 0; ntl < 3; ++ntl) { const v4u* wp = wl + (size_t)(u * 3 + ntl) * 128; wq[u][ntl][0] = wp[0]; wq[u][ntl][1] = wp[1]; }
#pragma unroll 1
            for (int s8g = 0; s8g < 32; s8g += 4) {
#pragma unroll
                for (int u = 0; u < 4; ++u) { const int s8 = s8g + u, col = 32 * s8;
                    const f32x4 xa = xq[u][0], xb = xq[u][1];
                    if (s8 + 4 < 32) { xq[u][0] = *(const f32x4*)(xr + col + 128); xq[u][1] = *(const f32x4*)(xr + col + 132); }
                    v4u wh[3], wlo[3];
#pragma unroll
                    for (int ntl = 0; ntl < 3; ++ntl) { wh[ntl] = wq[u & 1][ntl][0]; wlo[ntl] = wq[u & 1][ntl][1]; }
                    if (s8 + 2 < 32) {
#pragma unroll
                        for (int ntl = 0; ntl < 3; ++ntl) { const v4u* wp = wl + (size_t)((s8 + 2) * 3 + ntl) * 128; wq[u & 1][ntl][0] = wp[0]; wq[u & 1][ntl][1] = wp[1]; } }
                    const f32x4 ga = *(const LAS f32x4*)(mg + col), gb = *(const LAS f32x4*)(mg + col + 4), sa = *(const LAS f32x4*)(mg + DM + col), sb = *(const LAS f32x4*)(mg + DM + col + 4);
                    const f32x4 ha = (xa * rstd) * ga + sa, hb = (xb * rstd) * gb + sb;
                    v4u hh; hh.x = cvtpk2(ha.x, ha.y); hh.y = cvtpk2(ha.z, ha.w); hh.z = cvtpk2(hb.x, hb.y); hh.w = cvtpk2(hb.z, hb.w); *(GAS v4u*)(hr + col) = hh;
                    v4u hl; hl.x = cvtpk2(ha.x - bflo(hh.x), ha.y - bfhi(hh.x)); hl.y = cvtpk2(ha.z - bflo(hh.y), ha.w - bfhi(hh.y)); hl.z = cvtpk2(hb.x - bflo(hh.z), hb.y - bfhi(hh.z)); hl.w = cvtpk2(hb.z - bflo(hh.w), hb.w - bfhi(hh.w));
                    const bf16x8 ah = __builtin_bit_cast(bf16x8, hh), al = __builtin_bit_cast(bf16x8, hl);
#pragma unroll
                    for (int ntl = 0; ntl < 3; ++ntl) { const bf16x8 bh = __builtin_bit_cast(bf16x8, wh[ntl]), bl = __builtin_bit_cast(bf16x8, wlo[ntl]);
                        acc[ntl] = __builtin_amdgcn_mfma_f32_16x16x32_bf16(ah, bh, acc[ntl], 0, 0, 0); acc[ntl] = __builtin_amdgcn_mfma_f32_16x16x32_bf16(al, bh, acc[ntl], 0, 0, 0);
                        acc[ntl] = __builtin_amdgcn_mfma_f32_16x16x32_bf16(ah, bl, acc[ntl], 0, 0, 0); } } }
#pragma unroll
            for (int ntl = 0; ntl < 3; ++ntl)
#pragma unroll
                for (int r = 0; r < 4; ++r) lg[(4 * kq + r) * 52 + 16 * ntl + row] = acc[ntl][r] + bias[16 * ntl + row];
            LDS_WAIT(); asm volatile("" ::: "memory");
            if (lane < 16) {
                const LAS float* l = lg + lane * 52; const int tt = ti * 16 + lane;
                float gm = l[0]; int gi = 0;
#pragma unroll
                for (int j = 1; j < 4; ++j) if (l[j] > gm) { gm = l[j]; gi = j; }
                float se = 0.f;
#pragma unroll
                for (int j = 0; j < 4; ++j) se += __expf(l[j] - gm);
                const float ptop = 1.0f / se;
                const LAS float* le = l + 4 + gi * 8;
                float v1 = le[0]; int i1 = 0;
#pragma unroll
                for (int j = 1; j < 8; ++j) if (le[j] > v1) { v1 = le[j]; i1 = j; }
                float v2 = -3.0e38f; int i2 = 0;
#pragma unroll
                for (int j = 0; j < 8; ++j) if (j != i1 && le[j] > v2) { v2 = le[j]; i2 = j; }
                const float ex = __expf(v2 - v1), g0 = ptop / (1.0f + ex), g1 = ptop * ex / (1.0f + ex);
                const int e0 = gi * 8 + i1, e1 = gi * 8 + i2;
                gatew[(size_t)tt * 2] = g0; gatew[(size_t)tt * 2 + 1] = g1;
                const int a0 = wv * 32 + lane * 2;
                as_e[a0] = e0; as_rank[a0] = __hip_atomic_fetch_add(cntL + e0, 1, __ATOMIC_RELAXED, __HIP_MEMORY_SCOPE_WORKGROUP); as_entry[a0] = tt * 2;
                as_e[a0 + 1] = e1; as_rank[a0 + 1] = __hip_atomic_fetch_add(cntL + e1, 1, __ATOMIC_RELAXED, __HIP_MEMORY_SCOPE_WORKGROUP); as_entry[a0 + 1] = tt * 2 + 1;
            }
        }
        __syncthreads();
        if (F.tid < 32) { const int c = cntL[F.tid]; baseL[F.tid] = c > 0 ? (int)__hip_atomic_fetch_add(cntg + F.tid * CNT_STRIDE, (unsigned)c, RLX_AGENT) : 0; }
        __syncthreads();
        if (F.tid < 256) { const int en = as_entry[F.tid]; if (en >= 0) { const int e = as_e[F.tid]; const int idx = e * CAP + baseL[e] + as_rank[F.tid]; tok[idx] = en; slotinfo[en] = idx; } }
        __syncthreads();
        if (F.tid < 32) cntL[F.tid] = 0;
        __syncthreads();
    }
}

__device__ __forceinline__ void p10_final(Frame& F, const Args& a, const LAS int* pre) {
    const float* x1 = (const float*)(a.ws + WS_A); const bf16* y = (const bf16*)(a.ws + WS_D); const float* mod = (const float*)(a.ws + WS_MOD); const float* fg = (const float*)a.in[20];
    const int* slotinfo = (const int*)(a.ws + WS_SLOT); const float* gatew = (const float*)(a.ws + WS_GATEW);
    const int gw = F.bx * NWAVES + F.wave, NGW = F.G * NWAVES;
    typedef int i32x4 __attribute__((ext_vector_type(4)));
    i32x4 cn = (i32x4){0, 0, 0, 0}; f32x4 wn = (f32x4){0.f, 0.f, 0.f, 0.f};
    if (2 * gw < T) { cn = *(const i32x4*)(slotinfo + 4 * gw); wn = *(const f32x4*)(gatew + 4 * gw); }
    for (int m0 = 2 * gw; m0 < T; m0 += 2 * NGW) {
        const int b = m0 >> 12;
        f32x4 v[2][4]; v2u ya[2][4], yb[2][4]; float w0[2], w1[2];
        const i32x4 cc = cn; const f32x4 wc = wn;
        if (m0 + 2 * NGW < T) { cn = *(const i32x4*)(slotinfo + 2 * (m0 + 2 * NGW)); wn = *(const f32x4*)(gatew + 2 * (m0 + 2 * NGW)); }
#pragma unroll
        for (int r = 0; r < 2; ++r) { const GAS f32x4* xr = (const GAS f32x4*)(x1 + (size_t)(m0 + r) * DM) + F.lane;
            const int c0 = __builtin_amdgcn_readfirstlane(cc[2 * r]), c1 = __builtin_amdgcn_readfirstlane(cc[2 * r + 1]);
            w0[r] = wc[2 * r]; w1[r] = wc[2 * r + 1];
            const size_t s0 = (size_t)(256 * pre[c0 >> 16] + (c0 & 65535)), s1 = (size_t)(256 * pre[c1 >> 16] + (c1 & 65535));
            const GAS v2u* y0 = (const GAS v2u*)(y + s0 * DM) + F.lane; const GAS v2u* y1 = (const GAS v2u*)(y + s1 * DM) + F.lane;
#pragma unroll
            for (int j = 0; j < 4; ++j) { v[r][j] = xr[64 * j]; ya[r][j] = y0[64 * j]; yb[r][j] = y1[64 * j]; } }
        f32x4 g2[4], gf[4];
#pragma unroll
        for (int j = 0; j < 4; ++j) { const int col = 4 * F.lane + 256 * j; g2[j] = *(const f32x4*)(mod + (size_t)b * MODW + 5 * DM + col); gf[j] = *(const f32x4*)(fg + col); }
#pragma unroll
        for (int r = 0; r < 2; ++r) { float s = 0.f;
#pragma unroll
            for (int j = 0; j < 4; ++j) { const v2u a0 = ya[r][j], a1 = yb[r][j];
                f32x4 yy; yy.x = w0[r] * bflo(a0.x) + w1[r] * bflo(a1.x); yy.y = w0[r] * bfhi(a0.x) + w1[r] * bfhi(a1.x); yy.z = w0[r] * bflo(a0.y) + w1[r] * bflo(a1.y); yy.w = w0[r] * bfhi(a0.y) + w1[r] * bfhi(a1.y);
                v[r][j] = v[r][j] + g2[j] * yy; s += (v[r][j].x * v[r][j].x + v[r][j].y * v[r][j].y) + (v[r][j].z * v[r][j].z + v[r][j].w * v[r][j].w); }
            const float rstd = 1.0f / sqrtf(wave_sum(s) * (1.f / DM) + EPS);
            GAS f32x4* o = (GAS f32x4*)(a.out + (size_t)(m0 + r) * DM) + F.lane;
#pragma unroll
            for (int j = 0; j < 4; ++j) o[64 * j] = (v[r][j] * rstd) * gf[j]; }
    }
}
namespace mix {
__device__ __forceinline__ int crow(int r, int hi) { return (r & 3) + 8 * (r >> 2) + 4 * hi; }
__device__ __forceinline__ unsigned cvtpk(float lo, float hi) { return cvtpk2(lo, hi); }
typedef short v4i16_t __attribute__((ext_vector_type(4)));
__device__ __forceinline__ s16x4 vtr(const LAS unsigned char* p) { return __builtin_bit_cast(s16x4, __builtin_amdgcn_ds_read_tr16_b64_v4i16((LAS v4i16_t*)p)); }
__device__ __forceinline__ bf16x8 frag2(s16x4 lo, s16x4 hi) { return (bf16x8){lo[0], lo[1], lo[2], lo[3], hi[0], hi[1], hi[2], hi[3]}; }
__device__ __forceinline__ float swap_add(float v) { auto rr = __builtin_amdgcn_permlane32_swap(__float_as_uint(v), __float_as_uint(v), false, false); return __uint_as_float(rr[0]) + __uint_as_float(rr[1]); }
__device__ __forceinline__ float swap_max(float v) { auto rr = __builtin_amdgcn_permlane32_swap(__float_as_uint(v), __float_as_uint(v), false, false); return fmaxf(__uint_as_float(rr[0]), __uint_as_float(rr[1])); }
__device__ __forceinline__ void glds16_asm(const void* gsrc, unsigned lds_dst) { unsigned keep;
    asm volatile("s_mov_b32 %0, m0\n\ts_mov_b32 m0, %2\n\ts_nop 0\n\tglobal_load_lds_dwordx4 %1, off\n\ts_mov_b32 m0, %0" : "=&s"(keep) : "v"(gsrc), "s"(lds_dst) : "memory"); }
#define GLDS16(gp, lp) glds16_asm((const void*)(gp), (unsigned)__builtin_amdgcn_readfirstlane((int)(unsigned)(uintptr_t)(lp)))

constexpr int A_KS = 12288, A_VS = 8192, A_V0 = 49152;
__device__ __forceinline__ void attn_unit(LAS unsigned char* lds, int b, int h, int qb, const bf16* q, const bf16* kv, const bf16* proj, const int* positions, bf16* omix) {
    const int tid = threadIdx.x, lane = tid & 63, r32 = lane & 31, hi = lane >> 5; const int wid = __builtin_amdgcn_readfirstlane(tid >> 6);
    const size_t rowbase = (size_t)b * SEQ; const int q0 = qb * 256;
    const int NT = (q0 + 256) / 64;
    const bf16* ksrc = kv + (rowbase + lane) * KVW + h * 128 + 8 * wid;
    const bf16* psrc = proj + (rowbase + lane) * INWP + C_KR + 8 * (wid & 3);
    const bf16* vsrc = kv + (rowbase + 16 * (wid & 3) + (lane >> 2)) * KVW + h * 128 + 64 + (wid >> 2) * 32 + (lane & 3) * 8;
    LAS unsigned char* kd0 = lds + wid * 1024; LAS unsigned char* pd0 = lds + (8 + (wid & 3)) * 1024; LAS unsigned char* vd0 = lds + A_V0 + wid * 1024;
#define ADMA(t) do { const int s_ = (t) & 3; GLDS16(ksrc + (size_t)(t) * 64 * KVW, kd0 + s_ * A_KS); GLDS16(psrc + (size_t)(t) * 64 * INWP, pd0 + s_ * A_KS); GLDS16(vsrc + (size_t)(t) * 64 * KVW, vd0 + s_ * A_VS); } while (0)
    ADMA(0); ADMA(1);
    const size_t qrow = rowbase + q0 + wid * 32 + r32;
    const float C2 = 0.10206207261596575f * 1.4426950408889634f;
    bf16x8 qr[6];
    { const bf16* qp = q + qrow * QW + h * 96 + 8 * hi; v4u raw[6];
#pragma unroll
      for (int d0 = 0; d0 < 6; ++d0) raw[d0] = *(const GAS v4u*)(qp + 16 * d0);
      const float pos = (float)positions[qrow];
#pragma unroll
      for (int d0 = 0; d0 < 4; ++d0) { v4u o;
#pragma unroll
          for (int j = 0; j < 4; ++j) o[j] = cvtpk(bflo(raw[d0][j]) * C2, bfhi(raw[d0][j]) * C2);
          qr[d0] = __builtin_bit_cast(bf16x8, o); }
      v4u o1, o2;
#pragma unroll
      for (int j = 0; j < 4; ++j) {
#pragma unroll
          for (int e = 0; e < 2; ++e) { const int f = 8 * e + 4 * hi + j; float tt = pos * (exp2f(-(float)f * (13.287712379549449f / 16.f)) * 0.15915494309189535f); tt -= floorf(tt);
              const float sn = __builtin_amdgcn_sinf(tt), cs = __builtin_amdgcn_cosf(tt);
              const unsigned w = e ? raw[5][j] : raw[4][j]; const float x1 = bflo(w), x2 = bfhi(w);
              const unsigned r = cvtpk((x1 * cs - x2 * sn) * C2, (x1 * sn + x2 * cs) * C2);
              if (e) o2[j] = r; else o1[j] = r; } }
      qr[4] = __builtin_bit_cast(bf16x8, o1); qr[5] = __builtin_bit_cast(bf16x8, o2); }
    float mhat = 0.f, l_run = 0.f; f32x16 o[2]; o[0] = f32x16{}; o[1] = f32x16{};
    const int qrel = wid * 32 + r32;
    const int voff = ((lane >> 4) & 1) * 32 + (lane & 3) * 8 + (4 * hi + ((lane & 15) >> 2)) * 64;
    f32x16 pA0, pA1, pB0, pB1; v4u pw[4]; float resc_f = 1.0f; bool resc = false;
#define SGB(mask, n) __builtin_amdgcn_sched_group_barrier(mask, n, 0)
#define ATOP(t) do { if ((t) + 1 < NT) asm volatile("s_waitcnt vmcnt(3) lgkmcnt(0)\n\ts_barrier" ::: "memory"); else WAIT_BAR0(); if ((t) + 2 < NT) ADMA((t) + 2); } while (0)
#define AQK(C0, C1, t) do { const LAS unsigned char* kb_ = lds + ((t) & 3) * A_KS + hi * 1024 + r32 * 16; \
        { const bf16x8 k0_ = *(const LAS bf16x8*)(kb_), k1_ = *(const LAS bf16x8*)(kb_ + 512); \
          C0 = __builtin_amdgcn_mfma_f32_32x32x16_bf16(k0_, qr[0], f32x16{}, 0, 0, 0); C1 = __builtin_amdgcn_mfma_f32_32x32x16_bf16(k1_, qr[0], f32x16{}, 0, 0, 0); } \
        _Pragma("unroll") for (int d0 = 1; d0 < 6; ++d0) { const bf16x8 k0_ = *(const LAS bf16x8*)(kb_ + d0 * 2048), k1_ = *(const LAS bf16x8*)(kb_ + d0 * 2048 + 512); \
            C0 = __builtin_amdgcn_mfma_f32_32x32x16_bf16(k0_, qr[d0], C0, 0, 0, 0); C1 = __builtin_amdgcn_mfma_f32_32x32x16_bf16(k1_, qr[d0], C1, 0, 0, 0); } } while (0)
#define ASUMPACK(P0, P1) do { float s0_ = P0[0] + P0[1], s1_ = P1[0] + P1[1]; \
        _Pragma("unroll") for (int r = 2; r < 16; ++r) { s0_ += P0[r]; s1_ += P1[r]; } l_run += s0_ + s1_; \
        _Pragma("unroll") for (int j = 0; j < 4; ++j) { pw[0][j] = cvtpk(P0[2 * j], P0[2 * j + 1]); pw[1][j] = cvtpk(P0[8 + 2 * j], P0[9 + 2 * j]); pw[2][j] = cvtpk(P1[2 * j], P1[2 * j + 1]); pw[3][j] = cvtpk(P1[8 + 2 * j], P1[9 + 2 * j]); } } while (0)
#define AMASK(C0, C1, t) do { const int jb_ = (t) - (NT - 4); if (jb_ >= 0) { const int kb0_ = 64 * jb_ + 4 * hi; \
        _Pragma("unroll") for (int r = 0; r < 16; ++r) { const int kvr_ = kb0_ + (r & 3) + 8 * (r >> 2); if (kvr_ > qrel) C0[r] = -INFINITY; if (kvr_ + 32 > qrel) C1[r] = -INFINITY; } } } while (0)
#define ADECIDE(C0, C1, FIRST) do { \
        float ra_ = fmaxf(fmaxf(C0[0], C0[1]), C1[0]), rb_ = fmaxf(fmaxf(C0[2], C0[3]), C1[1]); ra_ = fmaxf(fmaxf(ra_, C1[2]), C1[3]); \
        _Pragma("unroll") for (int r = 4; r < 16; r += 4) { ra_ = fmaxf(fmaxf(ra_, C0[r]), C0[r + 1]); rb_ = fmaxf(fmaxf(rb_, C0[r + 2]), C0[r + 3]); ra_ = fmaxf(fmaxf(ra_, C1[r]), C1[r + 1]); rb_ = fmaxf(fmaxf(rb_, C1[r + 2]), C1[r + 3]); } \
        const float rm_ = swap_max(fmaxf(ra_, rb_)); resc = false; \
        if ((FIRST) || __builtin_expect(__any(rm_ - mhat > 8.0f), 0)) { const float mn_ = (FIRST) ? rm_ : fmaxf(mhat, rm_); \
            resc_f = (FIRST) ? 1.0f : __builtin_amdgcn_exp2f(mhat - mn_); mhat = mn_; l_run *= resc_f; resc = true; } } while (0)
#define AEXP(C0, C1) do { _Pragma("unroll") for (int r = 0; r < 16; ++r) { C0[r] = __builtin_amdgcn_exp2f(C0[r] - mhat); C1[r] = __builtin_amdgcn_exp2f(C1[r] - mhat); } } while (0)
#define APV(vs) do { const LAS unsigned char* vp_ = lds + A_V0 + (vs) * A_VS + voff; \
        _Pragma("unroll") for (int ks = 0; ks < 4; ++ks) _Pragma("unroll") for (int d0 = 0; d0 < 2; ++d0) { const s16x4 lo_ = vtr(vp_ + d0 * 4096 + ks * 1024), hh_ = vtr(vp_ + d0 * 4096 + ks * 1024 + 512); \
                o[d0] = __builtin_amdgcn_mfma_f32_32x32x16_bf16(frag2(lo_, hh_), __builtin_bit_cast(bf16x8, pw[ks]), o[d0], 0, 0, 0); } } while (0)
#define ARESC() do { if (resc) { _Pragma("unroll") for (int r = 0; r < 16; ++r) { o[0][r] *= resc_f; o[1][r] *= resc_f; } } } while (0)
#define SBAR() __builtin_amdgcn_sched_barrier(0)
#define PIN(x) asm volatile("" : "+v"(x))
#define ASTEP(C0, C1, P0, P1, t) do { ATOP(t); \
        bf16x8 kf_[12]; { const LAS unsigned char* kb_ = lds + ((t) & 3) * A_KS + hi * 1024 + r32 * 16; \
            _Pragma("unroll") for (int d0 = 0; d0 < 6; ++d0) { kf_[2 * d0] = *(const LAS bf16x8*)(kb_ + d0 * 2048); kf_[2 * d0 + 1] = *(const LAS bf16x8*)(kb_ + d0 * 2048 + 512); } } \
        SBAR(); \
        ASUMPACK(P0, P1); PIN(l_run); PIN(pw[0]); PIN(pw[1]); PIN(pw[2]); PIN(pw[3]); \
        SBAR(); \
        C0 = __builtin_amdgcn_mfma_f32_32x32x16_bf16(kf_[0], qr[0], f32x16{}, 0, 0, 0); C1 = __builtin_amdgcn_mfma_f32_32x32x16_bf16(kf_[1], qr[0], f32x16{}, 0, 0, 0); \
        _Pragma("unroll") for (int d0 = 1; d0 < 6; ++d0) { C0 = __builtin_amdgcn_mfma_f32_32x32x16_bf16(kf_[2 * d0], qr[d0], C0, 0, 0, 0); C1 = __builtin_amdgcn_mfma_f32_32x32x16_bf16(kf_[2 * d0 + 1], qr[d0], C1, 0, 0, 0); } \
        SBAR(); \
        AMASK(C0, C1, t); ADECIDE(C0, C1, false); \
        SBAR(); \
        s16x4 vl_[8], vh_[8]; { const LAS unsigned char* vp_ = lds + A_V0 + (((t) - 1) & 3) * A_VS + voff; \
            _Pragma("unroll") for (int i = 0; i < 8; ++i) { vl_[i] = vtr(vp_ + (i & 1) * 4096 + (i >> 1) * 1024); vh_[i] = vtr(vp_ + (i & 1) * 4096 + (i >> 1) * 1024 + 512); } } \
        SBAR(); \
        _Pragma("unroll") for (int i = 0; i < 8; ++i) { \
            o[i & 1] = __builtin_amdgcn_mfma_f32_32x32x16_bf16(frag2(vl_[i], vh_[i]), __builtin_bit_cast(bf16x8, pw[i >> 1]), o[i & 1], 0, 0, 0); \
            if (i < 4) { _Pragma("unroll") for (int r = 0; r < 4; ++r) C0[4 * i + r] = __builtin_amdgcn_exp2f(C0[4 * i + r] - mhat); PIN(C0); } \
            else { _Pragma("unroll") for (int r = 0; r < 4; ++r) C1[4 * (i - 4) + r] = __builtin_amdgcn_exp2f(C1[4 * (i - 4) + r] - mhat); PIN(C1); } \
            SBAR(); } \
        ARESC(); } while (0)
    ATOP(0); AQK(pA0, pA1, 0); AMASK(pA0, pA1, 0); ADECIDE(pA0, pA1, true); AEXP(pA0, pA1); resc = false;
    for (int t = 1; t + 2 < NT; t += 2) { ASTEP(pB0, pB1, pA0, pA1, t); ASTEP(pA0, pA1, pB0, pB1, t + 1); }
    ASTEP(pB0, pB1, pA0, pA1, NT - 1);
    ASUMPACK(pB0, pB1); APV((NT - 1) & 3);
#undef SGB
#undef ATOP
#undef ASUMPACK
#undef AMASK
#undef ADECIDE
#undef AEXP
#undef APV
#undef ARESC
#undef ASTEP
#undef SBAR
#undef PIN
    l_run = swap_add(l_run);
    const float inv = 1.0f / l_run;
    bf16* op = omix + qrow * DM + h * 64 + 4 * hi;
#pragma unroll
    for (int d0 = 0; d0 < 2; ++d0)
#pragma unroll
        for (int a4 = 0; a4 < 4; ++a4) { v2u w; w.x = cvtpk(o[d0][4 * a4] * inv, o[d0][4 * a4 + 1] * inv); w.y = cvtpk(o[d0][4 * a4 + 2] * inv, o[d0][4 * a4 + 3] * inv);
            *(GAS v2u*)(op + 32 * d0 + 8 * a4) = w; }
    WAIT_BAR0();
#undef ADMA
#undef AQK
}

constexpr int R_STG = 65536, R_K = 16384, R_V = 32768, R_ST = 131072, R_STAT = 147456;
__device__ __forceinline__ void ret_unit(LAS unsigned char* lds, int b, int hh, const bf16* proj, bf16* omix) {
    const int tid = threadIdx.x, lane = tid & 63, r32 = lane & 31, hi = lane >> 5; const int wid = __builtin_amdgcn_readfirstlane(tid >> 6);
    const int qbk = wid & 3, dvh = wid >> 2;
    const size_t rowbase = (size_t)b * SEQ;
    const float g128 = exp2f(128.0f * ret_log2g(hh));
    for (int i = tid; i < 16384 / 16; i += NTHR) *(LAS v4u*)(lds + R_ST + i * 16) = (v4u){0u, 0u, 0u, 0u};
    f32x16 st = f32x16{};
    const bf16* qsrc = proj + (rowbase + lane) * INWP + C_RQ + hh * 64 + 8 * wid;
    const bf16* ksrc = proj + (rowbase + lane) * INWP + C_RK + hh * 64 + 8 * wid;
    const bf16* vsrc = proj + (rowbase + (lane >> 2)) * INWP + C_RV + hh * 128 + (lane & 3) * 8;
#define RDMA(n, s) do { const size_t ro_ = (size_t)(n) * 128 * INWP; LAS unsigned char* sb_ = lds + (s) * R_STG; \
        GLDS16(qsrc + ro_, sb_ + wid * 2048); GLDS16(qsrc + ro_ + 64 * INWP, sb_ + wid * 2048 + 1024); \
        GLDS16(ksrc + ro_, sb_ + R_K + wid * 2048); GLDS16(ksrc + ro_ + 64 * INWP, sb_ + R_K + wid * 2048 + 1024); \
        _Pragma("unroll") for (int pq_ = 0; pq_ < 4; ++pq_) { const int pc_ = wid + 8 * pq_, cg_ = pc_ >> 3, rg_ = pc_ & 7; \
            GLDS16(vsrc + ro_ + (size_t)(16 * rg_) * INWP + cg_ * 32, sb_ + R_V + cg_ * 8192 + rg_ * 1024); } } while (0)
    RDMA(0, 0);
    const int g1 = (lane >> 4) & 1, qq = (lane & 15) >> 2, pp = lane & 3;
    const int tr_v = (4 * hi + qq) * 64 + 32 * g1 + 8 * pp;
    const int tr_n = (8 * hi + qq) * 64 + 32 * g1 + 8 * pp;
    const int tr_k = (8 * hi + qq) * 16 + (2 * g1 + (pp >> 1)) * 2048 + (pp & 1) * 8;
    for (int n = 0; n < 32; ++n) {
        const int s = n & 1;
        WAIT_BAR0();
        if (n + 1 < 32) RDMA(n + 1, s ^ 1);
        const LAS unsigned char* sb = lds + s * R_STG;
        const size_t trow = rowbase + (size_t)n * 128 + 32 * qbk + r32;
        v2u grr[2][4];
        { const bf16* gp = proj + trow * INWP + C_RG + hh * 128 + 64 * dvh + 4 * hi;
#pragma unroll
          for (int d0 = 0; d0 < 2; ++d0)
#pragma unroll
              for (int a4 = 0; a4 < 4; ++a4) grr[d0][a4] = *(const GAS v2u*)(gp + 32 * d0 + 8 * a4); }
#define RSBAR() __builtin_amdgcn_sched_barrier(0)
        bf16x8 qf[4]; bf16x8 kfr[4][4];
#pragma unroll
        for (int k = 0; k < 4; ++k) qf[k] = *(const LAS bf16x8*)(sb + (2 * k + hi) * 2048 + (32 * qbk + r32) * 16);
#pragma unroll
        for (int jt = 0; jt < 4; ++jt)
#pragma unroll
            for (int k = 0; k < 4; ++k) kfr[jt][k] = *(const LAS bf16x8*)(sb + R_K + (2 * k + hi) * 2048 + (32 * jt + r32) * 16);
        RSBAR();
        v4u pw[4][2];
#pragma unroll
        for (int jt = 0; jt < 4; ++jt) {
            f32x16 p = __builtin_amdgcn_mfma_f32_32x32x16_bf16(kfr[jt][0], qf[0], f32x16{}, 0, 0, 0);
#pragma unroll
            for (int k = 1; k < 4; ++k) p = __builtin_amdgcn_mfma_f32_32x32x16_bf16(kfr[jt][k], qf[k], p, 0, 0, 0);
            const int dq = 32 * (qbk - jt) + r32;
#pragma unroll
            for (int r = 0; r < 16; ++r) if (crow(r, hi) > dq) p[r] = 0.f;
#pragma unroll
            for (int j = 0; j < 4; ++j) { pw[jt][0][j] = cvtpk(p[2 * j], p[2 * j + 1]); pw[jt][1][j] = cvtpk(p[8 + 2 * j], p[9 + 2 * j]); }
        }
        RSBAR();
        f32x16 o[2]; o[0] = f32x16{}; o[1] = f32x16{};
#pragma unroll
        for (int d0 = 0; d0 < 2; ++d0) {
            const LAS unsigned char* vb = sb + R_V + (2 * dvh + d0) * 8192 + tr_v; const LAS unsigned char* stb = lds + R_ST + (2 * dvh + d0) * 4096 + tr_n;
            s16x4 va[8], vc[8], sa[4], sc[4];
#pragma unroll
            for (int i = 0; i < 8; ++i) { const LAS unsigned char* vp = vb + (16 * i) * 64; va[i] = vtr(vp); vc[i] = vtr(vp + 512); }
#pragma unroll
            for (int k = 0; k < 4; ++k) { const LAS unsigned char* sp = stb + (16 * k) * 64; sa[k] = vtr(sp); sc[k] = vtr(sp + 256); }
            RSBAR();
#pragma unroll
            for (int i = 0; i < 8; ++i) o[d0] = __builtin_amdgcn_mfma_f32_32x32x16_bf16(frag2(va[i], vc[i]), __builtin_bit_cast(bf16x8, pw[i >> 1][i & 1]), o[d0], 0, 0, 0);
#pragma unroll
            for (int k = 0; k < 4; ++k) o[d0] = __builtin_amdgcn_mfma_f32_32x32x16_bf16(frag2(sa[k], sc[k]), qf[k], o[d0], 0, 0, 0);
            RSBAR();
        }
        { const LAS unsigned char* vb = sb + R_V + qbk * 8192 + tr_n; const LAS unsigned char* kb = sb + R_K + dvh * 8192 + tr_k;
          s16x4 va[8], vc[8], ka[8], kc[8];
#pragma unroll
          for (int ks = 0; ks < 8; ++ks) { const LAS unsigned char* vp = vb + (16 * ks) * 64; const LAS unsigned char* kp = kb + (16 * ks) * 16; va[ks] = vtr(vp); vc[ks] = vtr(vp + 256); ka[ks] = vtr(kp); kc[ks] = vtr(kp + 64); }
          RSBAR();
#pragma unroll
          for (int ks = 0; ks < 8; ++ks) st = __builtin_amdgcn_mfma_f32_32x32x16_bf16(frag2(va[ks], vc[ks]), frag2(ka[ks], kc[ks]), st, 0, 0, 0);
#pragma unroll
          for (int r = 0; r < 16; ++r) st[r] *= g128; }
#undef RSBAR
        LGK_BAR();
        { LAS unsigned char* sw = lds + R_ST + qbk * 4096 + (32 * dvh + r32) * 64 + 8 * hi;
#pragma unroll
          for (int a4 = 0; a4 < 4; ++a4) { v2u w; w.x = cvtpk(st[4 * a4], st[4 * a4 + 1]); w.y = cvtpk(st[4 * a4 + 2], st[4 * a4 + 3]); *(LAS v2u*)(sw + 16 * a4) = w; } }
        float s1 = 0.f, s2 = 0.f;
#pragma unroll
        for (int d0 = 0; d0 < 2; ++d0)
#pragma unroll
            for (int r = 0; r < 16; ++r) { s1 += o[d0][r]; s2 += o[d0][r] * o[d0][r]; }
        s1 = swap_add(s1); s2 = swap_add(s2);
        LAS f32x2* stat = (LAS f32x2*)(lds + R_STAT);
        if (hi == 0) stat[wid * 32 + r32] = (f32x2){s1, s2};
        LGK_BAR();
        { const f32x2 ot = stat[(wid ^ 4) * 32 + r32]; s1 += ot.x; s2 += ot.y; }
        const float mean = s1 * (1.f / 128.f), var = fmaxf(s2 * (1.f / 128.f) - mean * mean, 0.f), rstd = 1.0f / sqrtf(var + EPS);
        bf16* op = omix + trow * DM + 512 + hh * 128 + 64 * dvh + 4 * hi;
#pragma unroll
        for (int d0 = 0; d0 < 2; ++d0)
#pragma unroll
            for (int a4 = 0; a4 < 4; ++a4) { const v2u gr = grr[d0][a4];
                const float y0 = silu_f(bflo(gr.x)) * (o[d0][4 * a4] - mean) * rstd, y1 = silu_f(bfhi(gr.x)) * (o[d0][4 * a4 + 1] - mean) * rstd;
                const float y2 = silu_f(bflo(gr.y)) * (o[d0][4 * a4 + 2] - mean) * rstd, y3 = silu_f(bfhi(gr.y)) * (o[d0][4 * a4 + 3] - mean) * rstd;
                v2u w; w.x = cvtpk(y0, y1); w.y = cvtpk(y2, y3); *(GAS v2u*)(op + 32 * d0 + 8 * a4) = w; }
    }
    WAIT_BAR0();
#undef RDMA
}
#undef GLDS16
}
#ifndef MK_ONE_LAUNCH
#define MK_ONE_LAUNCH 1
#endif
constexpr int NPHASE = 11;
__global__ void __launch_bounds__(NTHR, 2) fwd(Args args) {
    extern __shared__ __attribute__((aligned(16))) unsigned char lds_raw[];
    Frame F;
    F.lds = (LAS unsigned char*)lds_raw;
    F.MISC = (volatile LAS unsigned*)(F.lds + MISC_OFF);
    F.tid = threadIdx.x; F.lane = F.tid & 63; F.wave = __builtin_amdgcn_readfirstlane(F.tid >> 6);
    F.G = gridDim.x; F.bx = blockIdx.x;
    unsigned char* ws = args.ws;
    F.ctl = (gu32*)(ws + WS_CTL);
    for (int u = F.tid; u < (LDS_BYTES - LDSCTL_OFF) / 4; u += NTHR) ((LAS unsigned*)(F.lds + LDSCTL_OFF))[u] = 0u;
    __syncthreads();
    XcdBarrier bar; bar.bar = (unsigned*)(F.ctl + CW_BAR); bar.x = 0; bar.st = nullptr;
    const int lo = args.ph_lo, hi = args.ph_hi;
    if (hi - lo > 1) bar = xcd_barrier_post((unsigned*)(F.ctl + CW_BAR), F.MISC + 8);
#ifdef ONLY_PHASE
#define IN(k) ((k) == ONLY_PHASE && lo <= (k) && (k) < hi)
#else
#define IN(k) (lo <= (k) && (k) < hi)
#endif
#define SEAM(k) do { if (IN(k) && IN((k) + 1)) xcd_barrier(bar); } while (0)
    LAS unsigned char* ring = F.lds;

#ifndef REP_PHASE
#define REP_PHASE -1
#endif
    int rep_id = 0;
#define RUN(k, ...) do { if (IN(k)) { { __VA_ARGS__ } if (REP_PHASE == (k)) { xcd_barrier(bar); rep_id = 1; { __VA_ARGS__ } rep_id = 0; } SEAM(k); } } while (0)
    RUN(0, p0_prologue(F, args););
    RUN(1, p1_norm1(F, args););
    RUN(2,
        pg8::Gemm g{(const bf16*)(ws + WS_B), (const bf16*)(ws + WS_WIN), DM, DM}; pg8::StaticOrder S; S.init(T, INWP, F.G, F.bx);
        pg8::EpiProj E{(bf16*)(ws + WS_A), (const int*)args.in[2], (float*)(ws + WS_PQ), (float*)(ws + WS_PKV)};
        pg8::gemm_phase<pg8::EpiProj, pg8::StaticOrder, true>(ring, g, S, E);
    );
    RUN(4,
        { pg8::Gemm g{(const bf16*)(ws + WS_A) + C_CQ, (const bf16*)(ws + WS_WUQ), INWP, 256}; pg8::StaticOrder S; S.init(T, QW, F.G, F.bx);
          pg8::EpiScaled<8, 256> E{(bf16*)(ws + WS_B), QW, (const float*)(ws + WS_PQ)};
          pg8::gemm_phase<pg8::EpiScaled<8, 256>, pg8::StaticOrder, true>(ring, g, S, E); }
        { pg8::Gemm g{(const bf16*)(ws + WS_A) + C_CKV, (const bf16*)(ws + WS_WUKV), INWP, 128}; pg8::StaticOrder S; S.init(T, KVW, F.G, F.bx);
          pg8::EpiScaled<4, 128> E{(bf16*)(ws + WS_C), KVW, (const float*)(ws + WS_PKV)};
          pg8::gemm_phase<pg8::EpiScaled<4, 128>, pg8::StaticOrder, true>(ring, g, S, E); }
    );
    RUN(5,
        const bf16* proj = (const bf16*)(ws + WS_A); bf16* omix = (bf16*)(ws + WS_D);
#ifndef REP5_MODE
#define REP5_MODE 0
#endif
        if (!(rep_id == 1 && REP5_MODE == 2)) for (int u = F.bx; u < NB * 4; u += F.G) mix::ret_unit(ring, u >> 2, u & 3, proj, omix);
        volatile LAS int* qs = (volatile LAS int*)(F.MISC + 16);
        if (!(rep_id == 1 && REP5_MODE == 1)) for (;;) {
            if (F.tid == 0) qs[0] = (int)__hip_atomic_fetch_add(F.ctl + CW_QUEUE + 64 * rep_id, 1u, RLX_AGENT);
            __syncthreads();
            const int u = qs[0];
            __syncthreads();
            if (u >= NB * 8 * 16) break;
            const int qb = 15 - (u >> 7), bh = u & 127;
            mix::attn_unit(ring, bh >> 3, bh & 7, qb, (const bf16*)(ws + WS_B), (const bf16*)(ws + WS_C), proj, (const int*)args.in[2], omix);
        }
    );
    RUN(6,
        pg8::Gemm g{(const bf16*)(ws + WS_D), (const bf16*)(ws + WS_WO), DM, DM}; pg8::StaticOrder S; S.init(T, DM, F.G, F.bx);
        pg8::EpiResid E{(const float*)args.in[0], (const float*)(ws + WS_MOD), (float*)(ws + WS_A), (float*)(ws + WS_PART)};
        pg8::gemm_phase<pg8::EpiResid, pg8::StaticOrder, true>(ring, g, S, E);
    );
    RUN(7, p7_norm2_router(F, args, rep_id););
    if (IN(8) || IN(9) || IN(10)) {
        LAS int* pre = (LAS int*)(F.MISC + 32);
        if (F.tid == 0) { int s = 0; for (int e = 0; e < NE; ++e) { pre[e] = s; s += ((int)__hip_atomic_load(F.ctl + CW_CNT + e * CNT_STRIDE, RLX_AGENT) + 255) >> 8; } pre[NE] = s; }
        __syncthreads();
        const int* cnt = (const int*)(F.ctl + CW_CNT); const int* tok = (const int*)(ws + WS_TOK);
        RUN(8,
            pg8::Gemm g{(const bf16*)(ws + WS_B), (const bf16*)(ws + WS_W13), DM, DM}; pg8::MoeOrder S{F.G, F.bx, 2, pre, cnt, tok};
            pg8::EpiSwiGLU E{(bf16*)(ws + WS_C)};
            pg8::gemm_phase<pg8::EpiSwiGLU, pg8::MoeOrder, true, true>(ring, g, S, E);
        );
        RUN(9,
            pg8::Gemm g{(const bf16*)(ws + WS_C), (const bf16*)(ws + WS_W2), DE, DE}; pg8::MoeOrder S{F.G, F.bx, 4, pre, cnt, nullptr};
            pg8::EpiBf16 E{(bf16*)(ws + WS_D), DM};
            pg8::gemm_phase<pg8::EpiBf16, pg8::MoeOrder, true>(ring, g, S, E);
        );
        RUN(10, p10_final(F, args, pre););
    }
#undef RUN
#undef IN
#undef SEAM
}

extern "C" void kernel_launch(void* const* d_in, const int* in_sizes, int n_in, void* d_out, int out_size, void* d_ws, size_t ws_size, hipStream_t stream) {
    static int grid = 0;
    if (grid == 0) {
        if (n_in != 21 || in_sizes[0] != T * DM || out_size != T * DM || ws_size < WS_END) { fprintf(stderr, "kernel_launch: unexpected shapes (n_in %d, in0 %d, out %d, ws %zu); nothing launched\n", n_in, n_in > 0 ? in_sizes[0] : -1, out_size, ws_size); grid = -1; return; }
        int dev = 0, cus = 0, per_cu = 0;
        if (hipGetDevice(&dev) != hipSuccess || hipDeviceGetAttribute(&cus, hipDeviceAttributeMultiprocessorCount, dev) != hipSuccess) { grid = -1; return; }
        if (hipFuncSetAttribute((const void*)fwd, hipFuncAttributeMaxDynamicSharedMemorySize, LDS_BYTES) != hipSuccess) { fprintf(stderr, "kernel_launch: hipFuncSetAttribute failed\n"); grid = -1; return; }
        if (hipOccupancyMaxActiveBlocksPerMultiprocessor(&per_cu, (const void*)fwd, NTHR, LDS_BYTES) != hipSuccess || per_cu < 1) fprintf(stderr, "kernel_launch: occupancy query reports %d\n", per_cu);
        (void)hipGetLastError();
        grid = cus;
    }
    if (grid < 0) return;
    if (hipMemsetAsync((char*)d_ws + WS_CTL, 0, CTL_ZERO_BYTES, stream) != hipSuccess) return;
    Args a{};
    for (int i = 0; i < 21; ++i) a.in[i] = d_in[i];
    a.out = (float*)d_out; a.ws = (unsigned char*)d_ws;
#if MK_ONE_LAUNCH
    a.ph_lo = 0; a.ph_hi = NPHASE;
    hipLaunchKernelGGL(fwd, dim3(grid), dim3(NTHR), LDS_BYTES, stream, a);
#else
    for (int p = 0; p < NPHASE; ++p) { a.ph_lo = p; a.ph_hi = p + 1; hipLaunchKernelGGL(fwd, dim3(grid), dim3(NTHR), LDS_BYTES, stream, a); }
#endif
}
```

```cpp
#include <hip/hip_runtime.h>
#include <cstdio>
#include <cstdint>

#define GAS __attribute__((address_space(1)))
#define LAS __attribute__((address_space(3)))
typedef unsigned short bf16;
typedef unsigned v4u __attribute__((ext_vector_type(4)));
typedef unsigned v2u __attribute__((ext_vector_type(2)));
typedef float f32x2 __attribute__((ext_vector_type(2)));
typedef float f32x4 __attribute__((ext_vector_type(4)));
typedef float f32x16 __attribute__((ext_vector_type(16)));
typedef short bf16x8 __attribute__((ext_vector_type(8)));
typedef short s16x4 __attribute__((ext_vector_type(4)));
typedef GAS unsigned gu32;

constexpr int DM = 1024, NB = 16, SEQ = 4096, T = NB * SEQ;
constexpr int INW = 1952, INWP = 2048;
constexpr int C_CQ = 0, C_CKV = 256, C_KR = 384, C_RQ = 416, C_RK = 672, C_RV = 928, C_RG = 1440;
constexpr int QW = 768, KVW = 1024;
constexpr int NE = 32, DE = 256, CAP = 65536;
constexpr int MODW = 6 * DM;
constexpr float EPS = 1e-6f;
constexpr int NWAVES = 8, NTHR = 512;

constexpr size_t MiB = 1u << 20;
constexpr size_t WS_CTL = 0, CTL_ZERO_BYTES = 256 * 1024;
constexpr size_t WS_MOD = 1 * MiB;
constexpr size_t WS_WR = 1 * MiB + 512 * 1024;
constexpr size_t WS_WIN = 2 * MiB, WS_WUQ = 6 * MiB, WS_WUKV = 6 * MiB + 512 * 1024, WS_WO = 7 * MiB, WS_W13 = 9 * MiB, WS_W2 = 41 * MiB;
constexpr size_t WS_PQ = 70 * MiB;
constexpr size_t WS_PKV = 60 * MiB;
constexpr size_t WS_PART = 57 * MiB;
constexpr size_t WS_GATEW = 61 * MiB;
constexpr size_t WS_SLOT = 61 * MiB + 512 * 1024;
constexpr size_t WS_PTI = 1 * MiB + 768 * 1024;
constexpr int NPAIR = 4 * 28;
constexpr size_t WS_TOK = 62 * MiB;
constexpr size_t WS_A = 72 * MiB;
constexpr size_t WS_K8 = (328 + 96) * MiB;
constexpr size_t WS_B = 328 * MiB;
constexpr size_t WS_C = 456 * MiB;
constexpr size_t WS_D = 584 * MiB;
constexpr size_t WS_END = 872 * MiB;
constexpr int CW_TMO = 0, CW_CODE = 1, CW_BAR = 4096, CW_CNT = 8192, CNT_STRIDE = 64, CW_CNT2 = 12288, CW_QUEUE = 16384, CW_PCNT = 32768;

constexpr int RING_BYTES = 149504;
constexpr int LDSCTL_OFF = 150528, MISC_OFF = LDSCTL_OFF;
constexpr int LDS_BYTES = 151552;

#define RLX_AGENT __ATOMIC_RELAXED, __HIP_MEMORY_SCOPE_AGENT
#define LDS_WAIT() asm volatile("s_waitcnt lgkmcnt(0)" ::: "memory")
#define VM_WAIT() asm volatile("s_waitcnt vmcnt(0)" ::: "memory")
#define WAIT_BAR0() asm volatile("s_waitcnt vmcnt(0) lgkmcnt(0)\n\ts_barrier" ::: "memory")
#define LGK_BAR() asm volatile("s_waitcnt lgkmcnt(0)\n\ts_barrier" ::: "memory")
__device__ __forceinline__ unsigned f2bf(float f) { unsigned u = __builtin_bit_cast(unsigned, f); return (u + 0x7fffu + ((u >> 16) & 1u)) >> 16; }
__device__ __forceinline__ unsigned pk2(float lo, float hi) { return f2bf(lo) | (f2bf(hi) << 16); }
typedef __bf16 bf16x2_t __attribute__((ext_vector_type(2)));
__device__ __forceinline__ unsigned cvtpk2(float lo, float hi) { f32x2 v = {lo, hi}; bf16x2_t b = __builtin_convertvector(v, bf16x2_t); return __builtin_bit_cast(unsigned, b); }
__device__ __forceinline__ float clamp448(float v) { return __builtin_fminf(__builtin_fmaxf(v, -448.0f), 448.0f); }
__device__ __forceinline__ unsigned cvt4_fp8(float a, float b, float c, float d) { int p = __builtin_amdgcn_cvt_pk_fp8_f32(clamp448(a), clamp448(b), 0, false); p = __builtin_amdgcn_cvt_pk_fp8_f32(clamp448(c), clamp448(d), p, true); return (unsigned)p; }
constexpr float F8_SW13 = 32.0f, F8_SW2 = 16.0f, F8_SH = 8.0f, F8_SY = 16.0f;
constexpr unsigned F8_E1 = 0x7f7f7f7fu, F8_E32 = 0x7a7a7a7au, F8_E16 = 0x7b7b7b7bu, F8_E8 = 0x7c7c7c7cu;
__device__ __forceinline__ f32x4 fp8x4_f32(unsigned w) { return (f32x4){__builtin_amdgcn_cvt_f32_fp8((int)w, 0), __builtin_amdgcn_cvt_f32_fp8((int)w, 1), __builtin_amdgcn_cvt_f32_fp8((int)w, 2), __builtin_amdgcn_cvt_f32_fp8((int)w, 3)}; }
__device__ __forceinline__ float bf2f(unsigned b) { return __builtin_bit_cast(float, b << 16); }
__device__ __forceinline__ float bflo(unsigned w) { return __builtin_bit_cast(float, w << 16); }
__device__ __forceinline__ float bfhi(unsigned w) { return __builtin_bit_cast(float, w & 0xffff0000u); }
__device__ __forceinline__ float wave_sum(float v) {
#pragma unroll
    for (int o = 1; o < 64; o <<= 1) v += __shfl_xor(v, o);
    return v;
}
__device__ __forceinline__ float silu_f(float v) { return v / (1.0f + __expf(-v)); }

#define XB_TMO      128
#define XB_XCNT(j)  (256  + 64 * (j))
#define XB_XSUB(j)  (1280 + 64 * (j))
#define XB_XGEN(j)  (2304 + 64 * (j))
#define XB_TOP      3328
#define XB_TOPGEN   3392
#define XCD_BAR_WORDS 3456
#define XB_SPIN_CAP (1u << 22)
__device__ __forceinline__ unsigned xb_ld(unsigned* p)              { return __hip_atomic_load(p, __ATOMIC_RELAXED, __HIP_MEMORY_SCOPE_AGENT); }
__device__ __forceinline__ unsigned xb_add(unsigned* p, unsigned v) { return __hip_atomic_fetch_add(p, v, __ATOMIC_RELAXED, __HIP_MEMORY_SCOPE_AGENT); }
__device__ __forceinline__ unsigned xb_xcc_id() { return (unsigned)__builtin_amdgcn_s_getreg((3 << 11) | 20) & 0xFu; }
#define XB_SPIN(cond, bar) do { unsigned _sp = 0; while (cond) { __builtin_amdgcn_s_sleep(1); \
    if ((++_sp & 255u) == 0u) { if (xb_ld(&(bar)[XB_TMO])) break; if (_sp > XB_SPIN_CAP) { atomicAdd(&(bar)[XB_TMO], 1u); break; } } } } while (0)
struct XcdBarrier { unsigned* bar; unsigned x; volatile LAS unsigned* st; };
__device__ __forceinline__ XcdBarrier xcd_barrier_post(unsigned* bar, volatile LAS unsigned* st) {
    XcdBarrier b; b.bar = bar; b.x = xb_xcc_id(); b.st = st;
    if (threadIdx.x == 0) (void)xb_add(&bar[XB_XCNT(b.x)], 1u);
    return b;
}
__device__ __forceinline__ void xcd_barrier_complete(unsigned* bar, unsigned x, unsigned& nloc, unsigned& nx) {
    const unsigned G = gridDim.x * gridDim.y * gridDim.z;
    unsigned sum, cnt, mine, sp = 0u;
    for (;;) {
        sum = 0u; cnt = 0u; mine = 0u;
#pragma unroll
        for (unsigned j = 0; j < 16; ++j) { const unsigned c = xb_ld(&bar[XB_XCNT(j)]); sum += c; cnt += (c > 0u) ? 1u : 0u; mine = (j == x) ? c : mine; }
        if (sum == G) break;
        __builtin_amdgcn_s_sleep(1);
        if ((++sp & 255u) == 0u) { if (xb_ld(&bar[XB_TMO])) break; if (sp > XB_SPIN_CAP) { atomicAdd(&bar[XB_TMO], 1u); break; } }
    }
    nloc = mine > 0u ? mine : 1u; nx = cnt > 0u ? cnt : 1u;
}
__device__ __forceinline__ void xcd_barrier(const XcdBarrier& b) {
    asm volatile("s_waitcnt vmcnt(0)" ::: "memory");
    __syncthreads();
    if (threadIdx.x == 0) {
        unsigned* bar = b.bar;
        __builtin_amdgcn_s_waitcnt(0);
        unsigned nloc = b.st[0], nx = b.st[1];
        if (nloc == 0u) { xcd_barrier_complete(bar, b.x, nloc, nx); b.st[0] = nloc; b.st[1] = nx; }
        const unsigned old = xb_add(&bar[XB_XSUB(b.x)], 1u);
        const unsigned gen = old / nloc;
        if (old + 1u == (gen + 1u) * nloc) {
            __builtin_amdgcn_fence(__ATOMIC_RELEASE, "agent");
            asm volatile("s_waitcnt vmcnt(0)" ::: "memory");
            const unsigned og = xb_add(&bar[XB_TOP], 1u);
            const unsigned tg = og / nx;
            if (og + 1u == (tg + 1u) * nx) xb_add(&bar[XB_TOPGEN], 1u);
            else XB_SPIN(xb_ld(&bar[XB_TOPGEN]) == tg, bar);
            __builtin_amdgcn_fence(__ATOMIC_ACQUIRE, "agent");
            xb_add(&bar[XB_XGEN(b.x)], 1u);
            asm volatile("s_waitcnt vmcnt(0)" ::: "memory");
        } else {
            XB_SPIN(xb_ld(&bar[XB_XGEN(b.x)]) == gen, bar);
            __builtin_amdgcn_fence(__ATOMIC_ACQUIRE, "agent");
            asm volatile("s_waitcnt vmcnt(0)" ::: "memory");
        }
    }
    __syncthreads();
}
namespace pg8 {
constexpr int BM = 256, BK = 64, HALF = 128, HTB = HALF * BK * 2, STAGE_BYTES = 8 * HTB, NXCD = 8, WGM = 8;
__host__ __device__ __forceinline__ int lds_byte(int r, int c) { const int st = (r >> 4) * 2 + (c >> 5), rr = r & 15, cc = c & 31, ob = rr * 64 + cc * 2; return st * 1024 + (ob ^ (((ob >> 9) & 1) << 5)); }
__host__ __device__ __forceinline__ void stage_rc(int b, int& R, int& C) { const int st = b / 1024, sb = b % 1024, swz = sb ^ (((sb >> 9) & 1) << 5); R = (st >> 1) * 16 + swz / 64; C = (st & 1) * 32 + (swz % 64) / 2; }
__host__ __device__ __forceinline__ int perm32(int rho) { const int n = rho >> 4, i = rho & 15; return 8 * (i >> 2) + 4 * n + (i & 3); }

struct Unit { int pm, pn, e, rb, nv, pnl, acol, cont; };
struct Gemm { const bf16* A; const bf16* Bt; int lda, K; unsigned sw = 0x7f7f7f7fu, sx = 0x7f7f7f7fu; };

struct StaticOrder {
    int nM, nN, nwg, G, c;
    __device__ void init(int M, int N, int G_, int c_) { nM = M / BM; nN = N / BM; nwg = nM * nN; G = G_; c = c_; }
    __device__ bool next(int i, Unit& u) const {
        const long L = (long)i * G + c; if (L >= nwg) return false;
        int wgid = (int)L; { const int q = nwg / NXCD, r = nwg % NXCD, xcd = wgid % NXCD, off = wgid / NXCD; wgid = (xcd < r ? xcd * (q + 1) : r * (q + 1) + (xcd - r) * q) + off; }
        const int nig = WGM * nN, gid = wgid / nig, fm = gid * WGM, gsz = (nM - fm) < WGM ? (nM - fm) : WGM;
        u.pm = fm + ((wgid % nig) % gsz); u.pn = (wgid % nig) / gsz; u.e = 0; u.rb = 0; u.nv = 256; u.pnl = u.pn; u.acol = 0; u.cont = 0; return true;
    }
    __device__ __forceinline__ unsigned arow(const Unit& u, int r) const { return (unsigned)(u.pm * BM + r); }
};
struct MoeOrder {
    int G, c, ncol; const LAS int* pre; const int* cnt; const int* tok;
    __device__ bool next(int i, Unit& u) const {
        const int L = i * G + c, gb = L / ncol, pl = L % ncol;
        if (gb >= pre[NE]) return false;
        const int lj = threadIdx.x & 31;
        const unsigned long long bm = __ballot(pre[lj] <= gb) & 0xffffffffull;
        const int e = 31 - __builtin_clz((unsigned)bm);
        u.pm = gb; u.e = e; u.rb = gb - pre[e]; u.pnl = pl; u.pn = e * ncol + pl; u.acol = 0; u.cont = 0;
        const int left = cnt[e * CNT_STRIDE] - u.rb * 256; u.nv = left < 256 ? left : 256; return true;
    }
    __device__ __forceinline__ unsigned arow(const Unit& u, int r) const {
        if (tok) return (r < u.nv) ? (unsigned)(tok[(size_t)u.e * CAP + u.rb * 256 + r] >> 1) : 0u;
        return (unsigned)(u.pm * BM + r);
    }
};

struct PairOrder {
    int G, c; const LAS int* ppre;
    __device__ bool next(int i, Unit& u) const {
        const int L = (i >> 1) * G + c, h = i & 1, gb = L >> 2, pl = L & 3;
        if (gb >= ppre[NPAIR]) return false;
        const int lj = threadIdx.x & 63;
        const unsigned long long b0 = __ballot(ppre[lj] <= gb), b1 = __ballot(lj < NPAIR - 64 && ppre[64 + lj] <= gb);
        const int pid = b1 ? 127 - __builtin_clzll(b1) : 63 - __builtin_clzll(b0);
        int pidx = pid % 28, a = 0; const int g = pid / 28;
        while (pidx >= 7 - a) { pidx -= 7 - a; ++a; }
        const int b = a + 1 + pidx;
        u.pm = gb; u.e = pid; u.rb = gb - ppre[pid]; u.pnl = pl; u.pn = (g * 8 + (h ? b : a)) * 4 + pl; u.nv = 256; u.acol = h * 256; u.cont = h; return true;
    }
    __device__ __forceinline__ unsigned arow(const Unit& u, int r) const { return (unsigned)(u.pm * BM + r); }
};

__device__ __forceinline__ unsigned cvt_pk_bf16(float lo, float hi) { return cvtpk2(lo, hi); }

struct EpiBf16 {
    static constexpr bool PERM = true;
    bf16* O; int ldc;
    __device__ __forceinline__ void operator()(const f32x4 (&acc)[2][2][4][2], const Unit& u, int wr, int wc, int fr, int fq) const {
        const int row0 = u.pm * BM + wr * 64 + fr; const int col0 = u.pnl * BM + wc * 32 + 8 * fq;
#pragma unroll
        for (int ai = 0; ai < 2; ++ai)
#pragma unroll
            for (int m = 0; m < 4; ++m) { bf16* rowp = O + (size_t)(row0 + ai * HALF + m * 16) * ldc + col0;
#pragma unroll
                for (int bj = 0; bj < 2; ++bj) { const f32x4 v0 = acc[ai][bj][m][0], v1 = acc[ai][bj][m][1];
                    v4u w; w.x = cvt_pk_bf16(v0[0], v0[1]); w.y = cvt_pk_bf16(v0[2], v0[3]); w.z = cvt_pk_bf16(v1[0], v1[1]); w.w = cvt_pk_bf16(v1[2], v1[3]);
                    *(v4u*)(rowp + bj * HALF) = w; } }
    }
};
struct EpiFp8 {
    static constexpr bool PERM = true;
    unsigned char* O; int ldc; float scale;
    __device__ __forceinline__ void operator()(const f32x4 (&acc)[2][2][4][2], const Unit& u, int wr, int wc, int fr, int fq) const {
        const int row0 = u.pm * BM + wr * 64 + fr; const int col0 = u.pnl * BM + wc * 32 + 8 * fq;
#pragma unroll
        for (int ai = 0; ai < 2; ++ai)
#pragma unroll
            for (int m = 0; m < 4; ++m) { unsigned char* rowp = O + (size_t)(row0 + ai * HALF + m * 16) * ldc + col0;
#pragma unroll
                for (int bj = 0; bj < 2; ++bj) { const f32x4 v0 = acc[ai][bj][m][0] * scale, v1 = acc[ai][bj][m][1] * scale;
                    v2u w; w.x = cvt4_fp8(v0[0], v0[1], v0[2], v0[3]); w.y = cvt4_fp8(v1[0], v1[1], v1[2], v1[3]);
                    *(v2u*)(rowp + bj * HALF) = w; } }
    }
};
struct EpiProj {
    static constexpr bool PERM = true;
    bf16* O; const int* positions; float* pq; float* pkv;
    __device__ __forceinline__ void operator()(const f32x4 (&acc)[2][2][4][2], const Unit& u, int wr, int wc, int fr, int fq) const {
        const int row0 = u.pm * BM + wr * 64 + fr;
        const float L2B = 13.287712379549449f, I2PI = 0.15915494309189535f;
        float posr[2][4];
#pragma unroll
        for (int ai = 0; ai < 2; ++ai)
#pragma unroll
            for (int m = 0; m < 4; ++m) posr[ai][m] = (u.pnl >= 1 && u.pnl <= 3) ? (float)positions[row0 + ai * HALF + m * 16] : 0.f;
#pragma unroll
        for (int bj = 0; bj < 2; ++bj) {
            const int seg = u.pnl * BM + bj * HALF + wc * 32;
            const int kind = seg < 256 ? 0 : seg < 384 ? 1 : seg < 416 ? 2 : seg < 672 ? 3 : seg < 928 ? 4 : 5;
            float cf[4]; float lgh = 0.f;
            if (kind == 2) {
#pragma unroll
                for (int i = 0; i < 4; ++i) cf[i] = exp2f(-(float)(4 * fq + i) * (1.f / 16.f) * L2B) * I2PI;
            } else if (kind == 3 || kind == 4) { const int base = kind == 3 ? 416 : 672, hh = (seg - base) >> 6, off = ((seg - base) & 63) + 8 * fq;
                lgh = log2f(1.0f - exp2f(-5.0f - (float)hh));
#pragma unroll
                for (int i = 0; i < 4; ++i) cf[i] = exp2f(-(float)(off / 2 + i) * (1.f / 32.f) * L2B) * I2PI;
            } else {
#pragma unroll
                for (int i = 0; i < 4; ++i) cf[i] = 0.f; }
#pragma unroll
            for (int ai = 0; ai < 2; ++ai)
#pragma unroll
                for (int m = 0; m < 4; ++m) { const int row = row0 + ai * HALF + m * 16;
                    float v[8];
#pragma unroll
                    for (int i = 0; i < 4; ++i) { v[i] = acc[ai][bj][m][0][i]; v[4 + i] = acc[ai][bj][m][1][i]; }
                    if (kind <= 1) { float ss = 0.f;
#pragma unroll
                        for (int i = 0; i < 8; ++i) ss += v[i] * v[i];
                        ss += __shfl_xor(ss, 16); ss += __shfl_xor(ss, 32);
                        if (fq == 0) { if (kind == 0) pq[(size_t)row * 8 + bj * 4 + wc] = ss; else pkv[(size_t)row * 4 + wc] = ss; }
                    } else if (kind <= 4) { const float pos = posr[ai][m]; float scl = 1.0f;
                        if (kind >= 3) { const float lg = lgh * (float)((row & 127) + 1); scl = kind == 3 ? exp2f(lg) : 0.125f * exp2f(-lg); }
#pragma unroll
                        for (int i = 0; i < 4; ++i) { float t = pos * cf[i]; t -= floorf(t); const float sn = __builtin_amdgcn_sinf(t), cs = __builtin_amdgcn_cosf(t);
                            const float x1 = v[2 * i], x2 = v[2 * i + 1]; v[2 * i] = (x1 * cs - x2 * sn) * scl; v[2 * i + 1] = (x1 * sn + x2 * cs) * scl; } }
                    v4u w; w.x = cvt_pk_bf16(v[0], v[1]); w.y = cvt_pk_bf16(v[2], v[3]); w.z = cvt_pk_bf16(v[4], v[5]); w.w = cvt_pk_bf16(v[6], v[7]);
                    *(v4u*)(O + (size_t)row * INWP + seg + 8 * fq) = w; }
        }
    }
};
template <int NP, int NC> struct EpiScaled {
    static constexpr bool PERM = true;
    bf16* O; int ldc; const float* part; unsigned char* k8;
    __device__ __forceinline__ void operator()(const f32x4 (&acc)[2][2][4][2], const Unit& u, int wr, int wc, int fr, int fq) const {
        const int row0 = u.pm * BM + wr * 64 + fr; const int col0 = u.pnl * BM + wc * 32 + 8 * fq;
        float rstd[2][4];
        { f32x4 pv[2][4][NP / 4];
#pragma unroll
          for (int ai = 0; ai < 2; ++ai)
#pragma unroll
              for (int m = 0; m < 4; ++m)
#pragma unroll
                  for (int p = 0; p < NP / 4; ++p) pv[ai][m][p] = *(const f32x4*)(part + (size_t)(row0 + ai * HALF + m * 16) * NP + 4 * p);
#pragma unroll
          for (int ai = 0; ai < 2; ++ai)
#pragma unroll
              for (int m = 0; m < 4; ++m) { float ss = 0.f;
#pragma unroll
                  for (int p = 0; p < NP / 4; ++p) ss += (pv[ai][m][p].x + pv[ai][m][p].y) + (pv[ai][m][p].z + pv[ai][m][p].w);
                  rstd[ai][m] = 1.0f / sqrtf(ss * (1.f / NC) + EPS); } }
        asm volatile("" ::: "memory");
#pragma unroll
        for (int ai = 0; ai < 2; ++ai)
#pragma unroll
            for (int m = 0; m < 4; ++m) { const int row = row0 + ai * HALF + m * 16; const float rs = rstd[ai][m];
                bf16* rowp = O + (size_t)row * ldc + col0;
#pragma unroll
                for (int bj = 0; bj < 2; ++bj) { const f32x4 v0 = acc[ai][bj][m][0] * rs, v1 = acc[ai][bj][m][1] * rs;
                    if (NP == 4 && wc < 2) { v2u w8; w8.x = cvt4_fp8(v0[0], v0[1], v0[2], v0[3]); w8.y = cvt4_fp8(v1[0], v1[1], v1[2], v1[3]);
                        *(v2u*)(k8 + (size_t)row * 512 + (2 * u.pnl + bj) * 64 + wc * 32 + 8 * fq) = w8; continue; }
                    if (NP == 4) {
                        const int k = row & 63, k5 = k & 31, pos = 32 * ((k5 >> 2) & 1) + 16 * (k >> 5) + 4 * (k5 >> 3) + (k5 & 3);
                        const int dvb = (wc - 2) * 32 + 8 * fq;
                        unsigned char* vb = (unsigned char*)O + ((size_t)(((row >> 12) * 8 + 2 * u.pnl + bj) * 64 + ((row & 4095) >> 6)) * 64 + dvb) * 64 + (pos & 15);
                        const int pa = (((pos >> 4) ^ ((dvb >> 2) & 3)) << 4), pb = (((pos >> 4) ^ (((dvb >> 2) + 1) & 3)) << 4);
                        const unsigned wa = cvt4_fp8(v0[0], v0[1], v0[2], v0[3]), wb = cvt4_fp8(v1[0], v1[1], v1[2], v1[3]);
                        vb[pa] = (unsigned char)wa; vb[pa + 64] = (unsigned char)(wa >> 8); vb[pa + 128] = (unsigned char)(wa >> 16); vb[pa + 192] = (unsigned char)(wa >> 24);
                        vb[pb + 256] = (unsigned char)wb; vb[pb + 320] = (unsigned char)(wb >> 8); vb[pb + 384] = (unsigned char)(wb >> 16); vb[pb + 448] = (unsigned char)(wb >> 24); continue; }
                    v4u w; w.x = cvt_pk_bf16(v0[0], v0[1]); w.y = cvt_pk_bf16(v0[2], v0[3]); w.z = cvt_pk_bf16(v1[0], v1[1]); w.w = cvt_pk_bf16(v1[2], v1[3]);
                    *(v4u*)(rowp + bj * HALF) = w; } }
    }
};
struct EpiNull {
    static constexpr bool PERM = true;
    float* sink;
    __device__ __forceinline__ void operator()(const f32x4 (&acc)[2][2][4][2], const Unit& u, int wr, int wc, int fr, int fq) const {
        float s = 0.f;
#pragma unroll
        for (int ai = 0; ai < 2; ++ai)
#pragma unroll
            for (int bj = 0; bj < 2; ++bj)
#pragma unroll
                for (int m = 0; m < 4; ++m)
#pragma unroll
                    for (int n = 0; n < 2; ++n) s += acc[ai][bj][m][n][0];
        if (s == 1.2345e30f) sink[0] = s;
    }
};
struct EpiResid {
    static constexpr bool PERM = true;
    const float* x; const float* mod; bf16* x1; float* part;
    __device__ __forceinline__ void operator()(const f32x4 (&acc)[2][2][4][2], const Unit& u, int wr, int wc, int fr, int fq) const {
        const int row0 = u.pm * BM + wr * 64 + fr; const int col0 = u.pnl * BM + wc * 32 + 8 * fq;
        const int b = (u.pm * BM) / SEQ;
        const float* g1 = mod + (size_t)b * MODW + 2 * DM;
        f32x4 gv[2][2];
#pragma unroll
        for (int bj = 0; bj < 2; ++bj)
#pragma unroll
            for (int n = 0; n < 2; ++n) gv[bj][n] = *(const f32x4*)(g1 + col0 + bj * HALF + 4 * n);
#pragma unroll
        for (int ai = 0; ai < 2; ++ai) {
            f32x4 xv[4][2][2];
#pragma unroll
            for (int m = 0; m < 4; ++m) { const size_t off = (size_t)(row0 + ai * HALF + m * 16) * DM + col0;
#pragma unroll
                for (int bj = 0; bj < 2; ++bj) { xv[m][bj][0] = *(const f32x4*)(x + off + bj * HALF); xv[m][bj][1] = *(const f32x4*)(x + off + bj * HALF + 4); } }
            asm volatile("" ::: "memory");
#pragma unroll
            for (int m = 0; m < 4; ++m) { const int row = row0 + ai * HALF + m * 16; const size_t off = (size_t)row * DM + col0; float ss = 0.f;
#pragma unroll
                for (int bj = 0; bj < 2; ++bj) { const f32x4 o0 = xv[m][bj][0] + gv[bj][0] * acc[ai][bj][m][0], o1 = xv[m][bj][1] + gv[bj][1] * acc[ai][bj][m][1];
                    v4u w; w.x = cvt_pk_bf16(o0[0], o0[1]); w.y = cvt_pk_bf16(o0[2], o0[3]); w.z = cvt_pk_bf16(o1[0], o1[1]); w.w = cvt_pk_bf16(o1[2], o1[3]);
                    *(v4u*)(x1 + off + bj * HALF) = w;
#pragma unroll
                    for (int j = 0; j < 4; ++j) { const float lo = bflo(w[j]), hi = bfhi(w[j]); ss += lo * lo + hi * hi; } }
                ss += __shfl_xor(ss, 16); ss += __shfl_xor(ss, 32);
                if (fq == 0) part[(size_t)row * 16 + u.pnl * 4 + wc] = ss; }
            asm volatile("" ::: "memory");
        }
    }
};
struct EpiSwiGLU {
    static constexpr bool PERM = true;
    bf16* H;
    __device__ __forceinline__ void operator()(const f32x4 (&acc)[2][2][4][2], const Unit& u, int wr, int wc, int fr, int fq) const {
        const int row0 = u.pm * BM + wr * 64 + fr; const int col0 = u.pnl * 128 + wc * 16 + 4 * fq;
#pragma unroll
        for (int ai = 0; ai < 2; ++ai)
#pragma unroll
            for (int m = 0; m < 4; ++m) { bf16* rowp = H + (size_t)(row0 + ai * HALF + m * 16) * DE + col0;
#pragma unroll
                for (int bj = 0; bj < 2; ++bj) { const f32x4 g = acc[ai][bj][m][0], v = acc[ai][bj][m][1];
                    v2u w; w.x = cvt_pk_bf16(silu_f(g[0]) * v[0], silu_f(g[1]) * v[1]); w.y = cvt_pk_bf16(silu_f(g[2]) * v[2], silu_f(g[3]) * v[3]);
                    *(v2u*)(rowp + bj * 64) = w; } }
    }
};
struct EpiSwiGLU2 {
    static constexpr bool PERM = true;
    unsigned char* H; const int* tok; const int* ptinfo; const float* gatew; const LAS int* ppre;
    __device__ __forceinline__ void operator()(const f32x4 (&acc)[2][2][4][2], const Unit& u, int wr, int wc, int fr, int fq) const {
        const int col0 = u.pnl * 128 + wc * 16 + 4 * fq;
#pragma unroll
        for (int ai = 0; ai < 2; ++ai) {
            int en[4]; int pi[4]; float w[4];
#pragma unroll
            for (int m = 0; m < 4; ++m) { const int rl = ai * HALF + wr * 64 + m * 16 + fr; en[m] = rl < u.nv ? tok[(size_t)u.e * CAP + u.rb * 256 + rl] : -1; }
#pragma unroll
            for (int m = 0; m < 4; ++m) { pi[m] = en[m] >= 0 ? ptinfo[en[m] >> 1] : 0; w[m] = en[m] >= 0 ? F8_SH * gatew[en[m]] : 0.f; }
            asm volatile("" ::: "memory");
#pragma unroll
            for (int m = 0; m < 4; ++m) if (en[m] >= 0) {
                const int pid = (pi[m] & 0x3fffffff) >> 16, ppos = pi[m] & 65535, half = (en[m] & 1) ^ ((pi[m] >> 30) & 1);
                unsigned char* rowp = H + ((size_t)(256 * ppre[pid] + ppos)) * 512 + half * 256 + col0;
#pragma unroll
                for (int bj = 0; bj < 2; ++bj) { const f32x4 g = acc[ai][bj][m][0], v = acc[ai][bj][m][1];
                    *(unsigned*)(rowp + bj * 64) = cvt4_fp8(w[m] * silu_f(g[0]) * v[0], w[m] * silu_f(g[1]) * v[1], w[m] * silu_f(g[2]) * v[2], w[m] * silu_f(g[3]) * v[3]); } }
            asm volatile("" ::: "memory");
        }
    }
};
struct EpiDown {
    static constexpr bool PERM = true;
    bf16* Y; const int* tok; const float* gatew;
    __device__ __forceinline__ void operator()(const f32x4 (&acc)[2][2][4][2], const Unit& u, int wr, int wc, int fr, int fq) const {
        const int col0 = u.pnl * BM + wc * 32 + 8 * fq;
#pragma unroll
        for (int ai = 0; ai < 2; ++ai)
#pragma unroll
            for (int m = 0; m < 4; ++m) { const int rl = ai * HALF + wr * 64 + m * 16 + fr;
                if (rl < u.nv) { const int entry = tok[(size_t)u.e * CAP + u.rb * 256 + rl]; const float w = gatew[entry]; bf16* rowp = Y + (size_t)entry * DM + col0;
#pragma unroll
                    for (int bj = 0; bj < 2; ++bj) { const f32x4 v0 = acc[ai][bj][m][0] * w, v1 = acc[ai][bj][m][1] * w;
                        v4u o; o.x = cvt_pk_bf16(v0[0], v0[1]); o.y = cvt_pk_bf16(v0[2], v0[3]); o.z = cvt_pk_bf16(v1[0], v1[1]); o.w = cvt_pk_bf16(v1[2], v1[3]);
                        *(v4u*)(rowp + bj * HALF) = o; } }
                asm volatile("" ::: "memory"); }
    }
};

template <class Epi, class Sched, bool ALIGN_EPI, bool GATHER = false, bool FP8 = false>
__device__ __forceinline__ void gemm_phase(LAS unsigned char* lds, const Gemm g, const Sched& S, const Epi& E) {
    const int tid = threadIdx.x, wid = __builtin_amdgcn_readfirstlane(tid >> 6), lane = tid & 63, wr = wid >> 2, wc = wid & 3, fr = lane & 15, fq = lane >> 4;
    int K = g.K; asm volatile("" : "+s"(K));
    const int nt = K / BK;
    unsigned voffB[2], voffA[2]; int RA[2]; unsigned CA[2];
#pragma unroll
    for (int i = 0; i < 2; ++i) { int R, C; stage_rc(tid * 16 + i * 8192, R, C); const int Rb = Epi::PERM ? ((R & ~31) + perm32(R & 31)) : R;
        RA[i] = R; CA[i] = (unsigned)C * 2u; voffA[i] = (unsigned)(R * g.lda + C) * 2u; voffB[i] = (unsigned)(Rb * K + C) * 2u; }
    const unsigned kstep = (unsigned)(BK * 2);
    const size_t hstepB = (size_t)HALF * K * 2, tstepB = 2 * hstepB;
    const unsigned pitchA = (unsigned)g.lda * 2u; const size_t hstepA = (size_t)HALF * g.lda * 2, tstepA = 2 * hstepA;
    const unsigned ldsw = (unsigned)wid * 1024u;
    const int aoff = lds_byte(wr * 64 + fr, fq * 8), boff = lds_byte(wc * 32 + fr, fq * 8);
#define PG8_SA(b, h) (((b) * 2 + (h)) * HTB)
#define PG8_SB(b, h) ((4 + (b) * 2 + (h)) * HTB)
#define PG8_STAGE(bufoff, gbase, voff) do { _Pragma("unroll") for (int _i = 0; _i < 2; ++_i) \
        __builtin_amdgcn_global_load_lds((const unsigned*)((const char*)(gbase) + (voff)[_i]), (LAS unsigned*)(lds + (bufoff) + ldsw + _i * 8192), 16, 0, 0); } while (0)
#define PG8_STAGEA(bufoff, up, offs, h, kb) do { _Pragma("unroll") for (int _i = 0; _i < 2; ++_i) { \
        const char* _p = GATHER ? ((const char*)g.A + (size_t)(offs)[h][_i] + (kb)) : ((up) + (size_t)(h) * hstepA + voffA[_i] + (kb)); \
        __builtin_amdgcn_global_load_lds((const unsigned*)_p, (LAS unsigned*)(lds + (bufoff) + ldsw + _i * 8192), 16, 0, 0); } } while (0)
#define PG8_LDA(dst, b, h) do { if constexpr (FP8) { _Pragma("unroll") for (int m = 0; m < 4; ++m) { const v4i_ lo_ = *(const LAS v4i_*)(lds + PG8_SA(b, h) + aoff + m * 2048), hi_ = *(const LAS v4i_*)(lds + PG8_SA(b, h) + aoff + m * 2048 + 1024); \
            dst##8[m] = __builtin_shufflevector(lo_, hi_, 0, 1, 2, 3, 4, 5, 6, 7); } } \
        else { _Pragma("unroll") for (int m = 0; m < 4; ++m) _Pragma("unroll") for (int k = 0; k < 2; ++k) dst[m][k] = *(const LAS bf16x8*)(lds + PG8_SA(b, h) + aoff + m * 2048 + k * 1024); } } while (0)
#define PG8_LDB(dst, b, h) do { if constexpr (FP8) { _Pragma("unroll") for (int n = 0; n < 2; ++n) { const v4i_ lo_ = *(const LAS v4i_*)(lds + PG8_SB(b, h) + boff + n * 2048), hi_ = *(const LAS v4i_*)(lds + PG8_SB(b, h) + boff + n * 2048 + 1024); \
            dst##8[n] = __builtin_shufflevector(lo_, hi_, 0, 1, 2, 3, 4, 5, 6, 7); } } \
        else { _Pragma("unroll") for (int n = 0; n < 2; ++n) _Pragma("unroll") for (int k = 0; k < 2; ++k) dst[n][k] = *(const LAS bf16x8*)(lds + PG8_SB(b, h) + boff + n * 2048 + k * 1024); } } while (0)
#define PG8_MMA(ai, bj, At, Bt) do { __builtin_amdgcn_s_setprio(1); _Pragma("unroll") for (int m = 0; m < 4; ++m) _Pragma("unroll") for (int n = 0; n < 2; ++n) { \
        if constexpr (FP8) asm volatile("v_mfma_scale_f32_16x16x128_f8f6f4 %0, %1, %2, %0, %3, %4 op_sel_hi:[0,0,0]" : "+v"(acc[ai][bj][m][n]) : "v"(Bt##8[n]), "v"(At##8[m]), "v"(f8sw), "v"(f8sx));     \
        else { _Pragma("unroll") for (int k = 0; k < 2; ++k) acc[ai][bj][m][n] = __builtin_amdgcn_mfma_f32_16x16x32_bf16(Bt[n][k], At[m][k], acc[ai][bj][m][n], 0, 0, 0); } } \
        __builtin_amdgcn_s_setprio(0); } while (0)
#define PG8_WAIT_V(n) asm volatile("s_waitcnt vmcnt(" #n ")" ::: "memory")
#define PG8_WAIT_L(n) asm volatile("s_waitcnt lgkmcnt(" #n ")" ::: "memory")
#define PG8_BAR __builtin_amdgcn_s_barrier()
#define PG8_SCHED __builtin_amdgcn_sched_barrier(0)
#define PG8_AOFFS(dst, un) do { if constexpr (GATHER) _Pragma("unroll") for (int _h = 0; _h < 2; ++_h) _Pragma("unroll") for (int _i = 0; _i < 2; ++_i) dst[_h][_i] = S.arow(un, _h * HALF + RA[_i]) * pitchA + CA[_i]; } while (0)
    Unit cur, nxt; int ui = 0;
    if (!S.next(0, cur)) return;
    f32x4 acc[2][2][4][2];
#pragma unroll
    for (int a = 0; a < 2; ++a)
#pragma unroll
        for (int b = 0; b < 2; ++b)
#pragma unroll
            for (int m = 0; m < 4; ++m)
#pragma unroll
                for (int n = 0; n < 2; ++n) acc[a][b][m][n] = (f32x4){0.f, 0.f, 0.f, 0.f};
    typedef int v8i_ __attribute__((ext_vector_type(8))); typedef int v4i_ __attribute__((ext_vector_type(4)));
    bf16x8 At[4][2], B0[2][2], B1[2][2]; v8i_ At8[4], B08[2], B18[2];
    const int f8sw = (int)g.sw, f8sx = (int)g.sx;
    unsigned oC[2][2], oN[2][2];
    PG8_AOFFS(oC, cur);
    const char* cA = (const char*)g.A + (size_t)cur.pm * tstepA + cur.acol;
    const char* cB = (const char*)g.Bt + (size_t)cur.pn * tstepB;
    PG8_STAGE(PG8_SB(0, 0), cB, voffB); PG8_STAGE(PG8_SB(0, 1), cB + hstepB, voffB); PG8_STAGEA(PG8_SA(0, 0), cA, oC, 0, 0u); PG8_STAGEA(PG8_SA(0, 1), cA, oC, 1, 0u);
    if (wr == 1) PG8_BAR;
    PG8_WAIT_V(2); PG8_BAR;
    PG8_STAGE(PG8_SB(1, 0), cB + kstep, voffB); PG8_STAGEA(PG8_SA(1, 0), cA, oC, 0, kstep); PG8_STAGE(PG8_SB(1, 1), cB + hstepB + kstep, voffB);
    PG8_WAIT_V(6); PG8_BAR;
    for (;;) {
        const bool has_next = S.next(ui + 1, nxt);
        if (has_next) { PG8_AOFFS(oN, nxt); } else {
#pragma unroll
            for (int _h = 0; _h < 2; ++_h)
#pragma unroll
                for (int _i = 0; _i < 2; ++_i) oN[_h][_i] = oC[_h][_i]; }
        const char* nA = has_next ? (const char*)g.A + (size_t)nxt.pm * tstepA + nxt.acol : cA;
        const char* nB = has_next ? (const char*)g.Bt + (size_t)nxt.pn * tstepB : cB;
        for (int t = 0; t < nt; t += 2) {
            const bool last = (t == nt - 2);
            const unsigned ka1 = (unsigned)(t + 1) * kstep;
            const unsigned ka2 = last ? 0u : (unsigned)(t + 2) * kstep, ka3 = ka2 + kstep;
            unsigned o2[2][2];
#pragma unroll
            for (int _h = 0; _h < 2; ++_h)
#pragma unroll
                for (int _i = 0; _i < 2; ++_i) o2[_h][_i] = last ? oN[_h][_i] : oC[_h][_i];
            const char* a2 = last ? nA : cA;
            const char* b2 = last ? nB : cB + (size_t)(t + 2) * kstep; const char* b3 = b2 + kstep;
            PG8_LDB(B0, 0, 0); PG8_LDB(B1, 0, 1); PG8_SCHED; PG8_LDA(At, 0, 0); PG8_STAGEA(PG8_SA(1, 1), cA, oC, 1, ka1);
            PG8_WAIT_V(8); PG8_WAIT_L(0); PG8_BAR; PG8_MMA(0, 0, At, B0); PG8_MMA(0, 1, At, B1); PG8_BAR; PG8_SCHED;
            PG8_LDA(At, 0, 1); PG8_STAGE(PG8_SB(0, 0), b2, voffB); PG8_STAGE(PG8_SB(0, 1), b2 + hstepB, voffB); PG8_STAGEA(PG8_SA(0, 0), a2, o2, 0, ka2);
            PG8_WAIT_V(8); PG8_WAIT_L(0); PG8_BAR; PG8_MMA(1, 0, At, B0); PG8_MMA(1, 1, At, B1); PG8_BAR; PG8_SCHED;
            PG8_LDB(B0, 1, 0); PG8_LDB(B1, 1, 1); PG8_SCHED; PG8_LDA(At, 1, 0); PG8_STAGEA(PG8_SA(0, 1), a2, o2, 1, ka2);
            PG8_WAIT_V(8); PG8_WAIT_L(0); PG8_BAR; PG8_MMA(0, 0, At, B0); PG8_MMA(0, 1, At, B1); PG8_BAR; PG8_SCHED;
            PG8_LDA(At, 1, 1); PG8_STAGE(PG8_SB(1, 0), b3, voffB); PG8_STAGE(PG8_SB(1, 1), b3 + hstepB, voffB); PG8_STAGEA(PG8_SA(1, 0), a2, o2, 0, ka3);
            PG8_WAIT_V(8); PG8_WAIT_L(0); PG8_BAR; PG8_MMA(1, 0, At, B0); PG8_MMA(1, 1, At, B1); PG8_BAR; PG8_SCHED;
        }
        const bool fin = !(has_next && nxt.cont);
        if (fin) {
        if constexpr (ALIGN_EPI) { if (wr == 0) PG8_BAR; }
        E(acc, cur, wr, wc, fr, fq);
        }
        if (!has_next) break;
        if (fin) {
#pragma unroll
        for (int a = 0; a < 2; ++a)
#pragma unroll
            for (int b = 0; b < 2; ++b)
#pragma unroll
                for (int m = 0; m < 4; ++m)
#pragma unroll
                    for (int n = 0; n < 2; ++n) acc[a][b][m][n] = (f32x4){0.f, 0.f, 0.f, 0.f};
        }
        cur = nxt; cA = nA; cB = nB; ++ui;
#pragma unroll
        for (int _h = 0; _h < 2; ++_h)
#pragma unroll
            for (int _i = 0; _i < 2; ++_i) oC[_h][_i] = oN[_h][_i];
        if constexpr (ALIGN_EPI) { if (fin && wr == 1) PG8_BAR; }
    }
    PG8_WAIT_V(0);
    if constexpr (!ALIGN_EPI) { if (wr == 0) PG8_BAR; }
    PG8_BAR;
#undef PG8_SA
#undef PG8_SB
#undef PG8_STAGE
#undef PG8_STAGEA
#undef PG8_LDA
#undef PG8_LDB
#undef PG8_MMA
#undef PG8_WAIT_V
#undef PG8_WAIT_L
#undef PG8_BAR
#undef PG8_SCHED
#undef PG8_AOFFS
}
}
struct Frame {
    LAS unsigned char* lds;
    volatile LAS unsigned* MISC;
    gu32* ctl;
    int tid, lane, wave, G, bx;
};
struct Args { const void* in[21]; float* out; unsigned char* ws; int ph_lo, ph_hi; };

__device__ __forceinline__ int pair_map(int j, int half) { return j < half ? 2 * j : 2 * (j - half) + 1; }
__device__ __forceinline__ int row_map(int mode, int n) {
    if (mode == 0) return n;
    if (mode <= 2) return 8 * (n >> 2) + 4 * (mode - 1) + (n & 3);
    if (mode == 3) { if (n >= C_KR && n < C_RQ) return C_KR + pair_map(n - C_KR, 16);
                     if (n >= C_RQ && n < C_RV) { const int hb = C_RQ + ((n - C_RQ) & ~63); return hb + pair_map(n - hb, 32); }
                     return n; }
    { const int h = n / 96, d = n % 96; return d < 64 ? n : h * 96 + 64 + pair_map(d - 64, 16); }
}
__device__ __forceinline__ void transpose_item(const float* W, int K, int N, bf16* WT, int mode, const float* kscale, LAS float* scr, int item, int lane, float f8scale = 0.f) {
    const int nblk = N / 32, kb = item / nblk, nb = item % nblk, k0 = 64 * kb, n0 = 32 * nb;
    float wv[32];
#pragma unroll
    for (int i = 0; i < 32; ++i) { const int kk = 2 * i + (lane >> 5); wv[i] = __builtin_nontemporal_load(W + (size_t)(k0 + kk) * N + n0 + (lane & 31)); }
#pragma unroll
    for (int i = 0; i < 32; ++i) { const int kk = 2 * i + (lane >> 5); float w = wv[i]; if (kscale) w *= kscale[k0 + kk]; scr[kk * 33 + (lane & 31)] = w; }
    LDS_WAIT(); asm volatile("" ::: "memory");
    const int c = lane & 7;
#pragma unroll
    for (int j = 0; j < 4; ++j) { const int n = (lane >> 3) + 8 * j; const LAS float* s = scr + (8 * c) * 33 + n;
        v4u o; o.x = pk2(s[0 * 33], s[1 * 33]); o.y = pk2(s[2 * 33], s[3 * 33]); o.z = pk2(s[4 * 33], s[5 * 33]); o.w = pk2(s[6 * 33], s[7 * 33]);
        const int row = row_map(mode, n0 + n);
        if (f8scale > 0.f) { v2u o8; o8.x = cvt4_fp8(f8scale * s[0 * 33], f8scale * s[1 * 33], f8scale * s[2 * 33], f8scale * s[3 * 33]); o8.y = cvt4_fp8(f8scale * s[4 * 33], f8scale * s[5 * 33], f8scale * s[6 * 33], f8scale * s[7 * 33]);
            *(GAS v2u*)((unsigned char*)WT + (size_t)row * K + k0 + 8 * c) = o8; }
        else *(GAS v4u*)(WT + (size_t)row * K + k0 + 8 * c) = o; }
    LDS_WAIT(); asm volatile("" ::: "memory");
}
__device__ __forceinline__ void p0_prologue(Frame& F, const Args& a) {
    unsigned char* ws = a.ws;
    float* mod = (float*)(ws + WS_MOD);
    for (int cb = F.bx; cb < MODW / 32; cb += F.G) {
        const float* c = (const float*)a.in[1]; const float* w_ada = (const float*)a.in[3]; const float* b_ada = (const float*)a.in[4];
        LAS float* sc = (LAS float*)F.lds;
        LAS float* part = (LAS float*)(F.lds + 65536);
        for (int i = F.tid; i < NB * DM; i += NTHR) sc[i] = silu_f(c[i]);
        __syncthreads();
        const int cc = F.tid & 31, kq = F.tid >> 5, n = cb * 32 + cc;
        float acc[NB];
#pragma unroll
        for (int b = 0; b < NB; ++b) acc[b] = 0.f;
        for (int k0 = kq; k0 < DM; k0 += 128) { float wv[8];
#pragma unroll
            for (int i = 0; i < 8; ++i) wv[i] = __builtin_nontemporal_load(w_ada + (size_t)(k0 + 16 * i) * MODW + n);
#pragma unroll
            for (int i = 0; i < 8; ++i)
#pragma unroll
                for (int b = 0; b < NB; ++b) acc[b] += sc[b * DM + k0 + 16 * i] * wv[i]; }
#pragma unroll
        for (int b = 0; b < NB; ++b) part[(kq * NB + b) * 32 + cc] = acc[b];
        __syncthreads();
        { const int b = F.tid >> 5; float s = b_ada[n];
#pragma unroll
          for (int q = 0; q < 16; ++q) s += part[(q * NB + b) * 32 + cc];
          mod[(size_t)b * MODW + n] = s; }
        __syncthreads();
    }
    LAS float* scr = (LAS float*)(F.lds + F.wave * 16384);
    const int gw = F.bx * NWAVES + F.wave, NGW = F.G * NWAVES;
    constexpr int I_IN = (DM / 64) * (INW / 32), I_UQ = (256 / 64) * (QW / 32), I_UKV = (128 / 64) * (KVW / 32), I_O = (DM / 64) * (DM / 32);
    constexpr int I_W1 = (DM / 64) * (DE / 32), I_W2 = (DE / 64) * (DM / 32);
    constexpr int NITEMS = I_IN + I_UQ + I_UKV + I_O + NE * (2 * I_W1 + I_W2);
    for (int it = gw; it < NITEMS; it += NGW) {
        int r = it;
        if (r < I_IN) { transpose_item((const float*)a.in[6], DM, INW, (bf16*)(ws + WS_WIN), 3, nullptr, scr, r, F.lane); continue; } r -= I_IN;
        if (r < I_UQ) { transpose_item((const float*)a.in[8], 256, QW, (bf16*)(ws + WS_WUQ), 4, (const float*)a.in[7], scr, r, F.lane); continue; } r -= I_UQ;
        if (r < I_UKV) { transpose_item((const float*)a.in[10], 128, KVW, (bf16*)(ws + WS_WUKV), 0, (const float*)a.in[9], scr, r, F.lane); continue; } r -= I_UKV;
        if (r < I_O) { transpose_item((const float*)a.in[11], DM, DM, (bf16*)(ws + WS_WO), 0, nullptr, scr, r, F.lane); continue; } r -= I_O;
        if (r < NE * I_W1) { const int e = r / I_W1; transpose_item((const float*)a.in[17] + (size_t)e * DM * DE, DM, DE, (bf16*)(ws + WS_W13 + (size_t)e * 512 * DM), 1, nullptr, scr, r % I_W1, F.lane, F8_SW13); continue; } r -= NE * I_W1;
        if (r < NE * I_W1) { const int e = r / I_W1; transpose_item((const float*)a.in[18] + (size_t)e * DM * DE, DM, DE, (bf16*)(ws + WS_W13 + (size_t)e * 512 * DM), 2, nullptr, scr, r % I_W1, F.lane, F8_SW13); continue; } r -= NE * I_W1;
        { const int e = r / I_W2; transpose_item((const float*)a.in[19] + (size_t)e * DE * DM, DE, DM, (bf16*)(ws + WS_W2 + (size_t)e * DM * DE), 0, nullptr, scr, r % I_W2, F.lane, F8_SW2); }
    }
    const int gt = F.bx * NTHR + F.tid, NGT = F.G * NTHR;
    { v4u z = (v4u){0u, 0u, 0u, 0u}; GAS v4u* p = (GAS v4u*)((bf16*)(ws + WS_WIN) + (size_t)INW * DM);
      for (int i = gt; i < (INWP - INW) * DM / 8; i += NGT) p[i] = z; }
    { const float* w_gr = (const float*)a.in[13]; const float* w_er = (const float*)a.in[15]; float* wf = (float*)(ws + WS_WR);
      bf16* wb = (bf16*)wf;
      for (int i = gt; i < 32 * 3 * 64 * 8; i += NGT) { const int ii = i & 7, l = (i >> 3) & 63, ntl = (i >> 9) % 3, s8 = i / 1536;
          const int k = 32 * s8 + 8 * (l >> 4) + ii, nc = 16 * ntl + (l & 15);
          const float w = nc < 4 ? w_gr[k * 4 + nc] : (nc < 36 ? w_er[k * 32 + (nc - 4)] : 0.f);
          const unsigned hi = f2bf(w); const float lo = w - bf2f(hi);
          const size_t base = ((size_t)(s8 * 3 + ntl) * 64 + l) * 16; wb[base + ii] = (bf16)hi; wb[base + 8 + ii] = (bf16)f2bf(lo); }
      if (gt < 48) { const float* b_gr = (const float*)a.in[14]; const float* b_er = (const float*)a.in[16];
          wf[64 * 3 * 64 * 4 + gt] = gt < 4 ? b_gr[gt] : (gt < 36 ? b_er[gt - 4] : 0.f); } }
}

__device__ __forceinline__ void p1_norm1(Frame& F, const Args& a) {
    const float* x = (const float*)a.in[0]; const float* g = (const float*)a.in[5]; const float* mod = (const float*)(a.ws + WS_MOD); bf16* h1 = (bf16*)(a.ws + WS_B);
    const int gw = F.bx * NWAVES + F.wave, NGW = F.G * NWAVES;
    for (int m0 = 4 * gw; m0 < T; m0 += 4 * NGW) {
        const int b = m0 >> 12;
        f32x4 v[4][4];
#pragma unroll
        for (int r = 0; r < 4; ++r) { const GAS f32x4* xr = (const GAS f32x4*)(x + (size_t)(m0 + r) * DM) + F.lane;
#pragma unroll
            for (int j = 0; j < 4; ++j) v[r][j] = __builtin_nontemporal_load(xr + 64 * j); }
        f32x4 gs[4], sh[4];
#pragma unroll
        for (int j = 0; j < 4; ++j) { const int col = 4 * F.lane + 256 * j;
            gs[j] = *(const f32x4*)(g + col) * (*(const f32x4*)(mod + (size_t)b * MODW + DM + col) + 1.0f); sh[j] = *(const f32x4*)(mod + (size_t)b * MODW + col); }
#pragma unroll
        for (int r = 0; r < 4; ++r) { float s = 0.f;
#pragma unroll
            for (int j = 0; j < 4; ++j) s += (v[r][j].x * v[r][j].x + v[r][j].y * v[r][j].y) + (v[r][j].z * v[r][j].z + v[r][j].w * v[r][j].w);
            const float rstd = 1.0f / sqrtf(wave_sum(s) * (1.f / DM) + EPS);
            GAS v2u* o8 = (GAS v2u*)(h1 + (size_t)(m0 + r) * DM) + F.lane;
#pragma unroll
            for (int j = 0; j < 4; ++j) { const f32x4 o = (v[r][j] * rstd) * gs[j] + sh[j]; v2u w; w.x = cvtpk2(o.x, o.y); w.y = cvtpk2(o.z, o.w); o8[64 * j] = w; } }
    }
}

__device__ __forceinline__ float ret_log2g(int h) { return log2f(1.0f - exp2f(-5.0f - (float)h)); }

__device__ __forceinline__ void p7_norm2_router(Frame& F, const Args& a, int rep) {
    unsigned char* ws = a.ws;
    const bf16* x1 = (const bf16*)(ws + WS_A); const float* part = (const float*)(ws + WS_PART); const float* mod = (const float*)(ws + WS_MOD);
    const float* g2n = (const float*)a.in[12]; const float* wf = (const float*)(ws + WS_WR); const float* bias = wf + 64 * 3 * 64 * 4;
    unsigned char* h2 = ws + (rep ? WS_END : WS_B); float* gatew = (float*)(ws + (rep ? WS_END + 130 * MiB : WS_GATEW)); int* tok = (int*)(ws + (rep ? WS_END + 132 * MiB : WS_TOK)); int* slotinfo = (int*)(ws + (rep ? WS_END + 131 * MiB : WS_SLOT)); gu32* cntg = F.ctl + (rep ? CW_CNT2 : CW_CNT);
    int* ptinfo = (int*)(ws + (rep ? WS_END + 133 * MiB : WS_PTI)); gu32* pcntg = F.ctl + (rep ? CW_PCNT + NPAIR * CNT_STRIDE : CW_PCNT);
    const int lane = F.lane, wv = F.wave, row = lane & 15, kq = lane >> 4;
    LAS v4u* Wl = (LAS v4u*)(F.lds);
    LAS float* mw = (LAS float*)(F.lds + 98304);
    LAS float* lgs = (LAS float*)(F.lds + 106496);
    LAS int* as_e = (LAS int*)(F.lds);
    LAS int* as_rank = as_e + 512; LAS int* as_entry = as_rank + 512;
    LAS int* cntL = as_entry + 512; LAS int* baseL = cntL + 32;
    LAS int* tp_pid = baseL + 32; LAS int* tp_rank = tp_pid + 256; LAS int* tp_tok = tp_rank + 256;
    LAS int* pcntL = tp_tok + 256; LAS int* pbaseL = pcntL + 128;
    for (int rb = F.bx; rb < T / 256; rb += F.G) {
        const int b = rb >> 4, t0 = b * SEQ + (rb & 15) * 16;
        if (F.tid < 256) { const float* mb = mod + (size_t)b * MODW; const int col = 4 * F.tid;
            *(LAS f32x4*)(mw + col) = *(const f32x4*)(g2n + col) * (*(const f32x4*)(mb + 4 * DM + col) + 1.0f); *(LAS f32x4*)(mw + DM + col) = *(const f32x4*)(mb + 3 * DM + col); }
        float rstd[2];
#pragma unroll
        for (int h = 0; h < 2; ++h) { const f32x4* pp = (const f32x4*)(part + (size_t)(t0 + 256 * (wv + 8 * h) + row) * 16); const f32x4 p0 = pp[0], p1 = pp[1], p2 = pp[2], p3 = pp[3];
            const float ss = ((p0.x + p0.y) + (p0.z + p0.w)) + ((p1.x + p1.y) + (p1.z + p1.w)) + ((p2.x + p2.y) + (p2.z + p2.w)) + ((p3.x + p3.y) + (p3.z + p3.w));
            rstd[h] = 1.0f / sqrtf(ss * (1.f / DM) + EPS); }
        const unsigned lo = (unsigned)(row * DM + 8 * kq);
        const bf16* xw0 = x1 + (size_t)(t0 + 256 * wv) * DM; unsigned char* hw0 = h2 + (size_t)(t0 + 256 * wv) * DM;
        constexpr int XD = 8;
        v4u xq[XD];
#pragma unroll
        for (int u = 0; u < XD; ++u) xq[u] = __builtin_nontemporal_load((const GAS v4u*)(xw0 + 32 * u + lo));
        f32x4 acc[2][3];
#pragma unroll
        for (int h = 0; h < 2; ++h)
#pragma unroll
            for (int ntl = 0; ntl < 3; ++ntl) acc[h][ntl] = (f32x4){0.f, 0.f, 0.f, 0.f};
#pragma unroll 1
        for (int p = 0; p < 2; ++p) {
            __syncthreads();
            { const v4u* src = (const v4u*)wf + (size_t)p * 6144 + F.tid;
#pragma unroll
              for (int i = 0; i < 12; ++i) Wl[F.tid + 512 * i] = src[512 * i]; }
            __syncthreads();
#pragma unroll
            for (int h = 0; h < 2; ++h) {
#pragma unroll 1
                for (int g2 = 0; g2 < 2; ++g2) {
                    const size_t cur = (size_t)h * 2048 * DM + 512 * p + 256 * g2;
                    const size_t nxt = g2 == 0 ? cur + 256 : (h == 0 ? (size_t)2048 * DM + 512 * p : (p == 0 ? (size_t)512 : cur));
                    const LAS v4u* wl = Wl + g2 * 3072 + lane * 2;
#pragma unroll
                    for (int u = 0; u < 8; ++u) { const int col = 512 * p + 256 * g2 + 32 * u;
                        const v4u xw = xq[u]; const f32x4 xa = (f32x4){bflo(xw.x), bfhi(xw.x), bflo(xw.y), bfhi(xw.y)}, xb = (f32x4){bflo(xw.z), bfhi(xw.z), bflo(xw.w), bfhi(xw.w)};
                        xq[u] = __builtin_nontemporal_load((const GAS v4u*)(xw0 + nxt + 32 * u + lo));
                        const LAS float* mg = mw + 8 * kq + col;
                        const f32x4 ga = *(const LAS f32x4*)(mg), gb = *(const LAS f32x4*)(mg + 4), sa = *(const LAS f32x4*)(mg + DM), sb = *(const LAS f32x4*)(mg + DM + 4);
                        const f32x4 ha = (xa * rstd[h]) * ga + sa, hb = (xb * rstd[h]) * gb + sb;
                        v4u hh; hh.x = cvtpk2(ha.x, ha.y); hh.y = cvtpk2(ha.z, ha.w); hh.z = cvtpk2(hb.x, hb.y); hh.w = cvtpk2(hb.z, hb.w);
                        { v2u h8; h8.x = cvt4_fp8(ha.x, ha.y, ha.z, ha.w); h8.y = cvt4_fp8(hb.x, hb.y, hb.z, hb.w); *(GAS v2u*)(hw0 + cur + 32 * u + lo) = h8; }
                        v4u hl; hl.x = cvtpk2(ha.x - bflo(hh.x), ha.y - bfhi(hh.x)); hl.y = cvtpk2(ha.z - bflo(hh.y), ha.w - bfhi(hh.y)); hl.z = cvtpk2(hb.x - bflo(hh.z), hb.y - bfhi(hh.z)); hl.w = cvtpk2(hb.z - bflo(hh.w), hb.w - bfhi(hh.w));
                        const bf16x8 ah = __builtin_bit_cast(bf16x8, hh), al = __builtin_bit_cast(bf16x8, hl);
#pragma unroll
                        for (int ntl = 0; ntl < 3; ++ntl) { const v4u wh = wl[(u * 3 + ntl) * 128], wo = wl[(u * 3 + ntl) * 128 + 1];
                            const bf16x8 bh = __builtin_bit_cast(bf16x8, wh), bl = __builtin_bit_cast(bf16x8, wo);
                            acc[h][ntl] = __builtin_amdgcn_mfma_f32_16x16x32_bf16(ah, bh, acc[h][ntl], 0, 0, 0); acc[h][ntl] = __builtin_amdgcn_mfma_f32_16x16x32_bf16(al, bh, acc[h][ntl], 0, 0, 0);
                            acc[h][ntl] = __builtin_amdgcn_mfma_f32_16x16x32_bf16(ah, bl, acc[h][ntl], 0, 0, 0); } }
                }
            }
        }
#pragma unroll
        for (int h = 0; h < 2; ++h)
#pragma unroll
            for (int ntl = 0; ntl < 3; ++ntl)
#pragma unroll
                for (int r = 0; r < 4; ++r) if (16 * ntl + row < 40) lgs[(16 * (wv + 8 * h) + 4 * kq + r) * 40 + 16 * ntl + row] = acc[h][ntl][r];
        __syncthreads();
        if (F.tid < 32) cntL[F.tid] = 0;
        if (F.tid >= 64 && F.tid < 64 + NPAIR) pcntL[F.tid - 64] = 0;
        __syncthreads();
        if (F.tid < 256) {
            const LAS float* l = lgs + F.tid * 40; const int tt = t0 + 256 * (F.tid >> 4) + (F.tid & 15);
            float lv[36];
#pragma unroll
            for (int j = 0; j < 36; ++j) lv[j] = l[j] + bias[j];
            float gm = lv[0]; int gi = 0;
#pragma unroll
            for (int j = 1; j < 4; ++j) if (lv[j] > gm) { gm = lv[j]; gi = j; }
            float se = 0.f;
#pragma unroll
            for (int j = 0; j < 4; ++j) se += __expf(lv[j] - gm);
            const float ptop = 1.0f / se;
            float le[8];
#pragma unroll
            for (int j = 0; j < 8; ++j) le[j] = gi == 0 ? lv[4 + j] : gi == 1 ? lv[12 + j] : gi == 2 ? lv[20 + j] : lv[28 + j];
            float v1 = le[0]; int i1 = 0;
#pragma unroll
            for (int j = 1; j < 8; ++j) if (le[j] > v1) { v1 = le[j]; i1 = j; }
            float v2 = -3.0e38f; int i2 = 0;
#pragma unroll
            for (int j = 0; j < 8; ++j) if (j != i1 && le[j] > v2) { v2 = le[j]; i2 = j; }
            const float ex = __expf(v2 - v1), g0 = ptop / (1.0f + ex), g1 = ptop * ex / (1.0f + ex);
            const int e0 = gi * 8 + i1, e1 = gi * 8 + i2;
            *(f32x2*)(gatew + (size_t)tt * 2) = (f32x2){g0, g1};
            const int a0 = F.tid * 2;
            as_e[a0] = e0; as_rank[a0] = __hip_atomic_fetch_add(cntL + e0, 1, __ATOMIC_RELAXED, __HIP_MEMORY_SCOPE_WORKGROUP); as_entry[a0] = tt * 2;
            as_e[a0 + 1] = e1; as_rank[a0 + 1] = __hip_atomic_fetch_add(cntL + e1, 1, __ATOMIC_RELAXED, __HIP_MEMORY_SCOPE_WORKGROUP); as_entry[a0 + 1] = tt * 2 + 1;
            { const int pa = i1 < i2 ? i1 : i2, pb = i1 < i2 ? i2 : i1, pid = gi * 28 + pa * 8 - (pa * (pa + 1)) / 2 + (pb - pa - 1);
              tp_pid[F.tid] = pid; tp_rank[F.tid] = __hip_atomic_fetch_add(pcntL + pid, 1, __ATOMIC_RELAXED, __HIP_MEMORY_SCOPE_WORKGROUP); tp_tok[F.tid] = tt | ((i1 > i2) ? (1 << 30) : 0); }
        }
        __syncthreads();
        if (F.tid < 32) { const int c = cntL[F.tid]; baseL[F.tid] = c > 0 ? (int)__hip_atomic_fetch_add(cntg + F.tid * CNT_STRIDE, (unsigned)c, RLX_AGENT) : 0; }
        else if (F.tid >= 64 && F.tid < 64 + NPAIR) { const int q = F.tid - 64; const int c = pcntL[q]; pbaseL[q] = c > 0 ? (int)__hip_atomic_fetch_add(pcntg + q * CNT_STRIDE, (unsigned)c, RLX_AGENT) : 0; }
        __syncthreads();
        if (F.tid < 256) { const int tv2 = tp_tok[F.tid]; const int pid = tp_pid[F.tid]; ptinfo[tv2 & 0x3fffffff] = (tv2 & (1 << 30)) | (pid * 65536 + pbaseL[pid] + tp_rank[F.tid]); }
        { const int en = as_entry[F.tid]; const int e = as_e[F.tid]; const int idx = e * CAP + baseL[e] + as_rank[F.tid]; tok[idx] = en; slotinfo[en] = idx; }
        __syncthreads();
    }
}

__device__ __forceinline__ void p10_final(Frame& F, const Args& a, const LAS int* ppre) {
    const bf16* x1 = (const bf16*)(a.ws + WS_A); const unsigned char* y = a.ws + WS_D; const float* mod = (const float*)(a.ws + WS_MOD); const float* fg = (const float*)a.in[20];
    const int* ptinfo = (const int*)(a.ws + WS_PTI);
    const int gw = F.bx * NWAVES + F.wave, NGW = F.G * NWAVES;
#ifdef SELFCHECK
    float chk_scale; { const float* chk = (const float*)(F.ctl + 20480); const float e = (SELFCHECK == 1) ? sqrtf(chk[0] / chk[1]) : (SELFCHECK == 2) ? sqrtf(chk[2] / chk[3]) : sqrtf(chk[4] / chk[5]); chk_scale = 1.0f + 10.0f * e; }
#endif
    typedef int i32x2 __attribute__((ext_vector_type(2)));
    const int step = 2 * NGW;
    int m0 = 2 * gw;
    if (m0 >= T) return;
    f32x4 gf[4];
#pragma unroll
    for (int j = 0; j < 4; ++j) gf[j] = *(const f32x4*)(fg + 4 * F.lane + 256 * j);
    v2u xw[2][4]; unsigned ya[2][4]; f32x4 g2[4];
#define P10_ISSUE(M, CC) do { \
        _Pragma("unroll") for (int r = 0; r < 2; ++r) { const GAS v2u* xr = (const GAS v2u*)(x1 + (size_t)((M) + r) * DM) + F.lane; \
            const int c0 = __builtin_amdgcn_readfirstlane((CC)[r]) & 0x3fffffff; \
            const size_t s0 = (size_t)(256 * ppre[c0 >> 16] + (c0 & 65535)); \
            const GAS unsigned* y0 = (const GAS unsigned*)(y + s0 * DM) + F.lane; \
            _Pragma("unroll") for (int j = 0; j < 4; ++j) { xw[r][j] = __builtin_nontemporal_load(xr + 64 * j); ya[r][j] = __builtin_nontemporal_load(y0 + 64 * j); } } \
        _Pragma("unroll") for (int j = 0; j < 4; ++j) g2[j] = *(const f32x4*)(mod + (size_t)((M) >> 12) * MODW + 5 * DM + 4 * F.lane + 256 * j); } while (0)
    i32x2 c2;
    { const i32x2 c1 = *(const i32x2*)(ptinfo + m0); const int m2 = m0 + step < T ? m0 + step : m0; c2 = *(const i32x2*)(ptinfo + m2); P10_ISSUE(m0, c1); }
    auto body = [&](int m0) __attribute__((always_inline)) {
        f32x4 v[2][4], yy[2][4], gc[4];
#pragma unroll
        for (int j = 0; j < 4; ++j) gc[j] = g2[j];
#pragma unroll
        for (int r = 0; r < 2; ++r)
#pragma unroll
            for (int j = 0; j < 4; ++j) { const v2u w = xw[r][j]; v[r][j] = (f32x4){bflo(w.x), bfhi(w.x), bflo(w.y), bfhi(w.y)}; yy[r][j] = fp8x4_f32(ya[r][j]) * (1.0f / F8_SY); }
        { const int mn = m0 + step < T ? m0 + step : m0; const i32x2 cnx = c2; const int m3 = mn + step < T ? mn + step : mn;
          c2 = *(const i32x2*)(ptinfo + m3); P10_ISSUE(mn, cnx); }
#pragma unroll
        for (int r = 0; r < 2; ++r) { float s = 0.f;
#pragma unroll
            for (int j = 0; j < 4; ++j) { v[r][j] = v[r][j] + gc[j] * yy[r][j]; s += (v[r][j].x * v[r][j].x + v[r][j].y * v[r][j].y) + (v[r][j].z * v[r][j].z + v[r][j].w * v[r][j].w); }
            const float rstd = 1.0f / sqrtf(wave_sum(s) * (1.f / DM) + EPS);
            GAS f32x4* o = (GAS f32x4*)(a.out + (size_t)(m0 + r) * DM) + F.lane;
#ifdef SELFCHECK
            for (int j = 0; j < 4; ++j) o[64 * j] = (v[r][j] * (rstd * chk_scale)) * gf[j]; }
#else
            for (int j = 0; j < 4; ++j) __builtin_nontemporal_store((v[r][j] * rstd) * gf[j], o + 64 * j); }
#endif
    };
    body(m0); m0 += step;
    for (; m0 < T; m0 += step) body(m0);
#undef P10_ISSUE
}
namespace mix {
__device__ __forceinline__ int crow(int r, int hi) { return (r & 3) + 8 * (r >> 2) + 4 * hi; }
__device__ __forceinline__ unsigned cvtpk(float lo, float hi) { return cvtpk2(lo, hi); }
typedef short v4i16_t __attribute__((ext_vector_type(4)));
__device__ __forceinline__ s16x4 vtr(const LAS unsigned char* p) { return __builtin_bit_cast(s16x4, __builtin_amdgcn_ds_read_tr16_b64_v4i16((LAS v4i16_t*)p)); }
__device__ __forceinline__ bf16x8 frag2(s16x4 lo, s16x4 hi) { return (bf16x8){lo[0], lo[1], lo[2], lo[3], hi[0], hi[1], hi[2], hi[3]}; }
__device__ __forceinline__ float swap_add(float v) { auto rr = __builtin_amdgcn_permlane32_swap(__float_as_uint(v), __float_as_uint(v), false, false); return __uint_as_float(rr[0]) + __uint_as_float(rr[1]); }
__device__ __forceinline__ float swap_max(float v) { auto rr = __builtin_amdgcn_permlane32_swap(__float_as_uint(v), __float_as_uint(v), false, false); return fmaxf(__uint_as_float(rr[0]), __uint_as_float(rr[1])); }
__device__ __forceinline__ void glds16_asm(const void* gsrc, unsigned lds_dst) { unsigned keep;
    asm volatile("s_mov_b32 %0, m0\n\ts_mov_b32 m0, %2\n\ts_nop 0\n\tglobal_load_lds_dwordx4 %1, off\n\ts_mov_b32 m0, %0" : "=&s"(keep) : "v"(gsrc), "s"(lds_dst) : "memory"); }
#define GLDS16(gp, lp) glds16_asm((const void*)(gp), (unsigned)__builtin_amdgcn_readfirstlane((int)(unsigned)(uintptr_t)(lp)))

constexpr int A_KS = 8192, A_VS = 4096, A_V0 = 32768;
typedef int v8i_t __attribute__((ext_vector_type(8))); typedef int v4i_t __attribute__((ext_vector_type(4)));
__device__ __forceinline__ void attn_unit(LAS unsigned char* lds, int b, int h, int qb, const bf16* q, const unsigned char* vt8, const unsigned char* k8, const bf16* proj, const int* positions, bf16* omix) {
    const int tid = threadIdx.x, lane = tid & 63, r32 = lane & 31, hi = lane >> 5; const int wid = __builtin_amdgcn_readfirstlane(tid >> 6);
    const size_t rowbase = (size_t)b * SEQ; const int q0 = qb * 256;
    const int NT = (q0 + 256) / 64;
    const unsigned char* ksrc = wid < 4 ? k8 + (rowbase + lane) * 512 + h * 64 + 16 * wid : (const unsigned char*)(proj + (rowbase + lane) * INWP + C_KR + 8 * (wid - 4));
    const size_t kstr = wid < 4 ? (size_t)64 * 512 : (size_t)64 * INWP * 2;
    const unsigned char* vsrc = vt8 + (size_t)((b * 8 + h) * 64) * 4096 + (wid & 3) * 1024 + lane * 16;
    LAS unsigned char* kd0 = lds + wid * 1024; LAS unsigned char* vd0 = lds + A_V0 + (wid & 3) * 1024;
#define ADMA(t) do { const int s_ = (t) & 3; GLDS16(ksrc + (size_t)(t) * kstr, kd0 + s_ * A_KS); if (wid < 4) GLDS16(vsrc + (size_t)(t) * 4096, vd0 + s_ * A_VS); } while (0)
    ADMA(0); ADMA(1);
    const size_t qrow = rowbase + q0 + wid * 32 + r32;
    const float C2 = 0.10206207261596575f * 1.4426950408889634f;
    bf16x8 qr[6]; v8i_t q8;
    const int sK = (int)F8_E1, sQ = (int)F8_E8;
    { const bf16* qp = q + qrow * QW + h * 96 + 8 * hi; v4u raw[6];
      const bf16* qn = q + qrow * QW + h * 96 + 32 * hi;
#pragma unroll
      for (int d0 = 0; d0 < 4; ++d0) raw[d0] = *(const GAS v4u*)(qn + 8 * d0);
#pragma unroll
      for (int d0 = 4; d0 < 6; ++d0) raw[d0] = *(const GAS v4u*)(qp + 16 * d0);
      const float pos = (float)positions[qrow];
      const float C8 = C2 * 8.0f;
#pragma unroll
      for (int d0 = 0; d0 < 4; ++d0) {
          q8[2 * d0] = (int)cvt4_fp8(bflo(raw[d0][0]) * C8, bfhi(raw[d0][0]) * C8, bflo(raw[d0][1]) * C8, bfhi(raw[d0][1]) * C8);
          q8[2 * d0 + 1] = (int)cvt4_fp8(bflo(raw[d0][2]) * C8, bfhi(raw[d0][2]) * C8, bflo(raw[d0][3]) * C8, bfhi(raw[d0][3]) * C8); }
      v4u o1, o2;
#pragma unroll
      for (int j = 0; j < 4; ++j) {
#pragma unroll
          for (int e = 0; e < 2; ++e) { const int f = 8 * e + 4 * hi + j; float tt = pos * (exp2f(-(float)f * (13.287712379549449f / 16.f)) * 0.15915494309189535f); tt -= floorf(tt);
              const float sn = __builtin_amdgcn_sinf(tt), cs = __builtin_amdgcn_cosf(tt);
              const unsigned w = e ? raw[5][j] : raw[4][j]; const float x1 = bflo(w), x2 = bfhi(w);
              const unsigned r = cvtpk((x1 * cs - x2 * sn) * C2, (x1 * sn + x2 * cs) * C2);
              if (e) o2[j] = r; else o1[j] = r; } }
      qr[4] = __builtin_bit_cast(bf16x8, o1); qr[5] = __builtin_bit_cast(bf16x8, o2); }
    float mhat = 0.f, l_run = 0.f; f32x16 o[2]; o[0] = f32x16{}; o[1] = f32x16{};
    f32x16 negm = f32x16{};
    const int qrel = wid * 32 + r32;
    const int voa = r32 * 64 + (((2 * hi) ^ ((r32 >> 2) & 3)) << 4), vob = r32 * 64 + (((2 * hi + 1) ^ ((r32 >> 2) & 3)) << 4);
    f32x16 pA0, pA1, pB0, pB1; v8i_t pw; float resc_f = 1.0f; bool resc = false;
#define SGB(mask, n) __builtin_amdgcn_sched_group_barrier(mask, n, 0)
#define ATOP(t) do { if ((t) + 1 < NT) { if (wid < 4) asm volatile("s_waitcnt vmcnt(2) lgkmcnt(0)\n\ts_barrier" ::: "memory"); else asm volatile("s_waitcnt vmcnt(1) lgkmcnt(0)\n\ts_barrier" ::: "memory"); } else WAIT_BAR0(); if ((t) + 2 < NT) ADMA((t) + 2); } while (0)
#define FP8QK(C, KA, KB) asm volatile("v_mfma_scale_f32_32x32x64_f8f6f4 %0, %1, %2, %5, %3, %4 op_sel_hi:[0,0,0]" : "=&v"(C) : "v"(__builtin_shufflevector(KA, KB, 0, 1, 2, 3, 4, 5, 6, 7)), "v"(q8), "v"(sK), "v"(sQ), "v"(negm))
#define AQK(C0, C1, t) do { const LAS unsigned char* kn_ = lds + ((t) & 3) * A_KS + hi * 2048 + r32 * 16; const LAS unsigned char* kr_ = lds + ((t) & 3) * A_KS + 4096 + hi * 1024 + r32 * 16; \
        const v4i_t n0a_ = *(const LAS v4i_t*)(kn_), n0b_ = *(const LAS v4i_t*)(kn_ + 1024), n1a_ = *(const LAS v4i_t*)(kn_ + 512), n1b_ = *(const LAS v4i_t*)(kn_ + 1536); \
        const bf16x8 r0_ = *(const LAS bf16x8*)(kr_), r1_ = *(const LAS bf16x8*)(kr_ + 512), r2_ = *(const LAS bf16x8*)(kr_ + 2048), r3_ = *(const LAS bf16x8*)(kr_ + 2560); \
        FP8QK(C0, n0a_, n0b_); FP8QK(C1, n1a_, n1b_); \
        C0 = __builtin_amdgcn_mfma_f32_32x32x16_bf16(r0_, qr[4], C0, 0, 0, 0); C1 = __builtin_amdgcn_mfma_f32_32x32x16_bf16(r1_, qr[4], C1, 0, 0, 0); \
        C0 = __builtin_amdgcn_mfma_f32_32x32x16_bf16(r2_, qr[5], C0, 0, 0, 0); C1 = __builtin_amdgcn_mfma_f32_32x32x16_bf16(r3_, qr[5], C1, 0, 0, 0); } while (0)
#define PK8(a, b, c, d) __builtin_amdgcn_cvt_pk_fp8_f32((c), (d), __builtin_amdgcn_cvt_pk_fp8_f32((a), (b), 0, false), true)
#define ASUMPACK(P0, P1) do { float s0_ = P0[0] + P0[1], s1_ = P1[0] + P1[1]; \
        _Pragma("unroll") for (int r = 2; r < 16; ++r) { s0_ += P0[r]; s1_ += P1[r]; } l_run += s0_ + s1_; \
        _Pragma("unroll") for (int j = 0; j < 4; ++j) { pw[j] = PK8(P0[4 * j], P0[4 * j + 1], P0[4 * j + 2], P0[4 * j + 3]); pw[4 + j] = PK8(P1[4 * j], P1[4 * j + 1], P1[4 * j + 2], P1[4 * j + 3]); } } while (0)
#define AMASK(C0, C1, t) do { const int jb_ = (t) - (NT - 4); if (jb_ >= 0) { const int kb0_ = 64 * jb_ + 4 * hi; \
        _Pragma("unroll") for (int r = 0; r < 16; ++r) { const int kvr_ = kb0_ + (r & 3) + 8 * (r >> 2); if (kvr_ > qrel) C0[r] = -INFINITY; if (kvr_ + 32 > qrel) C1[r] = -INFINITY; } } } while (0)
#define ADECIDE(C0, C1, FIRST) do { \
        float ra_ = fmaxf(fmaxf(C0[0], C0[1]), C1[0]), rb_ = fmaxf(fmaxf(C0[2], C0[3]), C1[1]); ra_ = fmaxf(fmaxf(ra_, C1[2]), C1[3]); \
        _Pragma("unroll") for (int r = 4; r < 16; r += 4) { ra_ = fmaxf(fmaxf(ra_, C0[r]), C0[r + 1]); rb_ = fmaxf(fmaxf(rb_, C0[r + 2]), C0[r + 3]); ra_ = fmaxf(fmaxf(ra_, C1[r]), C1[r + 1]); rb_ = fmaxf(fmaxf(rb_, C1[r + 2]), C1[r + 3]); } \
        const float rm_ = swap_max(fmaxf(ra_, rb_)); resc = false; \
        if ((FIRST) || __builtin_expect(__any(rm_ > 8.0f), 0)) { const float dl_ = (FIRST) ? rm_ : fmaxf(rm_, 0.f); \
            resc_f = (FIRST) ? 1.0f : __builtin_amdgcn_exp2f(-dl_); mhat += dl_; l_run *= resc_f; resc = true; \
            _Pragma("unroll") for (int r = 0; r < 16; ++r) { C0[r] -= dl_; C1[r] -= dl_; negm[r] = -mhat; } } } while (0)
#define AEXP(C0, C1) do { _Pragma("unroll") for (int r = 0; r < 16; ++r) { C0[r] = __builtin_amdgcn_exp2f(C0[r]); C1[r] = __builtin_amdgcn_exp2f(C1[r]); } } while (0)
#define FP8PV(D0, VA, VB) asm volatile("v_mfma_scale_f32_32x32x64_f8f6f4 %0, %1, %2, %0, %3, %3 op_sel_hi:[0,0,0]" : "+v"(o[D0]) : "v"(__builtin_shufflevector(VA, VB, 0, 1, 2, 3, 4, 5, 6, 7)), "v"(pw), "v"(sK))
#define ONOP() asm volatile("s_nop 15\n\ts_nop 7" ::: "memory")
#define APV(vs) do { const LAS unsigned char* vp_ = lds + A_V0 + (vs) * A_VS; \
        const v4i_t a0_ = *(const LAS v4i_t*)(vp_ + voa), b0_ = *(const LAS v4i_t*)(vp_ + vob), a1_ = *(const LAS v4i_t*)(vp_ + 2048 + voa), b1_ = *(const LAS v4i_t*)(vp_ + 2048 + vob); \
        FP8PV(0, a0_, b0_); FP8PV(1, a1_, b1_); ONOP(); } while (0)
#define ARESC() do { if (resc) { ONOP(); _Pragma("unroll") for (int r = 0; r < 16; ++r) { o[0][r] *= resc_f; o[1][r] *= resc_f; } } } while (0)
#define SBAR() __builtin_amdgcn_sched_barrier(0)
#define PIN(x) asm volatile("" : "+v"(x))
#define ASTEP(C0, C1, P0, P1, t) do { ATOP(t); \
        v4i_t kn_[4]; bf16x8 kf_[4]; { const LAS unsigned char* kb_ = lds + ((t) & 3) * A_KS + hi * 2048 + r32 * 16; const LAS unsigned char* kr_ = lds + ((t) & 3) * A_KS + 4096 + hi * 1024 + r32 * 16; \
            kn_[0] = *(const LAS v4i_t*)(kb_); kn_[1] = *(const LAS v4i_t*)(kb_ + 1024); kn_[2] = *(const LAS v4i_t*)(kb_ + 512); kn_[3] = *(const LAS v4i_t*)(kb_ + 1536); \
            kf_[0] = *(const LAS bf16x8*)(kr_); kf_[1] = *(const LAS bf16x8*)(kr_ + 512); kf_[2] = *(const LAS bf16x8*)(kr_ + 2048); kf_[3] = *(const LAS bf16x8*)(kr_ + 2560); } \
        SBAR(); \
        ASUMPACK(P0, P1); PIN(l_run); PIN(pw); \
        SBAR(); \
        FP8QK(C0, kn_[0], kn_[1]); FP8QK(C1, kn_[2], kn_[3]); \
        C0 = __builtin_amdgcn_mfma_f32_32x32x16_bf16(kf_[0], qr[4], C0, 0, 0, 0); C1 = __builtin_amdgcn_mfma_f32_32x32x16_bf16(kf_[1], qr[4], C1, 0, 0, 0); \
        C0 = __builtin_amdgcn_mfma_f32_32x32x16_bf16(kf_[2], qr[5], C0, 0, 0, 0); C1 = __builtin_amdgcn_mfma_f32_32x32x16_bf16(kf_[3], qr[5], C1, 0, 0, 0); \
        SBAR(); \
        v4i_t va_[2], vb_[2]; { const LAS unsigned char* vp_ = lds + A_V0 + (((t) - 1) & 3) * A_VS;     \
            va_[0] = *(const LAS v4i_t*)(vp_ + voa); vb_[0] = *(const LAS v4i_t*)(vp_ + vob); va_[1] = *(const LAS v4i_t*)(vp_ + 2048 + voa); vb_[1] = *(const LAS v4i_t*)(vp_ + 2048 + vob); } \
        SBAR(); \
        AMASK(C0, C1, t); ADECIDE(C0, C1, false); \
        SBAR(); \
        FP8PV(0, va_[0], vb_[0]); \
        _Pragma("unroll") for (int r = 0; r < 16; ++r) C0[r] = __builtin_amdgcn_exp2f(C0[r]); PIN(C0); \
        SBAR(); \
        FP8PV(1, va_[1], vb_[1]); \
        _Pragma("unroll") for (int r = 0; r < 16; ++r) C1[r] = __builtin_amdgcn_exp2f(C1[r]); PIN(C1); \
        SBAR(); \
        ARESC(); } while (0)
    ATOP(0); AQK(pA0, pA1, 0); AMASK(pA0, pA1, 0); ADECIDE(pA0, pA1, true); AEXP(pA0, pA1); resc = false;
    for (int t = 1; t + 2 < NT; t += 2) { ASTEP(pB0, pB1, pA0, pA1, t); ASTEP(pA0, pA1, pB0, pB1, t + 1); }
    ASTEP(pB0, pB1, pA0, pA1, NT - 1);
    ASUMPACK(pB0, pB1); APV((NT - 1) & 3);
#undef SGB
#undef ATOP
#undef ASUMPACK
#undef AMASK
#undef ADECIDE
#undef AEXP
#undef APV
#undef FP8PV
#undef ONOP
#undef PK8
#undef ARESC
#undef ASTEP
#undef SBAR
#undef PIN
    l_run = swap_add(l_run);
    const float inv = 1.0f / l_run;
    bf16* op = omix + qrow * DM + h * 64 + 4 * hi;
#pragma unroll
    for (int d0 = 0; d0 < 2; ++d0)
#pragma unroll
        for (int a4 = 0; a4 < 4; ++a4) { v2u w; w.x = cvtpk(o[d0][4 * a4] * inv, o[d0][4 * a4 + 1] * inv); w.y = cvtpk(o[d0][4 * a4 + 2] * inv, o[d0][4 * a4 + 3] * inv);
            *(GAS v2u*)(op + 32 * d0 + 8 * a4) = w; }
    WAIT_BAR0();
#undef ADMA
#undef AQK
#undef FP8QK
}

constexpr int R_STG = 65536, R_K = 16384, R_V = 32768, R_ST = 131072, R_STAT = 147456;
__device__ __forceinline__ void ret_unit(LAS unsigned char* lds, int b, int hh, const bf16* proj, bf16* omix) {
    const int tid = threadIdx.x, lane = tid & 63, r32 = lane & 31, hi = lane >> 5; const int wid = __builtin_amdgcn_readfirstlane(tid >> 6);
    const int qbk = wid & 3, dvh = wid >> 2;
    const size_t rowbase = (size_t)b * SEQ;
    const float g128 = exp2f(128.0f * ret_log2g(hh));
    for (int i = tid; i < 16384 / 16; i += NTHR) *(LAS v4u*)(lds + R_ST + i * 16) = (v4u){0u, 0u, 0u, 0u};
    f32x16 st = f32x16{};
    const bf16* qsrc = proj + (rowbase + lane) * INWP + C_RQ + hh * 64 + 8 * wid;
    const bf16* ksrc = proj + (rowbase + lane) * INWP + C_RK + hh * 64 + 8 * wid;
    const bf16* vsrc = proj + (rowbase + (lane >> 2)) * INWP + C_RV + hh * 128 + (lane & 3) * 8;
#define RDMA(n, s) do { const size_t ro_ = (size_t)(n) * 128 * INWP; LAS unsigned char* sb_ = lds + (s) * R_STG; \
        GLDS16(qsrc + ro_, sb_ + wid * 2048); GLDS16(qsrc + ro_ + 64 * INWP, sb_ + wid * 2048 + 1024); \
        GLDS16(ksrc + ro_, sb_ + R_K + wid * 2048); GLDS16(ksrc + ro_ + 64 * INWP, sb_ + R_K + wid * 2048 + 1024); \
        _Pragma("unroll") for (int pq_ = 0; pq_ < 4; ++pq_) { const int pc_ = wid + 8 * pq_, cg_ = pc_ >> 3, rg_ = pc_ & 7; \
            GLDS16(vsrc + ro_ + (size_t)(16 * rg_) * INWP + cg_ * 32, sb_ + R_V + cg_ * 8192 + rg_ * 1024); } } while (0)
    RDMA(0, 0);
    const int g1 = (lane >> 4) & 1, qq = (lane & 15) >> 2, pp = lane & 3;
    const int tr_v = (4 * hi + qq) * 64 + 32 * g1 + 8 * pp;
    const int tr_n = (8 * hi + qq) * 64 + 32 * g1 + 8 * pp;
    const int tr_k = (8 * hi + qq) * 16 + (2 * g1 + (pp >> 1)) * 2048 + (pp & 1) * 8;
    for (int n = 0; n < 32; ++n) {
        const int s = n & 1;
        WAIT_BAR0();
        if (n + 1 < 32) RDMA(n + 1, s ^ 1);
        const LAS unsigned char* sb = lds + s * R_STG;
        const size_t trow = rowbase + (size_t)n * 128 + 32 * qbk + r32;
        v2u grr[2][4];
        { const bf16* gp = proj + trow * INWP + C_RG + hh * 128 + 64 * dvh + 4 * hi;
#pragma unroll
          for (int d0 = 0; d0 < 2; ++d0)
#pragma unroll
              for (int a4 = 0; a4 < 4; ++a4) grr[d0][a4] = *(const GAS v2u*)(gp + 32 * d0 + 8 * a4); }
#define RSBAR() __builtin_amdgcn_sched_barrier(0)
        bf16x8 qf[4]; bf16x8 kfr[4][4];
#pragma unroll
        for (int k = 0; k < 4; ++k) qf[k] = *(const LAS bf16x8*)(sb + (2 * k + hi) * 2048 + (32 * qbk + r32) * 16);
#pragma unroll
        for (int jt = 0; jt < 4; ++jt)
#pragma unroll
            for (int k = 0; k < 4; ++k) kfr[jt][k] = *(const LAS bf16x8*)(sb + R_K + (2 * k + hi) * 2048 + (32 * jt + r32) * 16);
        RSBAR();
        v4u pw[4][2];
#pragma unroll
        for (int jt = 0; jt < 4; ++jt) {
            f32x16 p = __builtin_amdgcn_mfma_f32_32x32x16_bf16(kfr[jt][0], qf[0], f32x16{}, 0, 0, 0);
#pragma unroll
            for (int k = 1; k < 4; ++k) p = __builtin_amdgcn_mfma_f32_32x32x16_bf16(kfr[jt][k], qf[k], p, 0, 0, 0);
            const int dq = 32 * (qbk - jt) + r32;
#pragma unroll
            for (int r = 0; r < 16; ++r) if (crow(r, hi) > dq) p[r] = 0.f;
#pragma unroll
            for (int j = 0; j < 4; ++j) { pw[jt][0][j] = cvtpk(p[2 * j], p[2 * j + 1]); pw[jt][1][j] = cvtpk(p[8 + 2 * j], p[9 + 2 * j]); }
        }
        RSBAR();
        f32x16 o[2]; o[0] = f32x16{}; o[1] = f32x16{};
#pragma unroll
        for (int d0 = 0; d0 < 2; ++d0) {
            const LAS unsigned char* vb = sb + R_V + (2 * dvh + d0) * 8192 + tr_v; const LAS unsigned char* stb = lds + R_ST + (2 * dvh + d0) * 4096 + tr_n;
            s16x4 va[8], vc[8], sa[4], sc[4];
#pragma unroll
            for (int i = 0; i < 8; ++i) { const LAS unsigned char* vp = vb + (16 * i) * 64; va[i] = vtr(vp); vc[i] = vtr(vp + 512); }
#pragma unroll
            for (int k = 0; k < 4; ++k) { const LAS unsigned char* sp = stb + (16 * k) * 64; sa[k] = vtr(sp); sc[k] = vtr(sp + 256); }
            RSBAR();
#pragma unroll
            for (int i = 0; i < 8; ++i) o[d0] = __builtin_amdgcn_mfma_f32_32x32x16_bf16(frag2(va[i], vc[i]), __builtin_bit_cast(bf16x8, pw[i >> 1][i & 1]), o[d0], 0, 0, 0);
#pragma unroll
            for (int k = 0; k < 4; ++k) o[d0] = __builtin_amdgcn_mfma_f32_32x32x16_bf16(frag2(sa[k], sc[k]), qf[k], o[d0], 0, 0, 0);
            RSBAR();
        }
        { const LAS unsigned char* vb = sb + R_V + qbk * 8192 + tr_n; const LAS unsigned char* kb = sb + R_K + dvh * 8192 + tr_k;
          s16x4 va[8], vc[8], ka[8], kc[8];
#pragma unroll
          for (int ks = 0; ks < 8; ++ks) { const LAS unsigned char* vp = vb + (16 * ks) * 64; const LAS unsigned char* kp = kb + (16 * ks) * 16; va[ks] = vtr(vp); vc[ks] = vtr(vp + 256); ka[ks] = vtr(kp); kc[ks] = vtr(kp + 64); }
          RSBAR();
#pragma unroll
          for (int ks = 0; ks < 8; ++ks) st = __builtin_amdgcn_mfma_f32_32x32x16_bf16(frag2(va[ks], vc[ks]), frag2(ka[ks], kc[ks]), st, 0, 0, 0);
#pragma unroll
          for (int r = 0; r < 16; ++r) st[r] *= g128; }
#undef RSBAR
        LGK_BAR();
        { LAS unsigned char* sw = lds + R_ST + qbk * 4096 + (32 * dvh + r32) * 64 + 8 * hi;
#pragma unroll
          for (int a4 = 0; a4 < 4; ++a4) { v2u w; w.x = cvtpk(st[4 * a4], st[4 * a4 + 1]); w.y = cvtpk(st[4 * a4 + 2], st[4 * a4 + 3]); *(LAS v2u*)(sw + 16 * a4) = w; } }
        float s1 = 0.f, s2 = 0.f;
#pragma unroll
        for (int d0 = 0; d0 < 2; ++d0)
#pragma unroll
            for (int r = 0; r < 16; ++r) { s1 += o[d0][r]; s2 += o[d0][r] * o[d0][r]; }
        s1 = swap_add(s1); s2 = swap_add(s2);
        LAS f32x2* stat = (LAS f32x2*)(lds + R_STAT);
        if (hi == 0) stat[wid * 32 + r32] = (f32x2){s1, s2};
        LGK_BAR();
        { const f32x2 ot = stat[(wid ^ 4) * 32 + r32]; s1 += ot.x; s2 += ot.y; }
        const float mean = s1 * (1.f / 128.f), var = fmaxf(s2 * (1.f / 128.f) - mean * mean, 0.f), rstd = 1.0f / sqrtf(var + EPS);
        bf16* op = omix + trow * DM + 512 + hh * 128 + 64 * dvh + 4 * hi;
#pragma unroll
        for (int d0 = 0; d0 < 2; ++d0)
#pragma unroll
            for (int a4 = 0; a4 < 4; ++a4) { const v2u gr = grr[d0][a4];
                const float y0 = silu_f(bflo(gr.x)) * (o[d0][4 * a4] - mean) * rstd, y1 = silu_f(bfhi(gr.x)) * (o[d0][4 * a4 + 1] - mean) * rstd;
                const float y2 = silu_f(bflo(gr.y)) * (o[d0][4 * a4 + 2] - mean) * rstd, y3 = silu_f(bfhi(gr.y)) * (o[d0][4 * a4 + 3] - mean) * rstd;
                v2u w; w.x = cvtpk(y0, y1); w.y = cvtpk(y2, y3); *(GAS v2u*)(op + 32 * d0 + 8 * a4) = w; }
    }
    WAIT_BAR0();
#undef RDMA
}
#undef GLDS16
}
#ifndef GEMM_ALIGN
#define GEMM_ALIGN true
#endif
#ifndef MK_ONE_LAUNCH
#define MK_ONE_LAUNCH 1
#endif
constexpr int NPHASE = 11;
__global__ void __launch_bounds__(NTHR, 2) fwd(Args args) {
    extern __shared__ __attribute__((aligned(16))) unsigned char lds_raw[];
    Frame F;
    F.lds = (LAS unsigned char*)lds_raw;
    F.MISC = (volatile LAS unsigned*)(F.lds + MISC_OFF);
    F.tid = threadIdx.x; F.lane = F.tid & 63; F.wave = __builtin_amdgcn_readfirstlane(F.tid >> 6);
    F.G = gridDim.x; F.bx = blockIdx.x;
    unsigned char* ws = args.ws;
    F.ctl = (gu32*)(ws + WS_CTL);
    for (int u = F.tid; u < (LDS_BYTES - LDSCTL_OFF) / 4; u += NTHR) ((LAS unsigned*)(F.lds + LDSCTL_OFF))[u] = 0u;
    __syncthreads();
    XcdBarrier bar; bar.bar = (unsigned*)(F.ctl + CW_BAR); bar.x = 0; bar.st = nullptr;
    const int lo = args.ph_lo, hi = args.ph_hi;
    if (hi - lo > 1) bar = xcd_barrier_post((unsigned*)(F.ctl + CW_BAR), F.MISC + 8);
#ifdef ONLY_PHASE
#define IN(k) ((k) == ONLY_PHASE && lo <= (k) && (k) < hi)
#else
#define IN(k) (lo <= (k) && (k) < hi)
#endif
#define SEAM(k) do { if (IN(k) && IN((k) + 1)) xcd_barrier(bar); } while (0)
    LAS unsigned char* ring = F.lds;

#ifndef REP_PHASE
#define REP_PHASE -1
#endif
    int rep_id = 0;
#define RUN(k, ...) do { if (IN(k)) { { __VA_ARGS__ } if (REP_PHASE == (k)) { xcd_barrier(bar); rep_id = 1; { __VA_ARGS__ } rep_id = 0; } SEAM(k); } } while (0)
    RUN(0, p0_prologue(F, args););
    RUN(1, p1_norm1(F, args););
    RUN(2,
        pg8::Gemm g{(const bf16*)(ws + WS_B), (const bf16*)(ws + WS_WIN), DM, DM}; pg8::StaticOrder S; S.init(T, INWP, F.G, F.bx);
#ifdef GEMM_STAGGER_US
        { const unsigned long long t0 = __builtin_amdgcn_s_memrealtime(); const unsigned long long dly = (unsigned long long)(((F.bx >> 3) & 3) * GEMM_STAGGER_US) * 100ull;
          while (__builtin_amdgcn_s_memrealtime() - t0 < dly) __builtin_amdgcn_s_sleep(8); }
#endif
#ifdef REP_NULL_EPI
        if (rep_id == 1) {
#if REP_NULL_EPI == 2
            pg8::EpiBf16 E0{(bf16*)(ws + WS_B), INWP}; pg8::gemm_phase<pg8::EpiBf16, pg8::StaticOrder, GEMM_ALIGN>(ring, g, S, E0);
#else
            pg8::EpiNull E0{(float*)(ws + WS_END)}; pg8::gemm_phase<pg8::EpiNull, pg8::StaticOrder, GEMM_ALIGN>(ring, g, S, E0);
#endif
        } else
#endif
        { pg8::EpiProj E{(bf16*)(ws + WS_A), (const int*)args.in[2], (float*)(ws + WS_PQ), (float*)(ws + WS_PKV)};
        pg8::gemm_phase<pg8::EpiProj, pg8::StaticOrder, GEMM_ALIGN>(ring, g, S, E); }
    );
    RUN(4,
        { pg8::Gemm g{(const bf16*)(ws + WS_A) + C_CQ, (const bf16*)(ws + WS_WUQ), INWP, 256}; pg8::StaticOrder S; S.init(T, QW, F.G, F.bx);
          pg8::EpiScaled<8, 256> E{(bf16*)(ws + WS_B), QW, (const float*)(ws + WS_PQ), nullptr};
          pg8::gemm_phase<pg8::EpiScaled<8, 256>, pg8::StaticOrder, GEMM_ALIGN>(ring, g, S, E); }
        { pg8::Gemm g{(const bf16*)(ws + WS_A) + C_CKV, (const bf16*)(ws + WS_WUKV), INWP, 128}; pg8::StaticOrder S; S.init(T, KVW, F.G, F.bx);
          pg8::EpiScaled<4, 128> E{(bf16*)(ws + WS_C), KVW, (const float*)(ws + WS_PKV), ws + WS_K8};
          pg8::gemm_phase<pg8::EpiScaled<4, 128>, pg8::StaticOrder, GEMM_ALIGN>(ring, g, S, E); }
    );
    RUN(5,
        const bf16* proj = (const bf16*)(ws + WS_A); bf16* omix = (bf16*)(ws + WS_D);
#ifndef REP5_MODE
#define REP5_MODE 0
#endif
        if (!(rep_id == 1 && REP5_MODE == 2)) for (int u = F.bx; u < NB * 4; u += F.G) mix::ret_unit(ring, u >> 2, u & 3, proj, omix);
        volatile LAS int* qs = (volatile LAS int*)(F.MISC + 16);
        if (!(rep_id == 1 && REP5_MODE == 1)) for (;;) {
            if (F.tid == 0) qs[0] = (int)__hip_atomic_fetch_add(F.ctl + CW_QUEUE + 64 * rep_id, 1u, RLX_AGENT);
            __syncthreads();
            const int u = qs[0];
            __syncthreads();
            if (u >= NB * 8 * 16) break;
            const int qb = 15 - (u >> 7), bh = u & 127;
            mix::attn_unit(ring, bh >> 3, bh & 7, qb, (const bf16*)(ws + WS_B), ws + WS_C, ws + WS_K8, proj, (const int*)args.in[2], omix);
        }
    );
#ifdef SELFCHECK
    if (IN(5)) { selfcheck_phase(F, args); xcd_barrier(bar); }
#endif
    RUN(6,
        pg8::Gemm g{(const bf16*)(ws + WS_D), (const bf16*)(ws + WS_WO), DM, DM}; pg8::StaticOrder S; S.init(T, DM, F.G, F.bx);
#ifdef P6_STAGGER_US
        { const unsigned long long t0 = __builtin_amdgcn_s_memrealtime(); const unsigned long long dly = (unsigned long long)(((F.bx >> 3) & 3) * P6_STAGGER_US) * 100ull;
          while (__builtin_amdgcn_s_memrealtime() - t0 < dly) __builtin_amdgcn_s_sleep(8); }
#endif
        pg8::EpiResid E{(const float*)args.in[0], (const float*)(ws + WS_MOD), (bf16*)(ws + WS_A), (float*)(ws + WS_PART)};
        pg8::gemm_phase<pg8::EpiResid, pg8::StaticOrder, GEMM_ALIGN>(ring, g, S, E);
    );
    RUN(7, p7_norm2_router(F, args, rep_id););
    if (IN(8) || IN(9) || IN(10)) {
        LAS int* pre = (LAS int*)(F.MISC + 32);
        LAS int* ppre = (LAS int*)(F.MISC + 96);
        if (F.tid < NE) pre[F.tid + 1] = ((int)__hip_atomic_load(F.ctl + CW_CNT + F.tid * CNT_STRIDE, RLX_AGENT) + 255) >> 8;
        else if (F.tid >= 64 && F.tid < 64 + NPAIR) ppre[F.tid - 64 + 1] = ((int)__hip_atomic_load(F.ctl + CW_PCNT + (F.tid - 64) * CNT_STRIDE, RLX_AGENT) + 255) >> 8;
        __syncthreads();
        if (F.tid == 0) { int s = 0; pre[0] = 0; for (int e = 1; e <= NE; ++e) { s += pre[e]; pre[e] = s; } }
        else if (F.tid == 64) { int s = 0; ppre[0] = 0; for (int q = 1; q <= NPAIR; ++q) { s += ppre[q]; ppre[q] = s; } }
        __syncthreads();
        const int* cnt = (const int*)(F.ctl + CW_CNT); const int* tok = (const int*)(ws + WS_TOK);
        RUN(8,
            pg8::Gemm g{(const bf16*)(ws + WS_B), (const bf16*)(ws + WS_W13), DM / 2, DM / 2, F8_E32, F8_E1}; pg8::MoeOrder S{F.G, F.bx, 2, pre, cnt, tok};
            pg8::EpiSwiGLU2 E{ws + WS_C, tok, (const int*)(ws + WS_PTI), (const float*)(ws + WS_GATEW), ppre};
            pg8::gemm_phase<pg8::EpiSwiGLU2, pg8::MoeOrder, GEMM_ALIGN, true, true>(ring, g, S, E);
        );
        RUN(9,
            pg8::Gemm g{(const bf16*)(ws + WS_C), (const bf16*)(ws + WS_W2), DE, DE / 2, F8_E16, F8_E8}; pg8::PairOrder S{F.G, F.bx, ppre};
            pg8::EpiFp8 E{ws + WS_D, DM, F8_SY};
            pg8::gemm_phase<pg8::EpiFp8, pg8::PairOrder, GEMM_ALIGN, false, true>(ring, g, S, E);
        );
#ifdef SELFCHECK
        if (IN(10)) { selfcheck_moe(F, args, ppre); xcd_barrier(bar); }
#endif
        RUN(10, p10_final(F, args, ppre););
    }
#undef RUN
#undef IN
#undef SEAM
}

extern "C" void kernel_launch(void* const* d_in, const int* in_sizes, int n_in, void* d_out, int out_size, void* d_ws, size_t ws_size, hipStream_t stream) {
    static int grid = 0;
    if (grid == 0) {
        if (n_in != 21 || in_sizes[0] != T * DM || out_size != T * DM || ws_size < WS_END) { fprintf(stderr, "kernel_launch: unexpected shapes (n_in %d, in0 %d, out %d, ws %zu); nothing launched\n", n_in, n_in > 0 ? in_sizes[0] : -1, out_size, ws_size); grid = -1; return; }
        int dev = 0, cus = 0, per_cu = 0;
        if (hipGetDevice(&dev) != hipSuccess || hipDeviceGetAttribute(&cus, hipDeviceAttributeMultiprocessorCount, dev) != hipSuccess) { grid = -1; return; }
        if (hipFuncSetAttribute((const void*)fwd, hipFuncAttributeMaxDynamicSharedMemorySize, LDS_BYTES) != hipSuccess) { fprintf(stderr, "kernel_launch: hipFuncSetAttribute failed\n"); grid = -1; return; }
        if (hipOccupancyMaxActiveBlocksPerMultiprocessor(&per_cu, (const void*)fwd, NTHR, LDS_BYTES) != hipSuccess || per_cu < 1) fprintf(stderr, "kernel_launch: occupancy query reports %d\n", per_cu);
        (void)hipGetLastError();
        grid = cus;
    }
    if (grid < 0) return;
    if (hipMemsetAsync((char*)d_ws + WS_CTL, 0, CTL_ZERO_BYTES, stream) != hipSuccess) return;
    Args a{};
    for (int i = 0; i < 21; ++i) a.in[i] = d_in[i];
    a.out = (float*)d_out; a.ws = (unsigned char*)d_ws;
#if MK_ONE_LAUNCH
    a.ph_lo = 0; a.ph_hi = NPHASE;
    hipLaunchKernelGGL(fwd, dim3(grid), dim3(NTHR), LDS_BYTES, stream, a);
#else
    for (int p = 0; p < NPHASE; ++p) { a.ph_lo = p; a.ph_hi = p + 1; hipLaunchKernelGGL(fwd, dim3(grid), dim3(NTHR), LDS_BYTES, stream, a); }
#endif
}
```

```cpp
#include <hip/hip_runtime.h>
#include <cstdio>
#include <cstdint>

#define GAS __attribute__((address_space(1)))
#define LAS __attribute__((address_space(3)))
typedef unsigned short bf16;
typedef unsigned v4u __attribute__((ext_vector_type(4)));
typedef unsigned v2u __attribute__((ext_vector_type(2)));
typedef float f32x2 __attribute__((ext_vector_type(2)));
typedef float f32x4 __attribute__((ext_vector_type(4)));
typedef float f32x16 __attribute__((ext_vector_type(16)));
typedef short bf16x8 __attribute__((ext_vector_type(8)));
typedef short s16x4 __attribute__((ext_vector_type(4)));
typedef GAS unsigned gu32;

constexpr int DM = 1024, NB = 16, SEQ = 4096, T = NB * SEQ;
constexpr int INW = 1952, INWP = 2048;
constexpr int C_CQ = 0, C_CKV = 256, C_KR = 384, C_RQ = 416, C_RK = 672, C_RV = 928, C_RG = 1440;
constexpr int QW = 768, KVW = 1024;
constexpr int NE = 32, DE = 256, CAP = 65536;
constexpr int MODW = 6 * DM;
constexpr float EPS = 1e-6f;
constexpr int NWAVES = 8, NTHR = 512;

constexpr size_t MiB = 1u << 20;
constexpr size_t WS_CTL = 0, CTL_ZERO_BYTES = 256 * 1024;
constexpr size_t WS_MOD = 1 * MiB;
constexpr size_t WS_WR = 1 * MiB + 512 * 1024;
constexpr size_t WS_WIN = 2 * MiB, WS_WUQ = 6 * MiB, WS_WUKV = 6 * MiB + 512 * 1024, WS_WO = 7 * MiB, WS_W13 = 9 * MiB, WS_W2 = 41 * MiB;
constexpr size_t WS_PQ = 70 * MiB;
constexpr size_t WS_PKV = 60 * MiB;
constexpr size_t WS_PART = 57 * MiB;
constexpr size_t WS_GATEW = 61 * MiB;
constexpr size_t WS_SLOT = 61 * MiB + 512 * 1024;
constexpr size_t WS_PTI = 1 * MiB + 768 * 1024;
constexpr int NPAIR = 4 * 28;
constexpr size_t WS_TOK = 62 * MiB;
constexpr size_t WS_A = 72 * MiB;
constexpr size_t WS_K8 = (328 + 96) * MiB;
constexpr size_t WS_B = 328 * MiB;
constexpr size_t WS_C = 456 * MiB;
constexpr size_t WS_D = 584 * MiB;
constexpr size_t WS_END = 872 * MiB;
constexpr int CW_TMO = 0, CW_CODE = 1, CW_BAR = 4096, CW_CNT = 8192, CNT_STRIDE = 64, CW_CNT2 = 12288, CW_QUEUE = 16384, CW_PCNT = 32768;

constexpr int RING_BYTES = 149504;
constexpr int LDSCTL_OFF = 150528, MISC_OFF = LDSCTL_OFF;
constexpr int LDS_BYTES = 151552;

#define RLX_AGENT __ATOMIC_RELAXED, __HIP_MEMORY_SCOPE_AGENT
#define LDS_WAIT() asm volatile("s_waitcnt lgkmcnt(0)" ::: "memory")
#define VM_WAIT() asm volatile("s_waitcnt vmcnt(0)" ::: "memory")
#define WAIT_BAR0() asm volatile("s_waitcnt vmcnt(0) lgkmcnt(0)\n\ts_barrier" ::: "memory")
#define LGK_BAR() asm volatile("s_waitcnt lgkmcnt(0)\n\ts_barrier" ::: "memory")
__device__ __forceinline__ unsigned f2bf(float f) { unsigned u = __builtin_bit_cast(unsigned, f); return (u + 0x7fffu + ((u >> 16) & 1u)) >> 16; }
__device__ __forceinline__ unsigned pk2(float lo, float hi) { return f2bf(lo) | (f2bf(hi) << 16); }
typedef __bf16 bf16x2_t __attribute__((ext_vector_type(2)));
__device__ __forceinline__ unsigned cvtpk2(float lo, float hi) { f32x2 v = {lo, hi}; bf16x2_t b = __builtin_convertvector(v, bf16x2_t); return __builtin_bit_cast(unsigned, b); }
__device__ __forceinline__ float clamp448(float v) { return __builtin_fminf(__builtin_fmaxf(v, -448.0f), 448.0f); }
__device__ __forceinline__ unsigned cvt4_fp8(float a, float b, float c, float d) { int p = __builtin_amdgcn_cvt_pk_fp8_f32(clamp448(a), clamp448(b), 0, false); p = __builtin_amdgcn_cvt_pk_fp8_f32(clamp448(c), clamp448(d), p, true); return (unsigned)p; }
constexpr float F8_SW13 = 32.0f, F8_SW2 = 16.0f, F8_SH = 8.0f, F8_SY = 16.0f;
constexpr unsigned F8_E1 = 0x7f7f7f7fu, F8_E32 = 0x7a7a7a7au, F8_E16 = 0x7b7b7b7bu, F8_E8 = 0x7c7c7c7cu;
__device__ __forceinline__ f32x4 fp8x4_f32(unsigned w) { return (f32x4){__builtin_amdgcn_cvt_f32_fp8((int)w, 0), __builtin_amdgcn_cvt_f32_fp8((int)w, 1), __builtin_amdgcn_cvt_f32_fp8((int)w, 2), __builtin_amdgcn_cvt_f32_fp8((int)w, 3)}; }
__device__ __forceinline__ float bf2f(unsigned b) { return __builtin_bit_cast(float, b << 16); }
__device__ __forceinline__ float bflo(unsigned w) { return __builtin_bit_cast(float, w << 16); }
__device__ __forceinline__ float bfhi(unsigned w) { return __builtin_bit_cast(float, w & 0xffff0000u); }
__device__ __forceinline__ float wave_sum(float v) {
#pragma unroll
    for (int o = 1; o < 64; o <<= 1) v += __shfl_xor(v, o);
    return v;
}
__device__ __forceinline__ float silu_f(float v) { return v / (1.0f + __expf(-v)); }

#define XB_TMO      128
#define XB_XCNT(j)  (256  + 64 * (j))
#define XB_XSUB(j)  (1280 + 64 * (j))
#define XB_XGEN(j)  (2304 + 64 * (j))
#define XB_TOP      3328
#define XB_TOPGEN   3392
#define XCD_BAR_WORDS 3456
#define XB_SPIN_CAP (1u << 22)
__device__ __forceinline__ unsigned xb_ld(unsigned* p)              { return __hip_atomic_load(p, __ATOMIC_RELAXED, __HIP_MEMORY_SCOPE_AGENT); }
__device__ __forceinline__ unsigned xb_add(unsigned* p, unsigned v) { return __hip_atomic_fetch_add(p, v, __ATOMIC_RELAXED, __HIP_MEMORY_SCOPE_AGENT); }
__device__ __forceinline__ unsigned xb_xcc_id() { return (unsigned)__builtin_amdgcn_s_getreg((3 << 11) | 20) & 0xFu; }
#define XB_SPIN(cond, bar) do { unsigned _sp = 0; while (cond) { __builtin_amdgcn_s_sleep(1); \
    if ((++_sp & 255u) == 0u) { if (xb_ld(&(bar)[XB_TMO])) break; if (_sp > XB_SPIN_CAP) { atomicAdd(&(bar)[XB_TMO], 1u); break; } } } } while (0)
struct XcdBarrier { unsigned* bar; unsigned x; volatile LAS unsigned* st; };
__device__ __forceinline__ XcdBarrier xcd_barrier_post(unsigned* bar, volatile LAS unsigned* st) {
    XcdBarrier b; b.bar = bar; b.x = xb_xcc_id(); b.st = st;
    if (threadIdx.x == 0) (void)xb_add(&bar[XB_XCNT(b.x)], 1u);
    return b;
}
__device__ __forceinline__ void xcd_barrier_complete(unsigned* bar, unsigned x, unsigned& nloc, unsigned& nx) {
    const unsigned G = gridDim.x * gridDim.y * gridDim.z;
    unsigned sum, cnt, mine, sp = 0u;
    for (;;) {
        sum = 0u; cnt = 0u; mine = 0u;
#pragma unroll
        for (unsigned j = 0; j < 16; ++j) { const unsigned c = xb_ld(&bar[XB_XCNT(j)]); sum += c; cnt += (c > 0u) ? 1u : 0u; mine = (j == x) ? c : mine; }
        if (sum == G) break;
        __builtin_amdgcn_s_sleep(1);
        if ((++sp & 255u) == 0u) { if (xb_ld(&bar[XB_TMO])) break; if (sp > XB_SPIN_CAP) { atomicAdd(&bar[XB_TMO], 1u); break; } }
    }
    nloc = mine > 0u ? mine : 1u; nx = cnt > 0u ? cnt : 1u;
}
__device__ __forceinline__ void xcd_barrier(const XcdBarrier& b) {
    asm volatile("s_waitcnt vmcnt(0)" ::: "memory");
    __syncthreads();
    if (threadIdx.x == 0) {
        unsigned* bar = b.bar;
        __builtin_amdgcn_s_waitcnt(0);
        unsigned nloc = b.st[0], nx = b.st[1];
        if (nloc == 0u) { xcd_barrier_complete(bar, b.x, nloc, nx); b.st[0] = nloc; b.st[1] = nx; }
        const unsigned old = xb_add(&bar[XB_XSUB(b.x)], 1u);
        const unsigned gen = old / nloc;
        if (old + 1u == (gen + 1u) * nloc) {
            __builtin_amdgcn_fence(__ATOMIC_RELEASE, "agent");
            asm volatile("s_waitcnt vmcnt(0)" ::: "memory");
            const unsigned og = xb_add(&bar[XB_TOP], 1u);
            const unsigned tg = og / nx;
            if (og + 1u == (tg + 1u) * nx) xb_add(&bar[XB_TOPGEN], 1u);
            else XB_SPIN(xb_ld(&bar[XB_TOPGEN]) == tg, bar);
            __builtin_amdgcn_fence(__ATOMIC_ACQUIRE, "agent");
            xb_add(&bar[XB_XGEN(b.x)], 1u);
            asm volatile("s_waitcnt vmcnt(0)" ::: "memory");
        } else {
            XB_SPIN(xb_ld(&bar[XB_XGEN(b.x)]) == gen, bar);
            __builtin_amdgcn_fence(__ATOMIC_ACQUIRE, "agent");
            asm volatile("s_waitcnt vmcnt(0)" ::: "memory");
        }
    }
    __syncthreads();
}
namespace pg8 {
constexpr int BM = 256, BK = 64, HALF = 128, HTB = HALF * BK * 2, STAGE_BYTES = 8 * HTB, NXCD = 8, WGM = 8;
__host__ __device__ __forceinline__ int lds_byte(int r, int c) { const int st = (r >> 4) * 2 + (c >> 5), rr = r & 15, cc = c & 31, ob = rr * 64 + cc * 2; return st * 1024 + (ob ^ (((ob >> 9) & 1) << 5)); }
__host__ __device__ __forceinline__ void stage_rc(int b, int& R, int& C) { const int st = b / 1024, sb = b % 1024, swz = sb ^ (((sb >> 9) & 1) << 5); R = (st >> 1) * 16 + swz / 64; C = (st & 1) * 32 + (swz % 64) / 2; }
__host__ __device__ __forceinline__ int perm32(int rho) { const int n = rho >> 4, i = rho & 15; return 8 * (i >> 2) + 4 * n + (i & 3); }

struct Unit { int pm, pn, e, rb, nv, pnl, acol, cont; };
struct Gemm { const bf16* A; const bf16* Bt; int lda, K; unsigned sw = 0x7f7f7f7fu, sx = 0x7f7f7f7fu; };

struct StaticOrder {
    int nM, nN, nwg, G, c;
    __device__ void init(int M, int N, int G_, int c_) { nM = M / BM; nN = N / BM; nwg = nM * nN; G = G_; c = c_; }
    __device__ bool next(int i, Unit& u) const {
        const long L = (long)i * G + c; if (L >= nwg) return false;
        int wgid = (int)L; { const int q = nwg / NXCD, r = nwg % NXCD, xcd = wgid % NXCD, off = wgid / NXCD; wgid = (xcd < r ? xcd * (q + 1) : r * (q + 1) + (xcd - r) * q) + off; }
        const int nig = WGM * nN, gid = wgid / nig, fm = gid * WGM, gsz = (nM - fm) < WGM ? (nM - fm) : WGM;
        u.pm = fm + ((wgid % nig) % gsz); u.pn = (wgid % nig) / gsz; u.e = 0; u.rb = 0; u.nv = 256; u.pnl = u.pn; u.acol = 0; u.cont = 0; return true;
    }
    __device__ __forceinline__ unsigned arow(const Unit& u, int r) const { return (unsigned)(u.pm * BM + r); }
};
struct MoeOrder {
    int G, c, ncol; const LAS int* pre; const int* cnt; const int* tok;
    __device__ bool next(int i, Unit& u) const {
        const int L = i * G + c, gb = L / ncol, pl = L % ncol;
        if (gb >= pre[NE]) return false;
        const int lj = threadIdx.x & 31;
        const unsigned long long bm = __ballot(pre[lj] <= gb) & 0xffffffffull;
        const int e = 31 - __builtin_clz((unsigned)bm);
        u.pm = gb; u.e = e; u.rb = gb - pre[e]; u.pnl = pl; u.pn = e * ncol + pl; u.acol = 0; u.cont = 0;
        const int left = cnt[e * CNT_STRIDE] - u.rb * 256; u.nv = left < 256 ? left : 256; return true;
    }
    __device__ __forceinline__ unsigned arow(const Unit& u, int r) const {
        if (tok) return (r < u.nv) ? (unsigned)(tok[(size_t)u.e * CAP + u.rb * 256 + r] >> 1) : 0u;
        return (unsigned)(u.pm * BM + r);
    }
};

struct PairOrder {
    int G, c; const LAS int* ppre;
    __device__ bool next(int i, Unit& u) const {
        const int L = (i >> 1) * G + c, h = i & 1, gb = L >> 2, pl = L & 3;
        if (gb >= ppre[NPAIR]) return false;
        const int lj = threadIdx.x & 63;
        const unsigned long long b0 = __ballot(ppre[lj] <= gb), b1 = __ballot(lj < NPAIR - 64 && ppre[64 + lj] <= gb);
        const int pid = b1 ? 127 - __builtin_clzll(b1) : 63 - __builtin_clzll(b0);
        int pidx = pid % 28, a = 0; const int g = pid / 28;
        while (pidx >= 7 - a) { pidx -= 7 - a; ++a; }
        const int b = a + 1 + pidx;
        u.pm = gb; u.e = pid; u.rb = gb - ppre[pid]; u.pnl = pl; u.pn = (g * 8 + (h ? b : a)) * 4 + pl; u.nv = 256; u.acol = h * 256; u.cont = h; return true;
    }
    __device__ __forceinline__ unsigned arow(const Unit& u, int r) const { return (unsigned)(u.pm * BM + r); }
};

__device__ __forceinline__ unsigned cvt_pk_bf16(float lo, float hi) { return cvtpk2(lo, hi); }

struct EpiBf16 {
    static constexpr bool PERM = true;
    bf16* O; int ldc;
    __device__ __forceinline__ void operator()(const f32x4 (&acc)[2][2][4][2], const Unit& u, int wr, int wc, int fr, int fq) const {
        const int row0 = u.pm * BM + wr * 64 + fr; const int col0 = u.pnl * BM + wc * 32 + 8 * fq;
#pragma unroll
        for (int ai = 0; ai < 2; ++ai)
#pragma unroll
            for (int m = 0; m < 4; ++m) { bf16* rowp = O + (size_t)(row0 + ai * HALF + m * 16) * ldc + col0;
#pragma unroll
                for (int bj = 0; bj < 2; ++bj) { const f32x4 v0 = acc[ai][bj][m][0], v1 = acc[ai][bj][m][1];
                    v4u w; w.x = cvt_pk_bf16(v0[0], v0[1]); w.y = cvt_pk_bf16(v0[2], v0[3]); w.z = cvt_pk_bf16(v1[0], v1[1]); w.w = cvt_pk_bf16(v1[2], v1[3]);
                    *(v4u*)(rowp + bj * HALF) = w; } }
    }
};
struct EpiFp8 {
    static constexpr bool PERM = true;
    unsigned char* O; int ldc; float scale;
    __device__ __forceinline__ void operator()(const f32x4 (&acc)[2][2][4][2], const Unit& u, int wr, int wc, int fr, int fq) const {
        const int row0 = u.pm * BM + wr * 64 + fr; const int col0 = u.pnl * BM + wc * 32 + 8 * fq;
#pragma unroll
        for (int ai = 0; ai < 2; ++ai)
#pragma unroll
            for (int m = 0; m < 4; ++m) { unsigned char* rowp = O + (size_t)(row0 + ai * HALF + m * 16) * ldc + col0;
#pragma unroll
                for (int bj = 0; bj < 2; ++bj) { const f32x4 v0 = acc[ai][bj][m][0] * scale, v1 = acc[ai][bj][m][1] * scale;
                    v2u w; w.x = cvt4_fp8(v0[0], v0[1], v0[2], v0[3]); w.y = cvt4_fp8(v1[0], v1[1], v1[2], v1[3]);
                    *(v2u*)(rowp + bj * HALF) = w; } }
    }
};
struct EpiProj {
    static constexpr bool PERM = true;
    bf16* O; const int* positions; float* pq; float* pkv;
    __device__ __forceinline__ void operator()(const f32x4 (&acc)[2][2][4][2], const Unit& u, int wr, int wc, int fr, int fq) const {
        const int row0 = u.pm * BM + wr * 64 + fr;
        const float L2B = 13.287712379549449f, I2PI = 0.15915494309189535f;
        float posr[2][4];
#pragma unroll
        for (int ai = 0; ai < 2; ++ai)
#pragma unroll
            for (int m = 0; m < 4; ++m) posr[ai][m] = (u.pnl >= 1 && u.pnl <= 3) ? (float)positions[row0 + ai * HALF + m * 16] : 0.f;
#pragma unroll
        for (int bj = 0; bj < 2; ++bj) {
            const int seg = u.pnl * BM + bj * HALF + wc * 32;
            if (seg >= INW) continue;
            const int kind = seg < 256 ? 0 : seg < 384 ? 1 : seg < 416 ? 2 : seg < 672 ? 3 : seg < 928 ? 4 : 5;
            float cf[4]; float lgh = 0.f;
            if (kind == 2) {
#pragma unroll
                for (int i = 0; i < 4; ++i) cf[i] = exp2f(-(float)(4 * fq + i) * (1.f / 16.f) * L2B) * I2PI;
            } else if (kind == 3 || kind == 4) { const int base = kind == 3 ? 416 : 672, hh = (seg - base) >> 6, off = ((seg - base) & 63) + 8 * fq;
                lgh = log2f(1.0f - exp2f(-5.0f - (float)hh));
#pragma unroll
                for (int i = 0; i < 4; ++i) cf[i] = exp2f(-(float)(off / 2 + i) * (1.f / 32.f) * L2B) * I2PI;
            } else {
#pragma unroll
                for (int i = 0; i < 4; ++i) cf[i] = 0.f; }
#pragma unroll
            for (int ai = 0; ai < 2; ++ai)
#pragma unroll
                for (int m = 0; m < 4; ++m) { const int row = row0 + ai * HALF + m * 16;
                    float v[8];
#pragma unroll
                    for (int i = 0; i < 4; ++i) { v[i] = acc[ai][bj][m][0][i]; v[4 + i] = acc[ai][bj][m][1][i]; }
                    if (kind <= 1) { float ss = 0.f;
#pragma unroll
                        for (int i = 0; i < 8; ++i) ss += v[i] * v[i];
                        ss += __shfl_xor(ss, 16); ss += __shfl_xor(ss, 32);
                        if (fq == 0) { if (kind == 0) pq[(size_t)row * 8 + bj * 4 + wc] = ss; else pkv[(size_t)row * 4 + wc] = ss; }
                    } else if (kind <= 4) { const float pos = posr[ai][m]; float scl = 1.0f;
                        if (kind >= 3) { const float lg = lgh * (float)((row & 127) + 1); scl = kind == 3 ? exp2f(lg) : 0.125f * exp2f(-lg); }
#pragma unroll
                        for (int i = 0; i < 4; ++i) { float t = pos * cf[i]; t -= floorf(t); const float sn = __builtin_amdgcn_sinf(t), cs = __builtin_amdgcn_cosf(t);
                            const float x1 = v[2 * i], x2 = v[2 * i + 1]; v[2 * i] = (x1 * cs - x2 * sn) * scl; v[2 * i + 1] = (x1 * sn + x2 * cs) * scl; } }
                    v4u w; w.x = cvt_pk_bf16(v[0], v[1]); w.y = cvt_pk_bf16(v[2], v[3]); w.z = cvt_pk_bf16(v[4], v[5]); w.w = cvt_pk_bf16(v[6], v[7]);
                    *(v4u*)(O + (size_t)row * INWP + seg + 8 * fq) = w; }
        }
    }
};
template <int NP, int NC> struct EpiScaled {
    static constexpr bool PERM = true;
    bf16* O; int ldc; const float* part; unsigned char* k8;
    __device__ __forceinline__ void operator()(const f32x4 (&acc)[2][2][4][2], const Unit& u, int wr, int wc, int fr, int fq) const {
        const int row0 = u.pm * BM + wr * 64 + fr; const int col0 = u.pnl * BM + wc * 32 + 8 * fq;
        float rstd[2][4];
        { f32x4 pv[2][4][NP / 4];
#pragma unroll
          for (int ai = 0; ai < 2; ++ai)
#pragma unroll
              for (int m = 0; m < 4; ++m)
#pragma unroll
                  for (int p = 0; p < NP / 4; ++p) pv[ai][m][p] = *(const f32x4*)(part + (size_t)(row0 + ai * HALF + m * 16) * NP + 4 * p);
#pragma unroll
          for (int ai = 0; ai < 2; ++ai)
#pragma unroll
              for (int m = 0; m < 4; ++m) { float ss = 0.f;
#pragma unroll
                  for (int p = 0; p < NP / 4; ++p) ss += (pv[ai][m][p].x + pv[ai][m][p].y) + (pv[ai][m][p].z + pv[ai][m][p].w);
                  rstd[ai][m] = 1.0f / sqrtf(ss * (1.f / NC) + EPS); } }
        asm volatile("" ::: "memory");
#pragma unroll
        for (int ai = 0; ai < 2; ++ai)
#pragma unroll
            for (int m = 0; m < 4; ++m) { const int row = row0 + ai * HALF + m * 16; const float rs = rstd[ai][m];
                bf16* rowp = O + (size_t)row * ldc + col0;
#pragma unroll
                for (int bj = 0; bj < 2; ++bj) { const f32x4 v0 = acc[ai][bj][m][0] * rs, v1 = acc[ai][bj][m][1] * rs;
                    if (NP == 4 && wc < 2) { v2u w8; w8.x = cvt4_fp8(v0[0], v0[1], v0[2], v0[3]); w8.y = cvt4_fp8(v1[0], v1[1], v1[2], v1[3]);
                        *(v2u*)(k8 + (size_t)row * 512 + (2 * u.pnl + bj) * 64 + wc * 32 + 8 * fq) = w8; continue; }
                    if (NP == 4) {
                        const int k = row & 63, k5 = k & 31, pos = 32 * ((k5 >> 2) & 1) + 16 * (k >> 5) + 4 * (k5 >> 3) + (k5 & 3);
                        const int dvb = (wc - 2) * 32 + 8 * fq;
                        unsigned char* vb = (unsigned char*)O + ((size_t)(((row >> 12) * 8 + 2 * u.pnl + bj) * 64 + ((row & 4095) >> 6)) * 64 + dvb) * 64 + (pos & 15);
                        const int pa = (((pos >> 4) ^ ((dvb >> 2) & 3)) << 4), pb = (((pos >> 4) ^ (((dvb >> 2) + 1) & 3)) << 4);
                        const unsigned wa = cvt4_fp8(v0[0], v0[1], v0[2], v0[3]), wb = cvt4_fp8(v1[0], v1[1], v1[2], v1[3]);
                        vb[pa] = (unsigned char)wa; vb[pa + 64] = (unsigned char)(wa >> 8); vb[pa + 128] = (unsigned char)(wa >> 16); vb[pa + 192] = (unsigned char)(wa >> 24);
                        vb[pb + 256] = (unsigned char)wb; vb[pb + 320] = (unsigned char)(wb >> 8); vb[pb + 384] = (unsigned char)(wb >> 16); vb[pb + 448] = (unsigned char)(wb >> 24); continue; }
                    v4u w; w.x = cvt_pk_bf16(v0[0], v0[1]); w.y = cvt_pk_bf16(v0[2], v0[3]); w.z = cvt_pk_bf16(v1[0], v1[1]); w.w = cvt_pk_bf16(v1[2], v1[3]);
                    *(v4u*)(rowp + bj * HALF) = w; } }
    }
};
struct EpiNull {
    static constexpr bool PERM = true;
    float* sink;
    __device__ __forceinline__ void operator()(const f32x4 (&acc)[2][2][4][2], const Unit& u, int wr, int wc, int fr, int fq) const {
        float s = 0.f;
#pragma unroll
        for (int ai = 0; ai < 2; ++ai)
#pragma unroll
            for (int bj = 0; bj < 2; ++bj)
#pragma unroll
                for (int m = 0; m < 4; ++m)
#pragma unroll
                    for (int n = 0; n < 2; ++n) s += acc[ai][bj][m][n][0];
        if (s == 1.2345e30f) sink[0] = s;
    }
};
struct EpiResid {
    static constexpr bool PERM = true;
    const float* x; const float* mod; bf16* x1; float* part;
    __device__ __forceinline__ void operator()(const f32x4 (&acc)[2][2][4][2], const Unit& u, int wr, int wc, int fr, int fq) const {
        const int row0 = u.pm * BM + wr * 64 + fr; const int col0 = u.pnl * BM + wc * 32 + 8 * fq;
        const int b = (u.pm * BM) / SEQ;
        const float* g1 = mod + (size_t)b * MODW + 2 * DM;
        f32x4 gv[2][2];
#pragma unroll
        for (int bj = 0; bj < 2; ++bj)
#pragma unroll
            for (int n = 0; n < 2; ++n) gv[bj][n] = *(const f32x4*)(g1 + col0 + bj * HALF + 4 * n);
#pragma unroll
        for (int ai = 0; ai < 2; ++ai) {
            f32x4 xv[4][2][2];
#pragma unroll
            for (int m = 0; m < 4; ++m) { const size_t off = (size_t)(row0 + ai * HALF + m * 16) * DM + col0;
#pragma unroll
                for (int bj = 0; bj < 2; ++bj) { xv[m][bj][0] = *(const f32x4*)(x + off + bj * HALF); xv[m][bj][1] = *(const f32x4*)(x + off + bj * HALF + 4); } }
            asm volatile("" ::: "memory");
#pragma unroll
            for (int m = 0; m < 4; ++m) { const int row = row0 + ai * HALF + m * 16; const size_t off = (size_t)row * DM + col0; float ss = 0.f;
#pragma unroll
                for (int bj = 0; bj < 2; ++bj) { const f32x4 o0 = xv[m][bj][0] + gv[bj][0] * acc[ai][bj][m][0], o1 = xv[m][bj][1] + gv[bj][1] * acc[ai][bj][m][1];
                    v4u w; w.x = cvt_pk_bf16(o0[0], o0[1]); w.y = cvt_pk_bf16(o0[2], o0[3]); w.z = cvt_pk_bf16(o1[0], o1[1]); w.w = cvt_pk_bf16(o1[2], o1[3]);
                    *(v4u*)(x1 + off + bj * HALF) = w;
#pragma unroll
                    for (int j = 0; j < 4; ++j) { const float lo = bflo(w[j]), hi = bfhi(w[j]); ss += lo * lo + hi * hi; } }
                ss += __shfl_xor(ss, 16); ss += __shfl_xor(ss, 32);
                if (fq == 0) part[(size_t)row * 16 + u.pnl * 4 + wc] = ss; }
            asm volatile("" ::: "memory");
        }
    }
};
struct EpiSwiGLU {
    static constexpr bool PERM = true;
    bf16* H;
    __device__ __forceinline__ void operator()(const f32x4 (&acc)[2][2][4][2], const Unit& u, int wr, int wc, int fr, int fq) const {
        const int row0 = u.pm * BM + wr * 64 + fr; const int col0 = u.pnl * 128 + wc * 16 + 4 * fq;
#pragma unroll
        for (int ai = 0; ai < 2; ++ai)
#pragma unroll
            for (int m = 0; m < 4; ++m) { bf16* rowp = H + (size_t)(row0 + ai * HALF + m * 16) * DE + col0;
#pragma unroll
                for (int bj = 0; bj < 2; ++bj) { const f32x4 g = acc[ai][bj][m][0], v = acc[ai][bj][m][1];
                    v2u w; w.x = cvt_pk_bf16(silu_f(g[0]) * v[0], silu_f(g[1]) * v[1]); w.y = cvt_pk_bf16(silu_f(g[2]) * v[2], silu_f(g[3]) * v[3]);
                    *(v2u*)(rowp + bj * 64) = w; } }
    }
};
struct EpiSwiGLU2 {
    static constexpr bool PERM = true;
    unsigned char* H; const int* tok; const int* ptinfo; const float* gatew; const LAS int* ppre;
    __device__ __forceinline__ void operator()(const f32x4 (&acc)[2][2][4][2], const Unit& u, int wr, int wc, int fr, int fq) const {
        const int col0 = u.pnl * 128 + wc * 16 + 4 * fq;
#pragma unroll
        for (int ai = 0; ai < 2; ++ai) {
            int en[4]; int pi[4]; float w[4];
#pragma unroll
            for (int m = 0; m < 4; ++m) { const int rl = ai * HALF + wr * 64 + m * 16 + fr; en[m] = rl < u.nv ? tok[(size_t)u.e * CAP + u.rb * 256 + rl] : -1; }
#pragma unroll
            for (int m = 0; m < 4; ++m) { pi[m] = en[m] >= 0 ? ptinfo[en[m] >> 1] : 0; w[m] = en[m] >= 0 ? F8_SH * gatew[en[m]] : 0.f; }
            asm volatile("" ::: "memory");
#pragma unroll
            for (int m = 0; m < 4; ++m) if (en[m] >= 0) {
                const int pid = (pi[m] & 0x3fffffff) >> 16, ppos = pi[m] & 65535, half = (en[m] & 1) ^ ((pi[m] >> 30) & 1);
                unsigned char* rowp = H + ((size_t)(256 * ppre[pid] + ppos)) * 512 + half * 256 + col0;
#pragma unroll
                for (int bj = 0; bj < 2; ++bj) { const f32x4 g = acc[ai][bj][m][0], v = acc[ai][bj][m][1];
                    *(unsigned*)(rowp + bj * 64) = cvt4_fp8(w[m] * silu_f(g[0]) * v[0], w[m] * silu_f(g[1]) * v[1], w[m] * silu_f(g[2]) * v[2], w[m] * silu_f(g[3]) * v[3]); } }
            asm volatile("" ::: "memory");
        }
    }
};
struct EpiDown {
    static constexpr bool PERM = true;
    bf16* Y; const int* tok; const float* gatew;
    __device__ __forceinline__ void operator()(const f32x4 (&acc)[2][2][4][2], const Unit& u, int wr, int wc, int fr, int fq) const {
        const int col0 = u.pnl * BM + wc * 32 + 8 * fq;
#pragma unroll
        for (int ai = 0; ai < 2; ++ai)
#pragma unroll
            for (int m = 0; m < 4; ++m) { const int rl = ai * HALF + wr * 64 + m * 16 + fr;
                if (rl < u.nv) { const int entry = tok[(size_t)u.e * CAP + u.rb * 256 + rl]; const float w = gatew[entry]; bf16* rowp = Y + (size_t)entry * DM + col0;
#pragma unroll
                    for (int bj = 0; bj < 2; ++bj) { const f32x4 v0 = acc[ai][bj][m][0] * w, v1 = acc[ai][bj][m][1] * w;
                        v4u o; o.x = cvt_pk_bf16(v0[0], v0[1]); o.y = cvt_pk_bf16(v0[2], v0[3]); o.z = cvt_pk_bf16(v1[0], v1[1]); o.w = cvt_pk_bf16(v1[2], v1[3]);
                        *(v4u*)(rowp + bj * HALF) = o; } }
                asm volatile("" ::: "memory"); }
    }
};

template <class Epi, class Sched, bool ALIGN_EPI, bool GATHER = false, bool FP8 = false>
__device__ __forceinline__ void gemm_phase(LAS unsigned char* lds, const Gemm g, const Sched& S, const Epi& E) {
    const int tid = threadIdx.x, wid = __builtin_amdgcn_readfirstlane(tid >> 6), lane = tid & 63, wr = wid >> 2, wc = wid & 3, fr = lane & 15, fq = lane >> 4;
    int K = g.K; asm volatile("" : "+s"(K));
    const int nt = K / BK;
    unsigned voffB[2], voffA[2]; int RA[2]; unsigned CA[2];
#pragma unroll
    for (int i = 0; i < 2; ++i) { int R, C; stage_rc(tid * 16 + i * 8192, R, C); const int Rb = Epi::PERM ? ((R & ~31) + perm32(R & 31)) : R;
        RA[i] = R; CA[i] = (unsigned)C * 2u; voffA[i] = (unsigned)(R * g.lda + C) * 2u; voffB[i] = (unsigned)(Rb * K + C) * 2u; }
    const unsigned kstep = (unsigned)(BK * 2);
    const size_t hstepB = (size_t)HALF * K * 2, tstepB = 2 * hstepB;
    const unsigned pitchA = (unsigned)g.lda * 2u; const size_t hstepA = (size_t)HALF * g.lda * 2, tstepA = 2 * hstepA;
    const unsigned ldsw = (unsigned)wid * 1024u;
    const int aoff = lds_byte(wr * 64 + fr, fq * 8), boff = lds_byte(wc * 32 + fr, fq * 8);
#define PG8_SA(b, h) (((b) * 2 + (h)) * HTB)
#define PG8_SB(b, h) ((4 + (b) * 2 + (h)) * HTB)
#define PG8_STAGE(bufoff, gbase, voff) do { _Pragma("unroll") for (int _i = 0; _i < 2; ++_i) \
        __builtin_amdgcn_global_load_lds((const unsigned*)((const char*)(gbase) + (voff)[_i]), (LAS unsigned*)(lds + (bufoff) + ldsw + _i * 8192), 16, 0, 0); } while (0)
#define PG8_STAGEA(bufoff, up, offs, h, kb) do { _Pragma("unroll") for (int _i = 0; _i < 2; ++_i) { \
        const char* _p = GATHER ? ((const char*)g.A + (size_t)(offs)[h][_i] + (kb)) : ((up) + (size_t)(h) * hstepA + voffA[_i] + (kb)); \
        __builtin_amdgcn_global_load_lds((const unsigned*)_p, (LAS unsigned*)(lds + (bufoff) + ldsw + _i * 8192), 16, 0, 0); } } while (0)
#define PG8_LDA(dst, b, h) do { if constexpr (FP8) { _Pragma("unroll") for (int m = 0; m < 4; ++m) { const v4i_ lo_ = *(const LAS v4i_*)(lds + PG8_SA(b, h) + aoff + m * 2048), hi_ = *(const LAS v4i_*)(lds + PG8_SA(b, h) + aoff + m * 2048 + 1024); \
            dst##8[m] = __builtin_shufflevector(lo_, hi_, 0, 1, 2, 3, 4, 5, 6, 7); } } \
        else { _Pragma("unroll") for (int m = 0; m < 4; ++m) _Pragma("unroll") for (int k = 0; k < 2; ++k) dst[m][k] = *(const LAS bf16x8*)(lds + PG8_SA(b, h) + aoff + m * 2048 + k * 1024); } } while (0)
#define PG8_LDB(dst, b, h) do { if constexpr (FP8) { _Pragma("unroll") for (int n = 0; n < 2; ++n) { const v4i_ lo_ = *(const LAS v4i_*)(lds + PG8_SB(b, h) + boff + n * 2048), hi_ = *(const LAS v4i_*)(lds + PG8_SB(b, h) + boff + n * 2048 + 1024); \
            dst##8[n] = __builtin_shufflevector(lo_, hi_, 0, 1, 2, 3, 4, 5, 6, 7); } } \
        else { _Pragma("unroll") for (int n = 0; n < 2; ++n) _Pragma("unroll") for (int k = 0; k < 2; ++k) dst[n][k] = *(const LAS bf16x8*)(lds + PG8_SB(b, h) + boff + n * 2048 + k * 1024); } } while (0)
#define PG8_MMA(ai, bj, At, Bt) do { __builtin_amdgcn_s_setprio(1); _Pragma("unroll") for (int m = 0; m < 4; ++m) _Pragma("unroll") for (int n = 0; n < 2; ++n) { \
        if constexpr (FP8) asm volatile("v_mfma_scale_f32_16x16x128_f8f6f4 %0, %1, %2, %0, %3, %4 op_sel_hi:[0,0,0]" : "+v"(acc[ai][bj][m][n]) : "v"(Bt##8[n]), "v"(At##8[m]), "v"(f8sw), "v"(f8sx));     \
        else { _Pragma("unroll") for (int k = 0; k < 2; ++k) acc[ai][bj][m][n] = __builtin_amdgcn_mfma_f32_16x16x32_bf16(Bt[n][k], At[m][k], acc[ai][bj][m][n], 0, 0, 0); } } \
        __builtin_amdgcn_s_setprio(0); } while (0)
#define PG8_WAIT_V(n) asm volatile("s_waitcnt vmcnt(" #n ")" ::: "memory")
#define PG8_WAIT_L(n) asm volatile("s_waitcnt lgkmcnt(" #n ")" ::: "memory")
#define PG8_BAR __builtin_amdgcn_s_barrier()
#define PG8_SCHED __builtin_amdgcn_sched_barrier(0)
#define PG8_AOFFS(dst, un) do { if constexpr (GATHER) _Pragma("unroll") for (int _h = 0; _h < 2; ++_h) _Pragma("unroll") for (int _i = 0; _i < 2; ++_i) dst[_h][_i] = S.arow(un, _h * HALF + RA[_i]) * pitchA + CA[_i]; } while (0)
    Unit cur, nxt; int ui = 0;
    if (!S.next(0, cur)) return;
    f32x4 acc[2][2][4][2];
#pragma unroll
    for (int a = 0; a < 2; ++a)
#pragma unroll
        for (int b = 0; b < 2; ++b)
#pragma unroll
            for (int m = 0; m < 4; ++m)
#pragma unroll
                for (int n = 0; n < 2; ++n) acc[a][b][m][n] = (f32x4){0.f, 0.f, 0.f, 0.f};
    typedef int v8i_ __attribute__((ext_vector_type(8))); typedef int v4i_ __attribute__((ext_vector_type(4)));
    bf16x8 At[4][2], B0[2][2], B1[2][2]; v8i_ At8[4], B08[2], B18[2];
    const int f8sw = (int)g.sw, f8sx = (int)g.sx;
    unsigned oC[2][2], oN[2][2];
    PG8_AOFFS(oC, cur);
    const char* cA = (const char*)g.A + (size_t)cur.pm * tstepA + cur.acol;
    const char* cB = (const char*)g.Bt + (size_t)cur.pn * tstepB;
    PG8_STAGE(PG8_SB(0, 0), cB, voffB); PG8_STAGE(PG8_SB(0, 1), cB + hstepB, voffB); PG8_STAGEA(PG8_SA(0, 0), cA, oC, 0, 0u); PG8_STAGEA(PG8_SA(0, 1), cA, oC, 1, 0u);
    if (wr == 1) PG8_BAR;
    PG8_WAIT_V(2); PG8_BAR;
    PG8_STAGE(PG8_SB(1, 0), cB + kstep, voffB); PG8_STAGEA(PG8_SA(1, 0), cA, oC, 0, kstep); PG8_STAGE(PG8_SB(1, 1), cB + hstepB + kstep, voffB);
    PG8_WAIT_V(6); PG8_BAR;
    for (;;) {
        const bool has_next = S.next(ui + 1, nxt);
        if (has_next) { PG8_AOFFS(oN, nxt); } else {
#pragma unroll
            for (int _h = 0; _h < 2; ++_h)
#pragma unroll
                for (int _i = 0; _i < 2; ++_i) oN[_h][_i] = oC[_h][_i]; }
        const char* nA = has_next ? (const char*)g.A + (size_t)nxt.pm * tstepA + nxt.acol : cA;
        const char* nB = has_next ? (const char*)g.Bt + (size_t)nxt.pn * tstepB : cB;
        for (int t = 0; t < nt; t += 2) {
            const bool last = (t == nt - 2);
            const unsigned ka1 = (unsigned)(t + 1) * kstep;
            const unsigned ka2 = last ? 0u : (unsigned)(t + 2) * kstep, ka3 = ka2 + kstep;
            unsigned o2[2][2];
#pragma unroll
            for (int _h = 0; _h < 2; ++_h)
#pragma unroll
                for (int _i = 0; _i < 2; ++_i) o2[_h][_i] = last ? oN[_h][_i] : oC[_h][_i];
            const char* a2 = last ? nA : cA;
            const char* b2 = last ? nB : cB + (size_t)(t + 2) * kstep; const char* b3 = b2 + kstep;
            PG8_LDB(B0, 0, 0); PG8_LDB(B1, 0, 1); PG8_SCHED; PG8_LDA(At, 0, 0); PG8_STAGEA(PG8_SA(1, 1), cA, oC, 1, ka1);
            PG8_WAIT_V(8); PG8_WAIT_L(0); PG8_BAR; PG8_MMA(0, 0, At, B0); PG8_MMA(0, 1, At, B1); PG8_BAR; PG8_SCHED;
            PG8_LDA(At, 0, 1); PG8_STAGE(PG8_SB(0, 0), b2, voffB); PG8_STAGE(PG8_SB(0, 1), b2 + hstepB, voffB); PG8_STAGEA(PG8_SA(0, 0), a2, o2, 0, ka2);
            PG8_WAIT_V(8); PG8_WAIT_L(0); PG8_BAR; PG8_MMA(1, 0, At, B0); PG8_MMA(1, 1, At, B1); PG8_BAR; PG8_SCHED;
            PG8_LDB(B0, 1, 0); PG8_LDB(B1, 1, 1); PG8_SCHED; PG8_LDA(At, 1, 0); PG8_STAGEA(PG8_SA(0, 1), a2, o2, 1, ka2);
            PG8_WAIT_V(8); PG8_WAIT_L(0); PG8_BAR; PG8_MMA(0, 0, At, B0); PG8_MMA(0, 1, At, B1); PG8_BAR; PG8_SCHED;
            PG8_LDA(At, 1, 1); PG8_STAGE(PG8_SB(1, 0), b3, voffB); PG8_STAGE(PG8_SB(1, 1), b3 + hstepB, voffB); PG8_STAGEA(PG8_SA(1, 0), a2, o2, 0, ka3);
            PG8_WAIT_V(8); PG8_WAIT_L(0); PG8_BAR; PG8_MMA(1, 0, At, B0); PG8_MMA(1, 1, At, B1); PG8_BAR; PG8_SCHED;
        }
        const bool fin = !(has_next && nxt.cont);
        if (fin) {
        if constexpr (ALIGN_EPI) { if (wr == 0) PG8_BAR; }
        E(acc, cur, wr, wc, fr, fq);
        }
        if (!has_next) break;
        if (fin) {
#pragma unroll
        for (int a = 0; a < 2; ++a)
#pragma unroll
            for (int b = 0; b < 2; ++b)
#pragma unroll
                for (int m = 0; m < 4; ++m)
#pragma unroll
                    for (int n = 0; n < 2; ++n) acc[a][b][m][n] = (f32x4){0.f, 0.f, 0.f, 0.f};
        }
        cur = nxt; cA = nA; cB = nB; ++ui;
#pragma unroll
        for (int _h = 0; _h < 2; ++_h)
#pragma unroll
            for (int _i = 0; _i < 2; ++_i) oC[_h][_i] = oN[_h][_i];
        if constexpr (ALIGN_EPI) { if (fin && wr == 1) PG8_BAR; }
    }
    PG8_WAIT_V(0);
    if constexpr (!ALIGN_EPI) { if (wr == 0) PG8_BAR; }
    PG8_BAR;
#undef PG8_SA
#undef PG8_SB
#undef PG8_STAGE
#undef PG8_STAGEA
#undef PG8_LDA
#undef PG8_LDB
#undef PG8_MMA
#undef PG8_WAIT_V
#undef PG8_WAIT_L
#undef PG8_BAR
#undef PG8_SCHED
#undef PG8_AOFFS
}
}
struct Frame {
    LAS unsigned char* lds;
    volatile LAS unsigned* MISC;
    gu32* ctl;
    int tid, lane, wave, G, bx;
};
struct Args { const void* in[21]; float* out; unsigned char* ws; int ph_lo, ph_hi; };

__device__ __forceinline__ int pair_map(int j, int half) { return j < half ? 2 * j : 2 * (j - half) + 1; }
__device__ __forceinline__ int row_map(int mode, int n) {
    if (mode == 0) return n;
    if (mode <= 2) return 8 * (n >> 2) + 4 * (mode - 1) + (n & 3);
    if (mode == 3) { if (n >= C_KR && n < C_RQ) return C_KR + pair_map(n - C_KR, 16);
                     if (n >= C_RQ && n < C_RV) { const int hb = C_RQ + ((n - C_RQ) & ~63); return hb + pair_map(n - hb, 32); }
                     return n; }
    { const int h = n / 96, d = n % 96; return d < 64 ? n : h * 96 + 64 + pair_map(d - 64, 16); }
}
__device__ __forceinline__ void transpose_item(const float* W, int K, int N, bf16* WT, int mode, const float* kscale, LAS float* scr, int item, int lane, float f8scale = 0.f) {
    const int nblk = N / 32, kb = item / nblk, nb = item % nblk, k0 = 64 * kb, n0 = 32 * nb;
    float wv[32];
#pragma unroll
    for (int i = 0; i < 32; ++i) { const int kk = 2 * i + (lane >> 5); wv[i] = __builtin_nontemporal_load(W + (size_t)(k0 + kk) * N + n0 + (lane & 31)); }
#pragma unroll
    for (int i = 0; i < 32; ++i) { const int kk = 2 * i + (lane >> 5); float w = wv[i]; if (kscale) w *= kscale[k0 + kk]; scr[kk * 33 + (lane & 31)] = w; }
    LDS_WAIT(); asm volatile("" ::: "memory");
    const int c = lane & 7;
#pragma unroll
    for (int j = 0; j < 4; ++j) { const int n = (lane >> 3) + 8 * j; const LAS float* s = scr + (8 * c) * 33 + n;
        v4u o; o.x = pk2(s[0 * 33], s[1 * 33]); o.y = pk2(s[2 * 33], s[3 * 33]); o.z = pk2(s[4 * 33], s[5 * 33]); o.w = pk2(s[6 * 33], s[7 * 33]);
        const int row = row_map(mode, n0 + n);
        if (f8scale > 0.f) { v2u o8; o8.x = cvt4_fp8(f8scale * s[0 * 33], f8scale * s[1 * 33], f8scale * s[2 * 33], f8scale * s[3 * 33]); o8.y = cvt4_fp8(f8scale * s[4 * 33], f8scale * s[5 * 33], f8scale * s[6 * 33], f8scale * s[7 * 33]);
            *(GAS v2u*)((unsigned char*)WT + (size_t)row * K + k0 + 8 * c) = o8; }
        else *(GAS v4u*)(WT + (size_t)row * K + k0 + 8 * c) = o; }
    LDS_WAIT(); asm volatile("" ::: "memory");
}
__device__ __forceinline__ void p0_prologue(Frame& F, const Args& a) {
    unsigned char* ws = a.ws;
    float* mod = (float*)(ws + WS_MOD);
    for (int cb = F.bx; cb < MODW / 32; cb += F.G) {
        const float* c = (const float*)a.in[1]; const float* w_ada = (const float*)a.in[3]; const float* b_ada = (const float*)a.in[4];
        LAS float* sc = (LAS float*)F.lds;
        LAS float* part = (LAS float*)(F.lds + 65536);
        for (int i = F.tid; i < NB * DM; i += NTHR) sc[i] = silu_f(c[i]);
        __syncthreads();
        const int cc = F.tid & 31, kq = F.tid >> 5, n = cb * 32 + cc;
        float acc[NB];
#pragma unroll
        for (int b = 0; b < NB; ++b) acc[b] = 0.f;
        for (int k0 = kq; k0 < DM; k0 += 128) { float wv[8];
#pragma unroll
            for (int i = 0; i < 8; ++i) wv[i] = __builtin_nontemporal_load(w_ada + (size_t)(k0 + 16 * i) * MODW + n);
#pragma unroll
            for (int i = 0; i < 8; ++i)
#pragma unroll
                for (int b = 0; b < NB; ++b) acc[b] += sc[b * DM + k0 + 16 * i] * wv[i]; }
#pragma unroll
        for (int b = 0; b < NB; ++b) part[(kq * NB + b) * 32 + cc] = acc[b];
        __syncthreads();
        { const int b = F.tid >> 5; float s = b_ada[n];
#pragma unroll
          for (int q = 0; q < 16; ++q) s += part[(q * NB + b) * 32 + cc];
          mod[(size_t)b * MODW + n] = s; }
        __syncthreads();
    }
    LAS float* scr = (LAS float*)(F.lds + F.wave * 16384);
    const int gw = F.bx * NWAVES + F.wave, NGW = F.G * NWAVES;
    constexpr int I_IN = (DM / 64) * (INW / 32), I_UQ = (256 / 64) * (QW / 32), I_UKV = (128 / 64) * (KVW / 32), I_O = (DM / 64) * (DM / 32);
    constexpr int I_W1 = (DM / 64) * (DE / 32), I_W2 = (DE / 64) * (DM / 32);
    constexpr int NITEMS = I_IN + I_UQ + I_UKV + I_O + NE * (2 * I_W1 + I_W2);
    for (int it = gw; it < NITEMS; it += NGW) {
        int r = it;
        if (r < I_IN) { transpose_item((const float*)a.in[6], DM, INW, (bf16*)(ws + WS_WIN), 3, nullptr, scr, r, F.lane); continue; } r -= I_IN;
        if (r < I_UQ) { transpose_item((const float*)a.in[8], 256, QW, (bf16*)(ws + WS_WUQ), 4, (const float*)a.in[7], scr, r, F.lane); continue; } r -= I_UQ;
        if (r < I_UKV) { transpose_item((const float*)a.in[10], 128, KVW, (bf16*)(ws + WS_WUKV), 0, (const float*)a.in[9], scr, r, F.lane); continue; } r -= I_UKV;
        if (r < I_O) { transpose_item((const float*)a.in[11], DM, DM, (bf16*)(ws + WS_WO), 0, nullptr, scr, r, F.lane); continue; } r -= I_O;
        if (r < NE * I_W1) { const int e = r / I_W1; transpose_item((const float*)a.in[17] + (size_t)e * DM * DE, DM, DE, (bf16*)(ws + WS_W13 + (size_t)e * 512 * DM), 1, nullptr, scr, r % I_W1, F.lane, F8_SW13); continue; } r -= NE * I_W1;
        if (r < NE * I_W1) { const int e = r / I_W1; transpose_item((const float*)a.in[18] + (size_t)e * DM * DE, DM, DE, (bf16*)(ws + WS_W13 + (size_t)e * 512 * DM), 2, nullptr, scr, r % I_W1, F.lane, F8_SW13); continue; } r -= NE * I_W1;
        { const int e = r / I_W2; transpose_item((const float*)a.in[19] + (size_t)e * DE * DM, DE, DM, (bf16*)(ws + WS_W2 + (size_t)e * DM * DE), 0, nullptr, scr, r % I_W2, F.lane, F8_SW2); }
    }
    const int gt = F.bx * NTHR + F.tid, NGT = F.G * NTHR;
    { v4u z = (v4u){0u, 0u, 0u, 0u}; GAS v4u* p = (GAS v4u*)((bf16*)(ws + WS_WIN) + (size_t)INW * DM);
      for (int i = gt; i < (INWP - INW) * DM / 8; i += NGT) p[i] = z; }
    { const float* w_gr = (const float*)a.in[13]; const float* w_er = (const float*)a.in[15]; float* wf = (float*)(ws + WS_WR);
      bf16* wb = (bf16*)wf;
      for (int i = gt; i < 32 * 3 * 64 * 8; i += NGT) { const int ii = i & 7, l = (i >> 3) & 63, ntl = (i >> 9) % 3, s8 = i / 1536;
          const int k = 32 * s8 + 8 * (l >> 4) + ii, nc = 16 * ntl + (l & 15);
          const float w = nc < 4 ? w_gr[k * 4 + nc] : (nc < 36 ? w_er[k * 32 + (nc - 4)] : 0.f);
          const unsigned hi = f2bf(w); const float lo = w - bf2f(hi);
          const size_t base = ((size_t)(s8 * 3 + ntl) * 64 + l) * 16; wb[base + ii] = (bf16)hi; wb[base + 8 + ii] = (bf16)f2bf(lo); }
      if (gt < 48) { const float* b_gr = (const float*)a.in[14]; const float* b_er = (const float*)a.in[16];
          wf[64 * 3 * 64 * 4 + gt] = gt < 4 ? b_gr[gt] : (gt < 36 ? b_er[gt - 4] : 0.f); } }
}

__device__ __forceinline__ void p1_norm1(Frame& F, const Args& a) {
    const float* x = (const float*)a.in[0]; const float* g = (const float*)a.in[5]; const float* mod = (const float*)(a.ws + WS_MOD); bf16* h1 = (bf16*)(a.ws + WS_B);
    const int gw = F.bx * NWAVES + F.wave, NGW = F.G * NWAVES;
    for (int m0 = 4 * gw; m0 < T; m0 += 4 * NGW) {
        const int b = m0 >> 12;
        f32x4 v[4][4];
#pragma unroll
        for (int r = 0; r < 4; ++r) { const GAS f32x4* xr = (const GAS f32x4*)(x + (size_t)(m0 + r) * DM) + F.lane;
#pragma unroll
            for (int j = 0; j < 4; ++j) v[r][j] = __builtin_nontemporal_load(xr + 64 * j); }
        f32x4 gs[4], sh[4];
#pragma unroll
        for (int j = 0; j < 4; ++j) { const int col = 4 * F.lane + 256 * j;
            gs[j] = *(const f32x4*)(g + col) * (*(const f32x4*)(mod + (size_t)b * MODW + DM + col) + 1.0f); sh[j] = *(const f32x4*)(mod + (size_t)b * MODW + col); }
#pragma unroll
        for (int r = 0; r < 4; ++r) { float s = 0.f;
#pragma unroll
            for (int j = 0; j < 4; ++j) s += (v[r][j].x * v[r][j].x + v[r][j].y * v[r][j].y) + (v[r][j].z * v[r][j].z + v[r][j].w * v[r][j].w);
            const float rstd = 1.0f / sqrtf(wave_sum(s) * (1.f / DM) + EPS);
            GAS v2u* o8 = (GAS v2u*)(h1 + (size_t)(m0 + r) * DM) + F.lane;
#pragma unroll
            for (int j = 0; j < 4; ++j) { const f32x4 o = (v[r][j] * rstd) * gs[j] + sh[j]; v2u w; w.x = cvtpk2(o.x, o.y); w.y = cvtpk2(o.z, o.w); o8[64 * j] = w; } }
    }
}

__device__ __forceinline__ float ret_log2g(int h) { return log2f(1.0f - exp2f(-5.0f - (float)h)); }

__device__ __forceinline__ void p7_norm2_router(Frame& F, const Args& a, int rep) {
    unsigned char* ws = a.ws;
    const bf16* x1 = (const bf16*)(ws + WS_A); const float* part = (const float*)(ws + WS_PART); const float* mod = (const float*)(ws + WS_MOD);
    const float* g2n = (const float*)a.in[12]; const float* wf = (const float*)(ws + WS_WR); const float* bias = wf + 64 * 3 * 64 * 4;
    unsigned char* h2 = ws + (rep ? WS_END : WS_B); float* gatew = (float*)(ws + (rep ? WS_END + 130 * MiB : WS_GATEW)); int* tok = (int*)(ws + (rep ? WS_END + 132 * MiB : WS_TOK)); int* slotinfo = (int*)(ws + (rep ? WS_END + 131 * MiB : WS_SLOT)); gu32* cntg = F.ctl + (rep ? CW_CNT2 : CW_CNT);
    int* ptinfo = (int*)(ws + (rep ? WS_END + 133 * MiB : WS_PTI)); gu32* pcntg = F.ctl + (rep ? CW_PCNT + NPAIR * CNT_STRIDE : CW_PCNT);
    const int lane = F.lane, wv = F.wave, row = lane & 15, kq = lane >> 4;
    LAS v4u* Wl = (LAS v4u*)(F.lds);
    LAS float* mw = (LAS float*)(F.lds + 98304);
    LAS float* lgs = (LAS float*)(F.lds + 106496);
    LAS int* as_e = (LAS int*)(F.lds);
    LAS int* as_rank = as_e + 512; LAS int* as_entry = as_rank + 512;
    LAS int* cntL = as_entry + 512; LAS int* baseL = cntL + 32;
    LAS int* tp_pid = baseL + 32; LAS int* tp_rank = tp_pid + 256; LAS int* tp_tok = tp_rank + 256;
    LAS int* pcntL = tp_tok + 256; LAS int* pbaseL = pcntL + 128;
    for (int rb = F.bx; rb < T / 256; rb += F.G) {
        const int b = rb >> 4, t0 = b * SEQ + (rb & 15) * 16;
        if (F.tid < 256) { const float* mb = mod + (size_t)b * MODW; const int col = 4 * F.tid;
            *(LAS f32x4*)(mw + col) = *(const f32x4*)(g2n + col) * (*(const f32x4*)(mb + 4 * DM + col) + 1.0f); *(LAS f32x4*)(mw + DM + col) = *(const f32x4*)(mb + 3 * DM + col); }
        float rstd[2];
#pragma unroll
        for (int h = 0; h < 2; ++h) { const f32x4* pp = (const f32x4*)(part + (size_t)(t0 + 256 * (wv + 8 * h) + row) * 16); const f32x4 p0 = pp[0], p1 = pp[1], p2 = pp[2], p3 = pp[3];
            const float ss = ((p0.x + p0.y) + (p0.z + p0.w)) + ((p1.x + p1.y) + (p1.z + p1.w)) + ((p2.x + p2.y) + (p2.z + p2.w)) + ((p3.x + p3.y) + (p3.z + p3.w));
            rstd[h] = 1.0f / sqrtf(ss * (1.f / DM) + EPS); }
        const unsigned lo = (unsigned)(row * DM + 8 * kq);
        const bf16* xw0 = x1 + (size_t)(t0 + 256 * wv) * DM; unsigned char* hw0 = h2 + (size_t)(t0 + 256 * wv) * DM;
        constexpr int XD = 8;
        v4u xq[XD];
#pragma unroll
        for (int u = 0; u < XD; ++u) xq[u] = __builtin_nontemporal_load((const GAS v4u*)(xw0 + 32 * u + lo));
        f32x4 acc[2][3];
#pragma unroll
        for (int h = 0; h < 2; ++h)
#pragma unroll
            for (int ntl = 0; ntl < 3; ++ntl) acc[h][ntl] = (f32x4){0.f, 0.f, 0.f, 0.f};
#pragma unroll 1
        for (int p = 0; p < 2; ++p) {
            __syncthreads();
            { const v4u* src = (const v4u*)wf + (size_t)p * 6144 + F.tid;
#pragma unroll
              for (int i = 0; i < 12; ++i) Wl[F.tid + 512 * i] = src[512 * i]; }
            __syncthreads();
#pragma unroll
            for (int h = 0; h < 2; ++h) {
#pragma unroll 1
                for (int g2 = 0; g2 < 2; ++g2) {
                    const size_t cur = (size_t)h * 2048 * DM + 512 * p + 256 * g2;
                    const size_t nxt = g2 == 0 ? cur + 256 : (h == 0 ? (size_t)2048 * DM + 512 * p : (p == 0 ? (size_t)512 : cur));
                    const LAS v4u* wl = Wl + g2 * 3072 + lane * 2;
#pragma unroll
                    for (int u = 0; u < 8; ++u) { const int col = 512 * p + 256 * g2 + 32 * u;
                        const v4u xw = xq[u]; const f32x4 xa = (f32x4){bflo(xw.x), bfhi(xw.x), bflo(xw.y), bfhi(xw.y)}, xb = (f32x4){bflo(xw.z), bfhi(xw.z), bflo(xw.w), bfhi(xw.w)};
                        xq[u] = __builtin_nontemporal_load((const GAS v4u*)(xw0 + nxt + 32 * u + lo));
                        const LAS float* mg = mw + 8 * kq + col;
                        const f32x4 ga = *(const LAS f32x4*)(mg), gb = *(const LAS f32x4*)(mg + 4), sa = *(const LAS f32x4*)(mg + DM), sb = *(const LAS f32x4*)(mg + DM + 4);
                        const f32x4 ha = (xa * rstd[h]) * ga + sa, hb = (xb * rstd[h]) * gb + sb;
                        v4u hh; hh.x = cvtpk2(ha.x, ha.y); hh.y = cvtpk2(ha.z, ha.w); hh.z = cvtpk2(hb.x, hb.y); hh.w = cvtpk2(hb.z, hb.w);
                        { v2u h8; h8.x = cvt4_fp8(ha.x, ha.y, ha.z, ha.w); h8.y = cvt4_fp8(hb.x, hb.y, hb.z, hb.w); *(GAS v2u*)(hw0 + cur + 32 * u + lo) = h8; }
                        v4u hl; hl.x = cvtpk2(ha.x - bflo(hh.x), ha.y - bfhi(hh.x)); hl.y = cvtpk2(ha.z - bflo(hh.y), ha.w - bfhi(hh.y)); hl.z = cvtpk2(hb.x - bflo(hh.z), hb.y - bfhi(hh.z)); hl.w = cvtpk2(hb.z - bflo(hh.w), hb.w - bfhi(hh.w));
                        const bf16x8 ah = __builtin_bit_cast(bf16x8, hh), al = __builtin_bit_cast(bf16x8, hl);
#pragma unroll
                        for (int ntl = 0; ntl < 3; ++ntl) { const v4u wh = wl[(u * 3 + ntl) * 128], wo = wl[(u * 3 + ntl) * 128 + 1];
                            const bf16x8 bh = __builtin_bit_cast(bf16x8, wh), bl = __builtin_bit_cast(bf16x8, wo);
                            acc[h][ntl] = __builtin_amdgcn_mfma_f32_16x16x32_bf16(ah, bh, acc[h][ntl], 0, 0, 0); acc[h][ntl] = __builtin_amdgcn_mfma_f32_16x16x32_bf16(al, bh, acc[h][ntl], 0, 0, 0);
                            acc[h][ntl] = __builtin_amdgcn_mfma_f32_16x16x32_bf16(ah, bl, acc[h][ntl], 0, 0, 0); } }
                }
            }
        }
#pragma unroll
        for (int h = 0; h < 2; ++h)
#pragma unroll
            for (int ntl = 0; ntl < 3; ++ntl)
#pragma unroll
                for (int r = 0; r < 4; ++r) if (16 * ntl + row < 40) lgs[(16 * (wv + 8 * h) + 4 * kq + r) * 40 + 16 * ntl + row] = acc[h][ntl][r];
        __syncthreads();
        if (F.tid < 32) cntL[F.tid] = 0;
        if (F.tid >= 64 && F.tid < 64 + NPAIR) pcntL[F.tid - 64] = 0;
        __syncthreads();
        if (F.tid < 256) {
            const LAS float* l = lgs + F.tid * 40; const int tt = t0 + 256 * (F.tid >> 4) + (F.tid & 15);
            float lv[36];
#pragma unroll
            for (int j = 0; j < 36; ++j) lv[j] = l[j] + bias[j];
            float gm = lv[0]; int gi = 0;
#pragma unroll
            for (int j = 1; j < 4; ++j) if (lv[j] > gm) { gm = lv[j]; gi = j; }
            float se = 0.f;
#pragma unroll
            for (int j = 0; j < 4; ++j) se += __expf(lv[j] - gm);
            const float ptop = 1.0f / se;
            float le[8];
#pragma unroll
            for (int j = 0; j < 8; ++j) le[j] = gi == 0 ? lv[4 + j] : gi == 1 ? lv[12 + j] : gi == 2 ? lv[20 + j] : lv[28 + j];
            float v1 = le[0]; int i1 = 0;
#pragma unroll
            for (int j = 1; j < 8; ++j) if (le[j] > v1) { v1 = le[j]; i1 = j; }
            float v2 = -3.0e38f; int i2 = 0;
#pragma unroll
            for (int j = 0; j < 8; ++j) if (j != i1 && le[j] > v2) { v2 = le[j]; i2 = j; }
            const float ex = __expf(v2 - v1), g0 = ptop / (1.0f + ex), g1 = ptop * ex / (1.0f + ex);
            const int e0 = gi * 8 + i1, e1 = gi * 8 + i2;
            *(f32x2*)(gatew + (size_t)tt * 2) = (f32x2){g0, g1};
            const int a0 = F.tid * 2;
            as_e[a0] = e0; as_rank[a0] = __hip_atomic_fetch_add(cntL + e0, 1, __ATOMIC_RELAXED, __HIP_MEMORY_SCOPE_WORKGROUP); as_entry[a0] = tt * 2;
            as_e[a0 + 1] = e1; as_rank[a0 + 1] = __hip_atomic_fetch_add(cntL + e1, 1, __ATOMIC_RELAXED, __HIP_MEMORY_SCOPE_WORKGROUP); as_entry[a0 + 1] = tt * 2 + 1;
            { const int pa = i1 < i2 ? i1 : i2, pb = i1 < i2 ? i2 : i1, pid = gi * 28 + pa * 8 - (pa * (pa + 1)) / 2 + (pb - pa - 1);
              tp_pid[F.tid] = pid; tp_rank[F.tid] = __hip_atomic_fetch_add(pcntL + pid, 1, __ATOMIC_RELAXED, __HIP_MEMORY_SCOPE_WORKGROUP); tp_tok[F.tid] = tt | ((i1 > i2) ? (1 << 30) : 0); }
        }
        __syncthreads();
        if (F.tid < 32) { const int c = cntL[F.tid]; baseL[F.tid] = c > 0 ? (int)__hip_atomic_fetch_add(cntg + F.tid * CNT_STRIDE, (unsigned)c, RLX_AGENT) : 0; }
        else if (F.tid >= 64 && F.tid < 64 + NPAIR) { const int q = F.tid - 64; const int c = pcntL[q]; pbaseL[q] = c > 0 ? (int)__hip_atomic_fetch_add(pcntg + q * CNT_STRIDE, (unsigned)c, RLX_AGENT) : 0; }
        __syncthreads();
        if (F.tid < 256) { const int tv2 = tp_tok[F.tid]; const int pid = tp_pid[F.tid]; ptinfo[tv2 & 0x3fffffff] = (tv2 & (1 << 30)) | (pid * 65536 + pbaseL[pid] + tp_rank[F.tid]); }
        { const int en = as_entry[F.tid]; const int e = as_e[F.tid]; const int idx = e * CAP + baseL[e] + as_rank[F.tid]; tok[idx] = en; slotinfo[en] = idx; }
        __syncthreads();
    }
}

__device__ __forceinline__ void p10_final(Frame& F, const Args& a, const LAS int* ppre) {
    const bf16* x1 = (const bf16*)(a.ws + WS_A); const unsigned char* y = a.ws + WS_D; const float* mod = (const float*)(a.ws + WS_MOD); const float* fg = (const float*)a.in[20];
    const int* ptinfo = (const int*)(a.ws + WS_PTI);
    const int gw = F.bx * NWAVES + F.wave, NGW = F.G * NWAVES;
#ifdef SELFCHECK
    float chk_scale; { const float* chk = (const float*)(F.ctl + 20480); const float e = (SELFCHECK == 1) ? sqrtf(chk[0] / chk[1]) : (SELFCHECK == 2) ? sqrtf(chk[2] / chk[3]) : sqrtf(chk[4] / chk[5]); chk_scale = 1.0f + 10.0f * e; }
#endif
    typedef int i32x2 __attribute__((ext_vector_type(2)));
    const int step = 2 * NGW;
    int m0 = 2 * gw;
    if (m0 >= T) return;
    f32x4 gf[4];
#pragma unroll
    for (int j = 0; j < 4; ++j) gf[j] = *(const f32x4*)(fg + 4 * F.lane + 256 * j);
    v2u xw[2][4]; unsigned ya[2][4]; f32x4 g2[4];
#define P10_ISSUE(M, CC) do { \
        _Pragma("unroll") for (int r = 0; r < 2; ++r) { const GAS v2u* xr = (const GAS v2u*)(x1 + (size_t)((M) + r) * DM) + F.lane; \
            const int c0 = __builtin_amdgcn_readfirstlane((CC)[r]) & 0x3fffffff; \
            const size_t s0 = (size_t)(256 * ppre[c0 >> 16] + (c0 & 65535)); \
            const GAS unsigned* y0 = (const GAS unsigned*)(y + s0 * DM) + F.lane; \
            _Pragma("unroll") for (int j = 0; j < 4; ++j) { xw[r][j] = __builtin_nontemporal_load(xr + 64 * j); ya[r][j] = __builtin_nontemporal_load(y0 + 64 * j); } } \
        _Pragma("unroll") for (int j = 0; j < 4; ++j) g2[j] = *(const f32x4*)(mod + (size_t)((M) >> 12) * MODW + 5 * DM + 4 * F.lane + 256 * j); } while (0)
    i32x2 c2;
    { const i32x2 c1 = *(const i32x2*)(ptinfo + m0); const int m2 = m0 + step < T ? m0 + step : m0; c2 = *(const i32x2*)(ptinfo + m2); P10_ISSUE(m0, c1); }
    auto body = [&](int m0) __attribute__((always_inline)) {
        f32x4 v[2][4], yy[2][4], gc[4];
#pragma unroll
        for (int j = 0; j < 4; ++j) gc[j] = g2[j];
#pragma unroll
        for (int r = 0; r < 2; ++r)
#pragma unroll
            for (int j = 0; j < 4; ++j) { const v2u w = xw[r][j]; v[r][j] = (f32x4){bflo(w.x), bfhi(w.x), bflo(w.y), bfhi(w.y)}; yy[r][j] = fp8x4_f32(ya[r][j]) * (1.0f / F8_SY); }
        { const int mn = m0 + step < T ? m0 + step : m0; const i32x2 cnx = c2; const int m3 = mn + step < T ? mn + step : mn;
          c2 = *(const i32x2*)(ptinfo + m3); P10_ISSUE(mn, cnx); }
#pragma unroll
        for (int r = 0; r < 2; ++r) { float s = 0.f;
#pragma unroll
            for (int j = 0; j < 4; ++j) { v[r][j] = v[r][j] + gc[j] * yy[r][j]; s += (v[r][j].x * v[r][j].x + v[r][j].y * v[r][j].y) + (v[r][j].z * v[r][j].z + v[r][j].w * v[r][j].w); }
            const float rstd = 1.0f / sqrtf(wave_sum(s) * (1.f / DM) + EPS);
            GAS f32x4* o = (GAS f32x4*)(a.out + (size_t)(m0 + r) * DM) + F.lane;
#ifdef SELFCHECK
            for (int j = 0; j < 4; ++j) o[64 * j] = (v[r][j] * (rstd * chk_scale)) * gf[j]; }
#else
            for (int j = 0; j < 4; ++j) __builtin_nontemporal_store((v[r][j] * rstd) * gf[j], o + 64 * j); }
#endif
    };
    body(m0); m0 += step;
    for (; m0 < T; m0 += step) body(m0);
#undef P10_ISSUE
}
namespace mix {
__device__ __forceinline__ int crow(int r, int hi) { return (r & 3) + 8 * (r >> 2) + 4 * hi; }
__device__ __forceinline__ unsigned cvtpk(float lo, float hi) { return cvtpk2(lo, hi); }
typedef short v4i16_t __attribute__((ext_vector_type(4)));
__device__ __forceinline__ s16x4 vtr(const LAS unsigned char* p) { return __builtin_bit_cast(s16x4, __builtin_amdgcn_ds_read_tr16_b64_v4i16((LAS v4i16_t*)p)); }
__device__ __forceinline__ bf16x8 frag2(s16x4 lo, s16x4 hi) { return (bf16x8){lo[0], lo[1], lo[2], lo[3], hi[0], hi[1], hi[2], hi[3]}; }
__device__ __forceinline__ float swap_add(float v) { auto rr = __builtin_amdgcn_permlane32_swap(__float_as_uint(v), __float_as_uint(v), false, false); return __uint_as_float(rr[0]) + __uint_as_float(rr[1]); }
__device__ __forceinline__ float swap_max(float v) { auto rr = __builtin_amdgcn_permlane32_swap(__float_as_uint(v), __float_as_uint(v), false, false); return fmaxf(__uint_as_float(rr[0]), __uint_as_float(rr[1])); }
__device__ __forceinline__ void glds16_asm(const void* gsrc, unsigned lds_dst) { unsigned keep;
    asm volatile("s_mov_b32 %0, m0\n\ts_mov_b32 m0, %2\n\ts_nop 0\n\tglobal_load_lds_dwordx4 %1, off\n\ts_mov_b32 m0, %0" : "=&s"(keep) : "v"(gsrc), "s"(lds_dst) : "memory"); }
#define GLDS16(gp, lp) glds16_asm((const void*)(gp), (unsigned)__builtin_amdgcn_readfirstlane((int)(unsigned)(uintptr_t)(lp)))

constexpr int A_KS = 8192, A_VS = 4096, A_V0 = 32768;
typedef int v8i_t __attribute__((ext_vector_type(8))); typedef int v4i_t __attribute__((ext_vector_type(4)));
__device__ __forceinline__ void attn_unit(LAS unsigned char* lds, int b, int h, int qb, const bf16* q, const unsigned char* vt8, const unsigned char* k8, const bf16* proj, const int* positions, bf16* omix) {
    const int tid = threadIdx.x, lane = tid & 63, r32 = lane & 31, hi = lane >> 5; const int wid = __builtin_amdgcn_readfirstlane(tid >> 6);
    const size_t rowbase = (size_t)b * SEQ; const int q0 = qb * 256;
    const int NT = (q0 + 256) / 64;
    const unsigned char* ksrc = wid < 4 ? k8 + (rowbase + lane) * 512 + h * 64 + 16 * wid : (const unsigned char*)(proj + (rowbase + lane) * INWP + C_KR + 8 * (wid - 4));
    const size_t kstr = wid < 4 ? (size_t)64 * 512 : (size_t)64 * INWP * 2;
    const unsigned char* vsrc = vt8 + (size_t)((b * 8 + h) * 64) * 4096 + (wid & 3) * 1024 + lane * 16;
    LAS unsigned char* kd0 = lds + wid * 1024; LAS unsigned char* vd0 = lds + A_V0 + (wid & 3) * 1024;
#define ADMA(t) do { const int s_ = (t) & 3; GLDS16(ksrc + (size_t)(t) * kstr, kd0 + s_ * A_KS); if (wid < 4) GLDS16(vsrc + (size_t)(t) * 4096, vd0 + s_ * A_VS); } while (0)
    ADMA(0); ADMA(1);
    const size_t qrow = rowbase + q0 + wid * 32 + r32;
    const float C2 = 0.10206207261596575f * 1.4426950408889634f;
    bf16x8 qr[6]; v8i_t q8;
    const int sK = (int)F8_E1, sQ = (int)F8_E8;
    { const bf16* qp = q + qrow * QW + h * 96 + 8 * hi; v4u raw[6];
      const bf16* qn = q + qrow * QW + h * 96 + 32 * hi;
#pragma unroll
      for (int d0 = 0; d0 < 4; ++d0) raw[d0] = *(const GAS v4u*)(qn + 8 * d0);
#pragma unroll
      for (int d0 = 4; d0 < 6; ++d0) raw[d0] = *(const GAS v4u*)(qp + 16 * d0);
      const float pos = (float)positions[qrow];
      const float C8 = C2 * 8.0f;
#pragma unroll
      for (int d0 = 0; d0 < 4; ++d0) {
          q8[2 * d0] = (int)cvt4_fp8(bflo(raw[d0][0]) * C8, bfhi(raw[d0][0]) * C8, bflo(raw[d0][1]) * C8, bfhi(raw[d0][1]) * C8);
          q8[2 * d0 + 1] = (int)cvt4_fp8(bflo(raw[d0][2]) * C8, bfhi(raw[d0][2]) * C8, bflo(raw[d0][3]) * C8, bfhi(raw[d0][3]) * C8); }
      v4u o1, o2;
#pragma unroll
      for (int j = 0; j < 4; ++j) {
#pragma unroll
          for (int e = 0; e < 2; ++e) { const int f = 8 * e + 4 * hi + j; float tt = pos * (exp2f(-(float)f * (13.287712379549449f / 16.f)) * 0.15915494309189535f); tt -= floorf(tt);
              const float sn = __builtin_amdgcn_sinf(tt), cs = __builtin_amdgcn_cosf(tt);
              const unsigned w = e ? raw[5][j] : raw[4][j]; const float x1 = bflo(w), x2 = bfhi(w);
              const unsigned r = cvtpk((x1 * cs - x2 * sn) * C2, (x1 * sn + x2 * cs) * C2);
              if (e) o2[j] = r; else o1[j] = r; } }
      qr[4] = __builtin_bit_cast(bf16x8, o1); qr[5] = __builtin_bit_cast(bf16x8, o2); }
    float mhat = 0.f, l_run = 0.f; f32x16 o[2]; o[0] = f32x16{}; o[1] = f32x16{};
    f32x16 negm = f32x16{};
    const int qrel = wid * 32 + r32;
    const int voa = r32 * 64 + (((2 * hi) ^ ((r32 >> 2) & 3)) << 4), vob = r32 * 64 + (((2 * hi + 1) ^ ((r32 >> 2) & 3)) << 4);
    f32x16 pA0, pA1, pB0, pB1; v8i_t pw; float resc_f = 1.0f; bool resc = false;
#define SGB(mask, n) __builtin_amdgcn_sched_group_barrier(mask, n, 0)
#define ATOP(t) do { if ((t) + 1 < NT) { if (wid < 4) asm volatile("s_waitcnt vmcnt(2) lgkmcnt(0)\n\ts_barrier" ::: "memory"); else asm volatile("s_waitcnt vmcnt(1) lgkmcnt(0)\n\ts_barrier" ::: "memory"); } else WAIT_BAR0(); if ((t) + 2 < NT) ADMA((t) + 2); } while (0)
#define FP8QK(C, KA, KB) asm volatile("v_mfma_scale_f32_32x32x64_f8f6f4 %0, %1, %2, %5, %3, %4 op_sel_hi:[0,0,0]" : "=&v"(C) : "v"(__builtin_shufflevector(KA, KB, 0, 1, 2, 3, 4, 5, 6, 7)), "v"(q8), "v"(sK), "v"(sQ), "v"(negm))
#define AQK(C0, C1, t) do { const LAS unsigned char* kn_ = lds + ((t) & 3) * A_KS + hi * 2048 + r32 * 16; const LAS unsigned char* kr_ = lds + ((t) & 3) * A_KS + 4096 + hi * 1024 + r32 * 16; \
        const v4i_t n0a_ = *(const LAS v4i_t*)(kn_), n0b_ = *(const LAS v4i_t*)(kn_ + 1024), n1a_ = *(const LAS v4i_t*)(kn_ + 512), n1b_ = *(const LAS v4i_t*)(kn_ + 1536); \
        const bf16x8 r0_ = *(const LAS bf16x8*)(kr_), r1_ = *(const LAS bf16x8*)(kr_ + 512), r2_ = *(const LAS bf16x8*)(kr_ + 2048), r3_ = *(const LAS bf16x8*)(kr_ + 2560); \
        FP8QK(C0, n0a_, n0b_); FP8QK(C1, n1a_, n1b_); \
        C0 = __builtin_amdgcn_mfma_f32_32x32x16_bf16(r0_, qr[4], C0, 0, 0, 0); C1 = __builtin_amdgcn_mfma_f32_32x32x16_bf16(r1_, qr[4], C1, 0, 0, 0); \
        C0 = __builtin_amdgcn_mfma_f32_32x32x16_bf16(r2_, qr[5], C0, 0, 0, 0); C1 = __builtin_amdgcn_mfma_f32_32x32x16_bf16(r3_, qr[5], C1, 0, 0, 0); } while (0)
#define PK8(a, b, c, d) __builtin_amdgcn_cvt_pk_fp8_f32((c), (d), __builtin_amdgcn_cvt_pk_fp8_f32((a), (b), 0, false), true)
#define ASUMPACK(P0, P1) do { float s0_ = P0[0] + P0[1], s1_ = P1[0] + P1[1]; \
        _Pragma("unroll") for (int r = 2; r < 16; ++r) { s0_ += P0[r]; s1_ += P1[r]; } l_run += s0_ + s1_; \
        _Pragma("unroll") for (int j = 0; j < 4; ++j) { pw[j] = PK8(P0[4 * j], P0[4 * j + 1], P0[4 * j + 2], P0[4 * j + 3]); pw[4 + j] = PK8(P1[4 * j], P1[4 * j + 1], P1[4 * j + 2], P1[4 * j + 3]); } } while (0)
#define AMASK(C0, C1, t) do { const int jb_ = (t) - (NT - 4); if (jb_ >= 0) { const int kb0_ = 64 * jb_ + 4 * hi; \
        _Pragma("unroll") for (int r = 0; r < 16; ++r) { const int kvr_ = kb0_ + (r & 3) + 8 * (r >> 2); if (kvr_ > qrel) C0[r] = -INFINITY; if (kvr_ + 32 > qrel) C1[r] = -INFINITY; } } } while (0)
#define ADECIDE(C0, C1, FIRST) do { \
        float ra_ = fmaxf(fmaxf(C0[0], C0[1]), C1[0]), rb_ = fmaxf(fmaxf(C0[2], C0[3]), C1[1]); ra_ = fmaxf(fmaxf(ra_, C1[2]), C1[3]); \
        _Pragma("unroll") for (int r = 4; r < 16; r += 4) { ra_ = fmaxf(fmaxf(ra_, C0[r]), C0[r + 1]); rb_ = fmaxf(fmaxf(rb_, C0[r + 2]), C0[r + 3]); ra_ = fmaxf(fmaxf(ra_, C1[r]), C1[r + 1]); rb_ = fmaxf(fmaxf(rb_, C1[r + 2]), C1[r + 3]); } \
        const float rm_ = swap_max(fmaxf(ra_, rb_)); resc = false; \
        if ((FIRST) || __builtin_expect(__any(rm_ > 8.0f), 0)) { const float dl_ = (FIRST) ? rm_ : fmaxf(rm_, 0.f); \
            resc_f = (FIRST) ? 1.0f : __builtin_amdgcn_exp2f(-dl_); mhat += dl_; l_run *= resc_f; resc = true; \
            _Pragma("unroll") for (int r = 0; r < 16; ++r) { C0[r] -= dl_; C1[r] -= dl_; negm[r] = -mhat; } } } while (0)
#define AEXP(C0, C1) do { _Pragma("unroll") for (int r = 0; r < 16; ++r) { C0[r] = __builtin_amdgcn_exp2f(C0[r]); C1[r] = __builtin_amdgcn_exp2f(C1[r]); } } while (0)
#define FP8PV(D0, VA, VB) asm volatile("v_mfma_scale_f32_32x32x64_f8f6f4 %0, %1, %2, %0, %3, %3 op_sel_hi:[0,0,0]" : "+v"(o[D0]) : "v"(__builtin_shufflevector(VA, VB, 0, 1, 2, 3, 4, 5, 6, 7)), "v"(pw), "v"(sK))
#define ONOP() asm volatile("s_nop 15\n\ts_nop 7" ::: "memory")
#define APV(vs) do { const LAS unsigned char* vp_ = lds + A_V0 + (vs) * A_VS; \
        const v4i_t a0_ = *(const LAS v4i_t*)(vp_ + voa), b0_ = *(const LAS v4i_t*)(vp_ + vob), a1_ = *(const LAS v4i_t*)(vp_ + 2048 + voa), b1_ = *(const LAS v4i_t*)(vp_ + 2048 + vob); \
        FP8PV(0, a0_, b0_); FP8PV(1, a1_, b1_); ONOP(); } while (0)
#define ARESC() do { if (resc) { ONOP(); _Pragma("unroll") for (int r = 0; r < 16; ++r) { o[0][r] *= resc_f; o[1][r] *= resc_f; } } } while (0)
#define SBAR() __builtin_amdgcn_sched_barrier(0)
#define PIN(x) asm volatile("" : "+v"(x))
#define ASTEP(C0, C1, P0, P1, t) do { ATOP(t); \
        v4i_t kn_[4]; bf16x8 kf_[4]; { const LAS unsigned char* kb_ = lds + ((t) & 3) * A_KS + hi * 2048 + r32 * 16; const LAS unsigned char* kr_ = lds + ((t) & 3) * A_KS + 4096 + hi * 1024 + r32 * 16; \
            kn_[0] = *(const LAS v4i_t*)(kb_); kn_[1] = *(const LAS v4i_t*)(kb_ + 1024); kn_[2] = *(const LAS v4i_t*)(kb_ + 512); kn_[3] = *(const LAS v4i_t*)(kb_ + 1536); \
            kf_[0] = *(const LAS bf16x8*)(kr_); kf_[1] = *(const LAS bf16x8*)(kr_ + 512); kf_[2] = *(const LAS bf16x8*)(kr_ + 2048); kf_[3] = *(const LAS bf16x8*)(kr_ + 2560); } \
        SBAR(); \
        ASUMPACK(P0, P1); PIN(l_run); PIN(pw); \
        SBAR(); \
        FP8QK(C0, kn_[0], kn_[1]); FP8QK(C1, kn_[2], kn_[3]); \
        C0 = __builtin_amdgcn_mfma_f32_32x32x16_bf16(kf_[0], qr[4], C0, 0, 0, 0); C1 = __builtin_amdgcn_mfma_f32_32x32x16_bf16(kf_[1], qr[4], C1, 0, 0, 0); \
        C0 = __builtin_amdgcn_mfma_f32_32x32x16_bf16(kf_[2], qr[5], C0, 0, 0, 0); C1 = __builtin_amdgcn_mfma_f32_32x32x16_bf16(kf_[3], qr[5], C1, 0, 0, 0); \
        SBAR(); \
        v4i_t va_[2], vb_[2]; { const LAS unsigned char* vp_ = lds + A_V0 + (((t) - 1) & 3) * A_VS;     \
            va_[0] = *(const LAS v4i_t*)(vp_ + voa); vb_[0] = *(const LAS v4i_t*)(vp_ + vob); va_[1] = *(const LAS v4i_t*)(vp_ + 2048 + voa); vb_[1] = *(const LAS v4i_t*)(vp_ + 2048 + vob); } \
        SBAR(); \
        AMASK(C0, C1, t); ADECIDE(C0, C1, false); \
        SBAR(); \
        FP8PV(0, va_[0], vb_[0]); \
        _Pragma("unroll") for (int r = 0; r < 16; ++r) C0[r] = __builtin_amdgcn_exp2f(C0[r]); PIN(C0); \
        SBAR(); \
        FP8PV(1, va_[1], vb_[1]); \
        _Pragma("unroll") for (int r = 0; r < 16; ++r) C1[r] = __builtin_amdgcn_exp2f(C1[r]); PIN(C1); \
        SBAR(); \
        ARESC(); } while (0)
    ATOP(0); AQK(pA0, pA1, 0); AMASK(pA0, pA1, 0); ADECIDE(pA0, pA1, true); AEXP(pA0, pA1); resc = false;
    for (int t = 1; t + 2 < NT; t += 2) { ASTEP(pB0, pB1, pA0, pA1, t); ASTEP(pA0, pA1, pB0, pB1, t + 1); }
    ASTEP(pB0, pB1, pA0, pA1, NT - 1);
    ASUMPACK(pB0, pB1); APV((NT - 1) & 3);
#undef SGB
#undef ATOP
#undef ASUMPACK
#undef AMASK
#undef ADECIDE
#undef AEXP
#undef APV
#undef FP8PV
#undef ONOP
#undef PK8
#undef ARESC
#undef ASTEP
#undef SBAR
#undef PIN
    l_run = swap_add(l_run);
    const float inv = 1.0f / l_run;
    bf16* op = omix + qrow * DM + h * 64 + 4 * hi;
#pragma unroll
    for (int d0 = 0; d0 < 2; ++d0)
#pragma unroll
        for (int a4 = 0; a4 < 4; ++a4) { v2u w; w.x = cvtpk(o[d0][4 * a4] * inv, o[d0][4 * a4 + 1] * inv); w.y = cvtpk(o[d0][4 * a4 + 2] * inv, o[d0][4 * a4 + 3] * inv);
            *(GAS v2u*)(op + 32 * d0 + 8 * a4) = w; }
    asm volatile("s_waitcnt lgkmcnt(0)\n\ts_barrier" ::: "memory");
#undef ADMA
#undef AQK
#undef FP8QK
}

constexpr int R_STG = 65536, R_K = 16384, R_V = 32768, R_ST = 131072, R_STAT = 147456;
__device__ __forceinline__ void ret_unit(LAS unsigned char* lds, int b, int hh, const bf16* proj, bf16* omix) {
    const int tid = threadIdx.x, lane = tid & 63, r32 = lane & 31, hi = lane >> 5; const int wid = __builtin_amdgcn_readfirstlane(tid >> 6);
    const int qbk = wid & 3, dvh = wid >> 2;
    const size_t rowbase = (size_t)b * SEQ;
    const float g128 = exp2f(128.0f * ret_log2g(hh));
    for (int i = tid; i < 16384 / 16; i += NTHR) *(LAS v4u*)(lds + R_ST + i * 16) = (v4u){0u, 0u, 0u, 0u};
    f32x16 st = f32x16{};
    const bf16* qsrc = proj + (rowbase + lane) * INWP + C_RQ + hh * 64 + 8 * wid;
    const bf16* ksrc = proj + (rowbase + lane) * INWP + C_RK + hh * 64 + 8 * wid;
    const bf16* vsrc = proj + (rowbase + (lane >> 2)) * INWP + C_RV + hh * 128 + (lane & 3) * 8;
#define RDMA(n, s) do { const size_t ro_ = (size_t)(n) * 128 * INWP; LAS unsigned char* sb_ = lds + (s) * R_STG; \
        GLDS16(qsrc + ro_, sb_ + wid * 2048); GLDS16(qsrc + ro_ + 64 * INWP, sb_ + wid * 2048 + 1024); \
        GLDS16(ksrc + ro_, sb_ + R_K + wid * 2048); GLDS16(ksrc + ro_ + 64 * INWP, sb_ + R_K + wid * 2048 + 1024); \
        _Pragma("unroll") for (int pq_ = 0; pq_ < 4; ++pq_) { const int pc_ = wid + 8 * pq_, cg_ = pc_ >> 3, rg_ = pc_ & 7; \
            GLDS16(vsrc + ro_ + (size_t)(16 * rg_) * INWP + cg_ * 32, sb_ + R_V + cg_ * 8192 + rg_ * 1024); } } while (0)
    RDMA(0, 0);
    const int g1 = (lane >> 4) & 1, qq = (lane & 15) >> 2, pp = lane & 3;
    const int tr_v = (4 * hi + qq) * 64 + 32 * g1 + 8 * pp;
    const int tr_n = (8 * hi + qq) * 64 + 32 * g1 + 8 * pp;
    const int tr_k = (8 * hi + qq) * 16 + (2 * g1 + (pp >> 1)) * 2048 + (pp & 1) * 8;
    for (int n = 0; n < 32; ++n) {
        const int s = n & 1;
        WAIT_BAR0();
        if (n + 1 < 32) RDMA(n + 1, s ^ 1);
        const LAS unsigned char* sb = lds + s * R_STG;
        const size_t trow = rowbase + (size_t)n * 128 + 32 * qbk + r32;
        v2u grr[2][4];
        { const bf16* gp = proj + trow * INWP + C_RG + hh * 128 + 64 * dvh + 4 * hi;
#pragma unroll
          for (int d0 = 0; d0 < 2; ++d0)
#pragma unroll
              for (int a4 = 0; a4 < 4; ++a4) grr[d0][a4] = *(const GAS v2u*)(gp + 32 * d0 + 8 * a4); }
#define RSBAR() __builtin_amdgcn_sched_barrier(0)
        bf16x8 qf[4]; bf16x8 kfr[4][4];
#pragma unroll
        for (int k = 0; k < 4; ++k) qf[k] = *(const LAS bf16x8*)(sb + (2 * k + hi) * 2048 + (32 * qbk + r32) * 16);
#pragma unroll
        for (int jt = 0; jt < 4; ++jt)
#pragma unroll
            for (int k = 0; k < 4; ++k) kfr[jt][k] = *(const LAS bf16x8*)(sb + R_K + (2 * k + hi) * 2048 + (32 * jt + r32) * 16);
        RSBAR();
        v4u pw[4][2];
#pragma unroll
        for (int jt = 0; jt < 4; ++jt) {
            f32x16 p = __builtin_amdgcn_mfma_f32_32x32x16_bf16(kfr[jt][0], qf[0], f32x16{}, 0, 0, 0);
#pragma unroll
            for (int k = 1; k < 4; ++k) p = __builtin_amdgcn_mfma_f32_32x32x16_bf16(kfr[jt][k], qf[k], p, 0, 0, 0);
            const int dq = 32 * (qbk - jt) + r32;
#pragma unroll
            for (int r = 0; r < 16; ++r) if (crow(r, hi) > dq) p[r] = 0.f;
#pragma unroll
            for (int j = 0; j < 4; ++j) { pw[jt][0][j] = cvtpk(p[2 * j], p[2 * j + 1]); pw[jt][1][j] = cvtpk(p[8 + 2 * j], p[9 + 2 * j]); }
        }
        RSBAR();
        f32x16 o[2]; o[0] = f32x16{}; o[1] = f32x16{};
#pragma unroll
        for (int d0 = 0; d0 < 2; ++d0) {
            const LAS unsigned char* vb = sb + R_V + (2 * dvh + d0) * 8192 + tr_v; const LAS unsigned char* stb = lds + R_ST + (2 * dvh + d0) * 4096 + tr_n;
            s16x4 va[8], vc[8], sa[4], sc[4];
#pragma unroll
            for (int i = 0; i < 8; ++i) { const LAS unsigned char* vp = vb + (16 * i) * 64; va[i] = vtr(vp); vc[i] = vtr(vp + 512); }
#pragma unroll
            for (int k = 0; k < 4; ++k) { const LAS unsigned char* sp = stb + (16 * k) * 64; sa[k] = vtr(sp); sc[k] = vtr(sp + 256); }
            RSBAR();
#pragma unroll
            for (int i = 0; i < 8; ++i) o[d0] = __builtin_amdgcn_mfma_f32_32x32x16_bf16(frag2(va[i], vc[i]), __builtin_bit_cast(bf16x8, pw[i >> 1][i & 1]), o[d0], 0, 0, 0);
#pragma unroll
            for (int k = 0; k < 4; ++k) o[d0] = __builtin_amdgcn_mfma_f32_32x32x16_bf16(frag2(sa[k], sc[k]), qf[k], o[d0], 0, 0, 0);
            RSBAR();
        }
        { const LAS unsigned char* vb = sb + R_V + qbk * 8192 + tr_n; const LAS unsigned char* kb = sb + R_K + dvh * 8192 + tr_k;
          s16x4 va[8], vc[8], ka[8], kc[8];
#pragma unroll
          for (int ks = 0; ks < 8; ++ks) { const LAS unsigned char* vp = vb + (16 * ks) * 64; const LAS unsigned char* kp = kb + (16 * ks) * 16; va[ks] = vtr(vp); vc[ks] = vtr(vp + 256); ka[ks] = vtr(kp); kc[ks] = vtr(kp + 64); }
          RSBAR();
#pragma unroll
          for (int ks = 0; ks < 8; ++ks) st = __builtin_amdgcn_mfma_f32_32x32x16_bf16(frag2(va[ks], vc[ks]), frag2(ka[ks], kc[ks]), st, 0, 0, 0);
#pragma unroll
          for (int r = 0; r < 16; ++r) st[r] *= g128; }
#undef RSBAR
        LGK_BAR();
        { LAS unsigned char* sw = lds + R_ST + qbk * 4096 + (32 * dvh + r32) * 64 + 8 * hi;
#pragma unroll
          for (int a4 = 0; a4 < 4; ++a4) { v2u w; w.x = cvtpk(st[4 * a4], st[4 * a4 + 1]); w.y = cvtpk(st[4 * a4 + 2], st[4 * a4 + 3]); *(LAS v2u*)(sw + 16 * a4) = w; } }
        float s1 = 0.f, s2 = 0.f;
#pragma unroll
        for (int d0 = 0; d0 < 2; ++d0)
#pragma unroll
            for (int r = 0; r < 16; ++r) { s1 += o[d0][r]; s2 += o[d0][r] * o[d0][r]; }
        s1 = swap_add(s1); s2 = swap_add(s2);
        LAS f32x2* stat = (LAS f32x2*)(lds + R_STAT);
        if (hi == 0) stat[wid * 32 + r32] = (f32x2){s1, s2};
        LGK_BAR();
        { const f32x2 ot = stat[(wid ^ 4) * 32 + r32]; s1 += ot.x; s2 += ot.y; }
        const float mean = s1 * (1.f / 128.f), var = fmaxf(s2 * (1.f / 128.f) - mean * mean, 0.f), rstd = 1.0f / sqrtf(var + EPS);
        bf16* op = omix + trow * DM + 512 + hh * 128 + 64 * dvh + 4 * hi;
#pragma unroll
        for (int d0 = 0; d0 < 2; ++d0)
#pragma unroll
            for (int a4 = 0; a4 < 4; ++a4) { const v2u gr = grr[d0][a4];
                const float y0 = silu_f(bflo(gr.x)) * (o[d0][4 * a4] - mean) * rstd, y1 = silu_f(bfhi(gr.x)) * (o[d0][4 * a4 + 1] - mean) * rstd;
                const float y2 = silu_f(bflo(gr.y)) * (o[d0][4 * a4 + 2] - mean) * rstd, y3 = silu_f(bfhi(gr.y)) * (o[d0][4 * a4 + 3] - mean) * rstd;
                v2u w; w.x = cvtpk(y0, y1); w.y = cvtpk(y2, y3); *(GAS v2u*)(op + 32 * d0 + 8 * a4) = w; }
    }
    WAIT_BAR0();
#undef RDMA
}
#undef GLDS16
}
#ifndef GEMM_ALIGN
#define GEMM_ALIGN true
#endif
#ifndef MK_ONE_LAUNCH
#define MK_ONE_LAUNCH 1
#endif
constexpr int NPHASE = 11;
__global__ void __launch_bounds__(NTHR, 2) fwd(Args args) {
    extern __shared__ __attribute__((aligned(16))) unsigned char lds_raw[];
    Frame F;
    F.lds = (LAS unsigned char*)lds_raw;
    F.MISC = (volatile LAS unsigned*)(F.lds + MISC_OFF);
    F.tid = threadIdx.x; F.lane = F.tid & 63; F.wave = __builtin_amdgcn_readfirstlane(F.tid >> 6);
    F.G = gridDim.x; F.bx = blockIdx.x;
    unsigned char* ws = args.ws;
    F.ctl = (gu32*)(ws + WS_CTL);
    for (int u = F.tid; u < (LDS_BYTES - LDSCTL_OFF) / 4; u += NTHR) ((LAS unsigned*)(F.lds + LDSCTL_OFF))[u] = 0u;
    __syncthreads();
    XcdBarrier bar; bar.bar = (unsigned*)(F.ctl + CW_BAR); bar.x = 0; bar.st = nullptr;
    const int lo = args.ph_lo, hi = args.ph_hi;
    if (hi - lo > 1) bar = xcd_barrier_post((unsigned*)(F.ctl + CW_BAR), F.MISC + 8);
#ifdef ONLY_PHASE
#define IN(k) ((k) == ONLY_PHASE && lo <= (k) && (k) < hi)
#else
#define IN(k) (lo <= (k) && (k) < hi)
#endif
#define SEAM(k) do { if (IN(k) && IN((k) + 1)) xcd_barrier(bar); } while (0)
    LAS unsigned char* ring = F.lds;

#ifndef REP_PHASE
#define REP_PHASE -1
#endif
    int rep_id = 0;
#define RUN(k, ...) do { if (IN(k)) { { __VA_ARGS__ } if (REP_PHASE == (k)) { xcd_barrier(bar); rep_id = 1; { __VA_ARGS__ } rep_id = 0; } SEAM(k); } } while (0)
    RUN(0, p0_prologue(F, args););
    RUN(1, p1_norm1(F, args););
    RUN(2,
        pg8::Gemm g{(const bf16*)(ws + WS_B), (const bf16*)(ws + WS_WIN), DM, DM}; pg8::StaticOrder S; S.init(T, INWP, F.G, F.bx);
#ifdef GEMM_STAGGER_US
        { const unsigned long long t0 = __builtin_amdgcn_s_memrealtime(); const unsigned long long dly = (unsigned long long)(((F.bx >> 3) & 3) * GEMM_STAGGER_US) * 100ull;
          while (__builtin_amdgcn_s_memrealtime() - t0 < dly) __builtin_amdgcn_s_sleep(8); }
#endif
#ifdef REP_NULL_EPI
        if (rep_id == 1) {
#if REP_NULL_EPI == 2
            pg8::EpiBf16 E0{(bf16*)(ws + WS_B), INWP}; pg8::gemm_phase<pg8::EpiBf16, pg8::StaticOrder, GEMM_ALIGN>(ring, g, S, E0);
#else
            pg8::EpiNull E0{(float*)(ws + WS_END)}; pg8::gemm_phase<pg8::EpiNull, pg8::StaticOrder, GEMM_ALIGN>(ring, g, S, E0);
#endif
        } else
#endif
        { pg8::EpiProj E{(bf16*)(ws + WS_A), (const int*)args.in[2], (float*)(ws + WS_PQ), (float*)(ws + WS_PKV)};
        pg8::gemm_phase<pg8::EpiProj, pg8::StaticOrder, GEMM_ALIGN>(ring, g, S, E); }
    );
    RUN(4,
        { pg8::Gemm g{(const bf16*)(ws + WS_A) + C_CQ, (const bf16*)(ws + WS_WUQ), INWP, 256}; pg8::StaticOrder S; S.init(T, QW, F.G, F.bx);
          pg8::EpiScaled<8, 256> E{(bf16*)(ws + WS_B), QW, (const float*)(ws + WS_PQ), nullptr};
          pg8::gemm_phase<pg8::EpiScaled<8, 256>, pg8::StaticOrder, GEMM_ALIGN>(ring, g, S, E); }
        { pg8::Gemm g{(const bf16*)(ws + WS_A) + C_CKV, (const bf16*)(ws + WS_WUKV), INWP, 128}; pg8::StaticOrder S; S.init(T, KVW, F.G, F.bx);
          pg8::EpiScaled<4, 128> E{(bf16*)(ws + WS_C), KVW, (const float*)(ws + WS_PKV), ws + WS_K8};
          pg8::gemm_phase<pg8::EpiScaled<4, 128>, pg8::StaticOrder, GEMM_ALIGN>(ring, g, S, E); }
    );
    RUN(5,
        const bf16* proj = (const bf16*)(ws + WS_A); bf16* omix = (bf16*)(ws + WS_D);
#ifndef REP5_MODE
#define REP5_MODE 0
#endif
        if (!(rep_id == 1 && REP5_MODE == 2)) for (int u = F.bx; u < NB * 4; u += F.G) mix::ret_unit(ring, u >> 2, u & 3, proj, omix);
        volatile LAS int* qs = (volatile LAS int*)(F.MISC + 16);
        if (!(rep_id == 1 && REP5_MODE == 1)) {
            if (F.tid == 0) qs[0] = (int)__hip_atomic_fetch_add(F.ctl + CW_QUEUE + 64 * rep_id, 1u, RLX_AGENT);
            __syncthreads();
            int u = qs[0];
            while (u < NB * 8 * 16) {
                int nxt = 0;
#if REP_PHASE != 5
                if (F.tid == 0) nxt = (int)__hip_atomic_fetch_add(F.ctl + CW_QUEUE + 64 * rep_id, 1u, RLX_AGENT);
#endif
                const int qb = 15 - (u >> 7), bh = u & 127;
#ifdef ATTN_PROBE
                if (rep_id) mix::attn_unit<ATTN_PROBE>(ring, bh >> 3, bh & 7, qb, (const bf16*)(ws + WS_B), ws + WS_C, ws + WS_K8, proj, (const int*)args.in[2], (bf16*)(ws + WS_END)); else
#endif
                mix::attn_unit(ring, bh >> 3, bh & 7, qb, (const bf16*)(ws + WS_B), ws + WS_C, ws + WS_K8, proj, (const int*)args.in[2], omix);
#if REP_PHASE == 5
                if (F.tid == 0) nxt = (int)__hip_atomic_fetch_add(F.ctl + CW_QUEUE + 64 * rep_id, 1u, RLX_AGENT);
#endif
                if (F.tid == 0) qs[0] = nxt;
                __syncthreads();
                u = qs[0];
            }
        }
    );
#ifdef SELFCHECK
    if (IN(5)) { selfcheck_phase(F, args); xcd_barrier(bar); }
#endif
    RUN(6,
        pg8::Gemm g{(const bf16*)(ws + WS_D), (const bf16*)(ws + WS_WO), DM, DM}; pg8::StaticOrder S; S.init(T, DM, F.G, F.bx);
#ifdef P6_STAGGER_US
        { const unsigned long long t0 = __builtin_amdgcn_s_memrealtime(); const unsigned long long dly = (unsigned long long)(((F.bx >> 3) & 3) * P6_STAGGER_US) * 100ull;
          while (__builtin_amdgcn_s_memrealtime() - t0 < dly) __builtin_amdgcn_s_sleep(8); }
#endif
        pg8::EpiResid E{(const float*)args.in[0], (const float*)(ws + WS_MOD), (bf16*)(ws + WS_A), (float*)(ws + WS_PART)};
        pg8::gemm_phase<pg8::EpiResid, pg8::StaticOrder, GEMM_ALIGN>(ring, g, S, E);
    );
    RUN(7, p7_norm2_router(F, args, rep_id););
    if (IN(8) || IN(9) || IN(10)) {
        LAS int* pre = (LAS int*)(F.MISC + 32);
        LAS int* ppre = (LAS int*)(F.MISC + 96);
        if (F.tid < NE) pre[F.tid + 1] = ((int)__hip_atomic_load(F.ctl + CW_CNT + F.tid * CNT_STRIDE, RLX_AGENT) + 255) >> 8;
        else if (F.tid >= 64 && F.tid < 64 + NPAIR) ppre[F.tid - 64 + 1] = ((int)__hip_atomic_load(F.ctl + CW_PCNT + (F.tid - 64) * CNT_STRIDE, RLX_AGENT) + 255) >> 8;
        __syncthreads();
        if (F.tid == 0) { int s = 0; pre[0] = 0; for (int e = 1; e <= NE; ++e) { s += pre[e]; pre[e] = s; } }
        else if (F.tid == 64) { int s = 0; ppre[0] = 0; for (int q = 1; q <= NPAIR; ++q) { s += ppre[q]; ppre[q] = s; } }
        __syncthreads();
        const int* cnt = (const int*)(F.ctl + CW_CNT); const int* tok = (const int*)(ws + WS_TOK);
        RUN(8,
            pg8::Gemm g{(const bf16*)(ws + WS_B), (const bf16*)(ws + WS_W13), DM / 2, DM / 2, F8_E32, F8_E1}; pg8::MoeOrder S{F.G, F.bx, 2, pre, cnt, tok};
            pg8::EpiSwiGLU2 E{ws + WS_C, tok, (const int*)(ws + WS_PTI), (const float*)(ws + WS_GATEW), ppre};
            pg8::gemm_phase<pg8::EpiSwiGLU2, pg8::MoeOrder, GEMM_ALIGN, true, true>(ring, g, S, E);
        );
        RUN(9,
            pg8::Gemm g{(const bf16*)(ws + WS_C), (const bf16*)(ws + WS_W2), DE, DE / 2, F8_E16, F8_E8}; pg8::PairOrder S{F.G, F.bx, ppre};
            pg8::EpiFp8 E{ws + WS_D, DM, F8_SY};
            pg8::gemm_phase<pg8::EpiFp8, pg8::PairOrder, GEMM_ALIGN, false, true>(ring, g, S, E);
        );
#ifdef SELFCHECK
        if (IN(10)) { selfcheck_moe(F, args, ppre); xcd_barrier(bar); }
#endif
        RUN(10, p10_final(F, args, ppre););
    }
#undef RUN
#undef IN
#undef SEAM
}

extern "C" void kernel_launch(void* const* d_in, const int* in_sizes, int n_in, void* d_out, int out_size, void* d_ws, size_t ws_size, hipStream_t stream) {
    static int grid = 0;
    if (grid == 0) {
        if (n_in != 21 || in_sizes[0] != T * DM || out_size != T * DM || ws_size < WS_END) { fprintf(stderr, "kernel_launch: unexpected shapes (n_in %d, in0 %d, out %d, ws %zu); nothing launched\n", n_in, n_in > 0 ? in_sizes[0] : -1, out_size, ws_size); grid = -1; return; }
        int dev = 0, cus = 0, per_cu = 0;
        if (hipGetDevice(&dev) != hipSuccess || hipDeviceGetAttribute(&cus, hipDeviceAttributeMultiprocessorCount, dev) != hipSuccess) { grid = -1; return; }
        if (hipFuncSetAttribute((const void*)fwd, hipFuncAttributeMaxDynamicSharedMemorySize, LDS_BYTES) != hipSuccess) { fprintf(stderr, "kernel_launch: hipFuncSetAttribute failed\n"); grid = -1; return; }
        if (hipOccupancyMaxActiveBlocksPerMultiprocessor(&per_cu, (const void*)fwd, NTHR, LDS_BYTES) != hipSuccess || per_cu < 1) fprintf(stderr, "kernel_launch: occupancy query reports %d\n", per_cu);
        (void)hipGetLastError();
        grid = cus;
    }
    if (grid < 0) return;
    if (hipMemsetAsync((char*)d_ws + WS_CTL, 0, CTL_ZERO_BYTES, stream) != hipSuccess) return;
    Args a{};
    for (int i = 0; i < 21; ++i) a.in[i] = d_in[i];
    a.out = (float*)d_out; a.ws = (unsigned char*)d_ws;
#if MK_ONE_LAUNCH
    a.ph_lo = 0; a.ph_hi = NPHASE;
    hipLaunchKernelGGL(fwd, dim3(grid), dim3(NTHR), LDS_BYTES, stream, a);
#else
    for (int p = 0; p < NPHASE; ++p) { a.ph_lo = p; a.ph_hi = p + 1; hipLaunchKernelGGL(fwd, dim3(grid), dim3(NTHR), LDS_BYTES, stream, a); }
#endif
}
```

```cpp
#include <hip/hip_runtime.h>
#include <cstdio>
#include <cstdint>

#define GAS __attribute__((address_space(1)))
#define LAS __attribute__((address_space(3)))
typedef unsigned short bf16;
typedef unsigned v4u __attribute__((ext_vector_type(4)));
typedef unsigned v2u __attribute__((ext_vector_type(2)));
typedef float f32x2 __attribute__((ext_vector_type(2)));
typedef float f32x4 __attribute__((ext_vector_type(4)));
typedef float f32x16 __attribute__((ext_vector_type(16)));
typedef short bf16x8 __attribute__((ext_vector_type(8)));
typedef short s16x4 __attribute__((ext_vector_type(4)));
typedef GAS unsigned gu32;

constexpr int DM = 1024, NB = 16, SEQ = 4096, T = NB * SEQ;
constexpr int INW = 1952, INWP = 2048;
constexpr int C_CQ = 0, C_CKV = 256, C_KR = 384, C_RQ = 416, C_RK = 672, C_RV = 928, C_RG = 1440;
constexpr int QW = 768, KVW = 1024;
constexpr int NE = 32, DE = 256, CAP = 65536;
constexpr int MODW = 6 * DM;
constexpr float EPS = 1e-6f;
constexpr int NWAVES = 8, NTHR = 512;

constexpr size_t MiB = 1u << 20;
constexpr size_t WS_CTL = 0, CTL_ZERO_BYTES = 256 * 1024;
constexpr size_t WS_MOD = 1 * MiB;
constexpr size_t WS_WR = 1 * MiB + 512 * 1024;
constexpr size_t WS_WIN = 2 * MiB, WS_WUQ = 6 * MiB, WS_WUKV = 6 * MiB + 512 * 1024, WS_WO = 7 * MiB, WS_W13 = 9 * MiB, WS_W2 = 41 * MiB;
constexpr size_t WS_PQ = 70 * MiB;
constexpr size_t WS_PKV = 60 * MiB;
constexpr size_t WS_PART = 57 * MiB;
constexpr size_t WS_GATEW = 61 * MiB;
constexpr size_t WS_SLOT = 61 * MiB + 512 * 1024;
constexpr size_t WS_PTI = 1 * MiB + 768 * 1024;
constexpr int NPAIR = 4 * 28;
constexpr size_t WS_TOK = 62 * MiB;
constexpr size_t WS_A = 72 * MiB;
constexpr size_t WS_K8 = (328 + 96) * MiB;
constexpr size_t WS_B = 328 * MiB;
constexpr size_t WS_C = 456 * MiB;
constexpr size_t WS_D = 584 * MiB;
constexpr size_t WS_END = 872 * MiB;
constexpr int CW_TMO = 0, CW_CODE = 1, CW_BAR = 4096, CW_CNT = 8192, CNT_STRIDE = 64, CW_CNT2 = 12288, CW_QUEUE = 16384, CW_PCNT = 32768;

constexpr int RING_BYTES = 149504;
constexpr int LDSCTL_OFF = 150528, MISC_OFF = LDSCTL_OFF;
constexpr int LDS_BYTES = 151552;

#define RLX_AGENT __ATOMIC_RELAXED, __HIP_MEMORY_SCOPE_AGENT
#define LDS_WAIT() asm volatile("s_waitcnt lgkmcnt(0)" ::: "memory")
#define VM_WAIT() asm volatile("s_waitcnt vmcnt(0)" ::: "memory")
#define WAIT_BAR0() asm volatile("s_waitcnt vmcnt(0) lgkmcnt(0)\n\ts_barrier" ::: "memory")
#define LGK_BAR() asm volatile("s_waitcnt lgkmcnt(0)\n\ts_barrier" ::: "memory")
__device__ __forceinline__ unsigned f2bf(float f) { unsigned u = __builtin_bit_cast(unsigned, f); return (u + 0x7fffu + ((u >> 16) & 1u)) >> 16; }
__device__ __forceinline__ unsigned pk2(float lo, float hi) { return f2bf(lo) | (f2bf(hi) << 16); }
typedef __bf16 bf16x2_t __attribute__((ext_vector_type(2)));
__device__ __forceinline__ unsigned cvtpk2(float lo, float hi) { f32x2 v = {lo, hi}; bf16x2_t b = __builtin_convertvector(v, bf16x2_t); return __builtin_bit_cast(unsigned, b); }
__device__ __forceinline__ float clamp448(float v) { return __builtin_fminf(__builtin_fmaxf(v, -448.0f), 448.0f); }
__device__ __forceinline__ unsigned cvt4_fp8(float a, float b, float c, float d) { int p = __builtin_amdgcn_cvt_pk_fp8_f32(clamp448(a), clamp448(b), 0, false); p = __builtin_amdgcn_cvt_pk_fp8_f32(clamp448(c), clamp448(d), p, true); return (unsigned)p; }
constexpr float F8_SW13 = 32.0f, F8_SW2 = 16.0f, F8_SH = 8.0f, F8_SY = 16.0f;
constexpr float F8_SWO = 32.0f, F8_SO = 8.0f;
constexpr unsigned F8_E1 = 0x7f7f7f7fu, F8_E32 = 0x7a7a7a7au, F8_E16 = 0x7b7b7b7bu, F8_E8 = 0x7c7c7c7cu;
__device__ __forceinline__ f32x4 fp8x4_f32(unsigned w) { return (f32x4){__builtin_amdgcn_cvt_f32_fp8((int)w, 0), __builtin_amdgcn_cvt_f32_fp8((int)w, 1), __builtin_amdgcn_cvt_f32_fp8((int)w, 2), __builtin_amdgcn_cvt_f32_fp8((int)w, 3)}; }
__device__ __forceinline__ float bf2f(unsigned b) { return __builtin_bit_cast(float, b << 16); }
__device__ __forceinline__ float bflo(unsigned w) { return __builtin_bit_cast(float, w << 16); }
__device__ __forceinline__ float bfhi(unsigned w) { return __builtin_bit_cast(float, w & 0xffff0000u); }
__device__ __forceinline__ float wave_sum(float v) {
#pragma unroll
    for (int o = 1; o < 64; o <<= 1) v += __shfl_xor(v, o);
    return v;
}
__device__ __forceinline__ float silu_f(float v) { return v / (1.0f + __expf(-v)); }

#define XB_TMO      128
#define XB_XCNT(j)  (256  + 64 * (j))
#define XB_XSUB(j)  (1280 + 64 * (j))
#define XB_XGEN(j)  (2304 + 64 * (j))
#define XB_TOP      3328
#define XB_TOPGEN   3392
#define XCD_BAR_WORDS 3456
#define XB_SPIN_CAP (1u << 22)
__device__ __forceinline__ unsigned xb_ld(unsigned* p)              { return __hip_atomic_load(p, __ATOMIC_RELAXED, __HIP_MEMORY_SCOPE_AGENT); }
__device__ __forceinline__ unsigned xb_add(unsigned* p, unsigned v) { return __hip_atomic_fetch_add(p, v, __ATOMIC_RELAXED, __HIP_MEMORY_SCOPE_AGENT); }
__device__ __forceinline__ unsigned xb_xcc_id() { return (unsigned)__builtin_amdgcn_s_getreg((3 << 11) | 20) & 0xFu; }
#define XB_SPIN(cond, bar) do { unsigned _sp = 0; while (cond) { __builtin_amdgcn_s_sleep(1); \
    if ((++_sp & 255u) == 0u) { if (xb_ld(&(bar)[XB_TMO])) break; if (_sp > XB_SPIN_CAP) { atomicAdd(&(bar)[XB_TMO], 1u); break; } } } } while (0)
struct XcdBarrier { unsigned* bar; unsigned x; volatile LAS unsigned* st; };
__device__ __forceinline__ XcdBarrier xcd_barrier_post(unsigned* bar, volatile LAS unsigned* st) {
    XcdBarrier b; b.bar = bar; b.x = xb_xcc_id(); b.st = st;
    if (threadIdx.x == 0) (void)xb_add(&bar[XB_XCNT(b.x)], 1u);
    return b;
}
__device__ __forceinline__ void xcd_barrier_complete(unsigned* bar, unsigned x, unsigned& nloc, unsigned& nx) {
    const unsigned G = gridDim.x * gridDim.y * gridDim.z;
    unsigned sum, cnt, mine, sp = 0u;
    for (;;) {
        sum = 0u; cnt = 0u; mine = 0u;
#pragma unroll
        for (unsigned j = 0; j < 16; ++j) { const unsigned c = xb_ld(&bar[XB_XCNT(j)]); sum += c; cnt += (c > 0u) ? 1u : 0u; mine = (j == x) ? c : mine; }
        if (sum == G) break;
        __builtin_amdgcn_s_sleep(1);
        if ((++sp & 255u) == 0u) { if (xb_ld(&bar[XB_TMO])) break; if (sp > XB_SPIN_CAP) { atomicAdd(&bar[XB_TMO], 1u); break; } }
    }
    nloc = mine > 0u ? mine : 1u; nx = cnt > 0u ? cnt : 1u;
}
__device__ __forceinline__ void xcd_barrier(const XcdBarrier& b) {
    asm volatile("s_waitcnt vmcnt(0)" ::: "memory");
    __syncthreads();
    if (threadIdx.x == 0) {
        unsigned* bar = b.bar;
        __builtin_amdgcn_s_waitcnt(0);
        unsigned nloc = b.st[0], nx = b.st[1];
        if (nloc == 0u) { xcd_barrier_complete(bar, b.x, nloc, nx); b.st[0] = nloc; b.st[1] = nx; }
        const unsigned old = xb_add(&bar[XB_XSUB(b.x)], 1u);
        const unsigned gen = old / nloc;
        if (old + 1u == (gen + 1u) * nloc) {
            __builtin_amdgcn_fence(__ATOMIC_RELEASE, "agent");
            asm volatile("s_waitcnt vmcnt(0)" ::: "memory");
            const unsigned og = xb_add(&bar[XB_TOP], 1u);
            const unsigned tg = og / nx;
            if (og + 1u == (tg + 1u) * nx) xb_add(&bar[XB_TOPGEN], 1u);
            else XB_SPIN(xb_ld(&bar[XB_TOPGEN]) == tg, bar);
            __builtin_amdgcn_fence(__ATOMIC_ACQUIRE, "agent");
            xb_add(&bar[XB_XGEN(b.x)], 1u);
            asm volatile("s_waitcnt vmcnt(0)" ::: "memory");
        } else {
            XB_SPIN(xb_ld(&bar[XB_XGEN(b.x)]) == gen, bar);
            __builtin_amdgcn_fence(__ATOMIC_ACQUIRE, "agent");
            asm volatile("s_waitcnt vmcnt(0)" ::: "memory");
        }
    }
    __syncthreads();
}
namespace pg8 {
constexpr int BM = 256, BK = 64, HALF = 128, HTB = HALF * BK * 2, STAGE_BYTES = 8 * HTB, NXCD = 8, WGM = 8;
__host__ __device__ __forceinline__ int lds_byte(int r, int c) { const int st = (r >> 4) * 2 + (c >> 5), rr = r & 15, cc = c & 31, ob = rr * 64 + cc * 2; return st * 1024 + (ob ^ (((ob >> 9) & 1) << 5)); }
__host__ __device__ __forceinline__ void stage_rc(int b, int& R, int& C) { const int st = b / 1024, sb = b % 1024, swz = sb ^ (((sb >> 9) & 1) << 5); R = (st >> 1) * 16 + swz / 64; C = (st & 1) * 32 + (swz % 64) / 2; }
__host__ __device__ __forceinline__ int perm32(int rho) { const int n = rho >> 4, i = rho & 15; return 8 * (i >> 2) + 4 * n + (i & 3); }

struct Unit { int pm, pn, e, rb, nv, pnl, acol, cont; };
struct Gemm { const bf16* A; const bf16* Bt; int lda, K; unsigned sw = 0x7f7f7f7fu, sx = 0x7f7f7f7fu; };

struct StaticOrder {
    int nM, nN, nwg, G, c;
    __device__ void init(int M, int N, int G_, int c_) { nM = M / BM; nN = N / BM; nwg = nM * nN; G = G_; c = c_; }
    __device__ bool next(int i, Unit& u) const {
        const long L = (long)i * G + c; if (L >= nwg) return false;
        int wgid = (int)L; { const int q = nwg / NXCD, r = nwg % NXCD, xcd = wgid % NXCD, off = wgid / NXCD; wgid = (xcd < r ? xcd * (q + 1) : r * (q + 1) + (xcd - r) * q) + off; }
        const int nig = WGM * nN, gid = wgid / nig, fm = gid * WGM, gsz = (nM - fm) < WGM ? (nM - fm) : WGM;
        u.pm = fm + ((wgid % nig) % gsz); u.pn = (wgid % nig) / gsz; u.e = 0; u.rb = 0; u.nv = 256; u.pnl = u.pn; u.acol = 0; u.cont = 0; return true;
    }
    __device__ __forceinline__ unsigned arow(const Unit& u, int r) const { return (unsigned)(u.pm * BM + r); }
};
struct MoeOrder {
    int G, c, ncol; const LAS int* pre; const int* cnt; const int* tok;
    __device__ bool next(int i, Unit& u) const {
        const int L = i * G + c, gb = L / ncol, pl = L % ncol;
        if (gb >= pre[NE]) return false;
        const int lj = threadIdx.x & 31;
        const unsigned long long bm = __ballot(pre[lj] <= gb) & 0xffffffffull;
        const int e = 31 - __builtin_clz((unsigned)bm);
        u.pm = gb; u.e = e; u.rb = gb - pre[e]; u.pnl = pl; u.pn = e * ncol + pl; u.acol = 0; u.cont = 0;
        const int left = cnt[e * CNT_STRIDE] - u.rb * 256; u.nv = left < 256 ? left : 256; return true;
    }
    __device__ __forceinline__ unsigned arow(const Unit& u, int r) const {
        if (tok) return (r < u.nv) ? (unsigned)(tok[(size_t)u.e * CAP + u.rb * 256 + r] >> 1) : 0u;
        return (unsigned)(u.pm * BM + r);
    }
};

struct PairOrder {
    int G, c; const LAS int* ppre;
    __device__ bool next(int i, Unit& u) const {
        const int L = (i >> 1) * G + c, h = i & 1, gb = L >> 2, pl = L & 3;
        if (gb >= ppre[NPAIR]) return false;
        const int lj = threadIdx.x & 63;
        const unsigned long long b0 = __ballot(ppre[lj] <= gb), b1 = __ballot(lj < NPAIR - 64 && ppre[64 + lj] <= gb);
        const int pid = b1 ? 127 - __builtin_clzll(b1) : 63 - __builtin_clzll(b0);
        int pidx = pid % 28, a = 0; const int g = pid / 28;
        while (pidx >= 7 - a) { pidx -= 7 - a; ++a; }
        const int b = a + 1 + pidx;
        u.pm = gb; u.e = pid; u.rb = gb - ppre[pid]; u.pnl = pl; u.pn = (g * 8 + (h ? b : a)) * 4 + pl; u.nv = 256; u.acol = h * 256; u.cont = h; return true;
    }
    __device__ __forceinline__ unsigned arow(const Unit& u, int r) const { return (unsigned)(u.pm * BM + r); }
};

__device__ __forceinline__ unsigned cvt_pk_bf16(float lo, float hi) { return cvtpk2(lo, hi); }

struct EpiBf16 {
    static constexpr bool PERM = true;
    bf16* O; int ldc;
    __device__ __forceinline__ void operator()(const f32x4 (&acc)[2][2][4][2], const Unit& u, int wr, int wc, int fr, int fq) const {
        const int row0 = u.pm * BM + wr * 64 + fr; const int col0 = u.pnl * BM + wc * 32 + 8 * fq;
#pragma unroll
        for (int ai = 0; ai < 2; ++ai)
#pragma unroll
            for (int m = 0; m < 4; ++m) { bf16* rowp = O + (size_t)(row0 + ai * HALF + m * 16) * ldc + col0;
#pragma unroll
                for (int bj = 0; bj < 2; ++bj) { const f32x4 v0 = acc[ai][bj][m][0], v1 = acc[ai][bj][m][1];
                    v4u w; w.x = cvt_pk_bf16(v0[0], v0[1]); w.y = cvt_pk_bf16(v0[2], v0[3]); w.z = cvt_pk_bf16(v1[0], v1[1]); w.w = cvt_pk_bf16(v1[2], v1[3]);
                    *(v4u*)(rowp + bj * HALF) = w; } }
    }
};
struct EpiFp8 {
    static constexpr bool PERM = true;
    unsigned char* O; int ldc; float scale;
    __device__ __forceinline__ void operator()(const f32x4 (&acc)[2][2][4][2], const Unit& u, int wr, int wc, int fr, int fq) const {
        const int row0 = u.pm * BM + wr * 64 + fr; const int col0 = u.pnl * BM + wc * 32 + 8 * fq;
#pragma unroll
        for (int ai = 0; ai < 2; ++ai)
#pragma unroll
            for (int m = 0; m < 4; ++m) { unsigned char* rowp = O + (size_t)(row0 + ai * HALF + m * 16) * ldc + col0;
#pragma unroll
                for (int bj = 0; bj < 2; ++bj) { const f32x4 v0 = acc[ai][bj][m][0] * scale, v1 = acc[ai][bj][m][1] * scale;
                    v2u w; w.x = cvt4_fp8(v0[0], v0[1], v0[2], v0[3]); w.y = cvt4_fp8(v1[0], v1[1], v1[2], v1[3]);
                    *(v2u*)(rowp + bj * HALF) = w; } }
    }
};
struct EpiProj {
    static constexpr bool PERM = true;
    bf16* O; const int* positions; float* pq; float* pkv;
    __device__ __forceinline__ void operator()(const f32x4 (&acc)[2][2][4][2], const Unit& u, int wr, int wc, int fr, int fq) const {
        const int row0 = u.pm * BM + wr * 64 + fr;
        const float L2B = 13.287712379549449f, I2PI = 0.15915494309189535f;
        float posr[2][4];
#pragma unroll
        for (int ai = 0; ai < 2; ++ai)
#pragma unroll
            for (int m = 0; m < 4; ++m) posr[ai][m] = (u.pnl >= 1 && u.pnl <= 3) ? (float)positions[row0 + ai * HALF + m * 16] : 0.f;
#pragma unroll
        for (int bj = 0; bj < 2; ++bj) {
            const int seg = u.pnl * BM + bj * HALF + wc * 32;
            if (seg >= INW) continue;
            const int kind = seg < 256 ? 0 : seg < 384 ? 1 : seg < 416 ? 2 : seg < 672 ? 3 : seg < 928 ? 4 : 5;
            float cf[4]; float lgh = 0.f;
            if (kind == 2) {
#pragma unroll
                for (int i = 0; i < 4; ++i) cf[i] = exp2f(-(float)(4 * fq + i) * (1.f / 16.f) * L2B) * I2PI;
            } else if (kind == 3 || kind == 4) { const int base = kind == 3 ? 416 : 672, hh = (seg - base) >> 6, off = ((seg - base) & 63) + 8 * fq;
                lgh = log2f(1.0f - exp2f(-5.0f - (float)hh));
#pragma unroll
                for (int i = 0; i < 4; ++i) cf[i] = exp2f(-(float)(off / 2 + i) * (1.f / 32.f) * L2B) * I2PI;
            } else {
#pragma unroll
                for (int i = 0; i < 4; ++i) cf[i] = 0.f; }
#pragma unroll
            for (int ai = 0; ai < 2; ++ai)
#pragma unroll
                for (int m = 0; m < 4; ++m) { const int row = row0 + ai * HALF + m * 16;
                    float v[8];
#pragma unroll
                    for (int i = 0; i < 4; ++i) { v[i] = acc[ai][bj][m][0][i]; v[4 + i] = acc[ai][bj][m][1][i]; }
                    if (kind <= 1) { float ss = 0.f;
#pragma unroll
                        for (int i = 0; i < 8; ++i) ss += v[i] * v[i];
                        ss += __shfl_xor(ss, 16); ss += __shfl_xor(ss, 32);
                        if (fq == 0) { if (kind == 0) pq[(size_t)row * 8 + bj * 4 + wc] = ss; else pkv[(size_t)row * 4 + wc] = ss; }
                    } else if (kind <= 4) { const float pos = posr[ai][m]; float scl = 1.0f;
                        if (kind >= 3) { const float lg = lgh * (float)((row & 127) + 1); scl = kind == 3 ? exp2f(lg) : 0.125f * exp2f(-lg); }
#pragma unroll
                        for (int i = 0; i < 4; ++i) { float t = pos * cf[i]; t -= floorf(t); const float sn = __builtin_amdgcn_sinf(t), cs = __builtin_amdgcn_cosf(t);
                            const float x1 = v[2 * i], x2 = v[2 * i + 1]; v[2 * i] = (x1 * cs - x2 * sn) * scl; v[2 * i + 1] = (x1 * sn + x2 * cs) * scl; } }
                    v4u w; w.x = cvt_pk_bf16(v[0], v[1]); w.y = cvt_pk_bf16(v[2], v[3]); w.z = cvt_pk_bf16(v[4], v[5]); w.w = cvt_pk_bf16(v[6], v[7]);
                    *(v4u*)(O + (size_t)row * INWP + seg + 8 * fq) = w; }
        }
    }
};
template <int NP, int NC> struct EpiScaled {
    static constexpr bool PERM = true;
    bf16* O; int ldc; const float* part; unsigned char* k8;
    __device__ __forceinline__ void operator()(const f32x4 (&acc)[2][2][4][2], const Unit& u, int wr, int wc, int fr, int fq) const {
        const int row0 = u.pm * BM + wr * 64 + fr; const int col0 = u.pnl * BM + wc * 32 + 8 * fq;
        float rstd[2][4];
        { f32x4 pv[2][4][NP / 4];
#pragma unroll
          for (int ai = 0; ai < 2; ++ai)
#pragma unroll
              for (int m = 0; m < 4; ++m)
#pragma unroll
                  for (int p = 0; p < NP / 4; ++p) pv[ai][m][p] = *(const f32x4*)(part + (size_t)(row0 + ai * HALF + m * 16) * NP + 4 * p);
#pragma unroll
          for (int ai = 0; ai < 2; ++ai)
#pragma unroll
              for (int m = 0; m < 4; ++m) { float ss = 0.f;
#pragma unroll
                  for (int p = 0; p < NP / 4; ++p) ss += (pv[ai][m][p].x + pv[ai][m][p].y) + (pv[ai][m][p].z + pv[ai][m][p].w);
                  rstd[ai][m] = 1.0f / sqrtf(ss * (1.f / NC) + EPS); } }
        asm volatile("" ::: "memory");
#pragma unroll
        for (int ai = 0; ai < 2; ++ai)
#pragma unroll
            for (int m = 0; m < 4; ++m) { const int row = row0 + ai * HALF + m * 16; const float rs = rstd[ai][m];
                bf16* rowp = O + (size_t)row * ldc + col0;
#pragma unroll
                for (int bj = 0; bj < 2; ++bj) { const f32x4 v0 = acc[ai][bj][m][0] * rs, v1 = acc[ai][bj][m][1] * rs;
                    if (NP == 4 && wc < 2) { v2u w8; w8.x = cvt4_fp8(v0[0], v0[1], v0[2], v0[3]); w8.y = cvt4_fp8(v1[0], v1[1], v1[2], v1[3]);
                        *(v2u*)(k8 + (size_t)row * 512 + (2 * u.pnl + bj) * 64 + wc * 32 + 8 * fq) = w8; continue; }
                    if (NP == 4) {
                        const int k = row & 63, k5 = k & 31, pos = 32 * ((k5 >> 2) & 1) + 16 * (k >> 5) + 4 * (k5 >> 3) + (k5 & 3);
                        const int dvb = (wc - 2) * 32 + 8 * fq;
                        unsigned char* vb = (unsigned char*)O + ((size_t)(((row >> 12) * 8 + 2 * u.pnl + bj) * 64 + ((row & 4095) >> 6)) * 64 + dvb) * 64 + (pos & 15);
                        const int pa = (((pos >> 4) ^ ((dvb >> 2) & 3)) << 4), pb = (((pos >> 4) ^ (((dvb >> 2) + 1) & 3)) << 4);
                        const unsigned wa = cvt4_fp8(v0[0], v0[1], v0[2], v0[3]), wb = cvt4_fp8(v1[0], v1[1], v1[2], v1[3]);
                        vb[pa] = (unsigned char)wa; vb[pa + 64] = (unsigned char)(wa >> 8); vb[pa + 128] = (unsigned char)(wa >> 16); vb[pa + 192] = (unsigned char)(wa >> 24);
                        vb[pb + 256] = (unsigned char)wb; vb[pb + 320] = (unsigned char)(wb >> 8); vb[pb + 384] = (unsigned char)(wb >> 16); vb[pb + 448] = (unsigned char)(wb >> 24); continue; }
                    v4u w; w.x = cvt_pk_bf16(v0[0], v0[1]); w.y = cvt_pk_bf16(v0[2], v0[3]); w.z = cvt_pk_bf16(v1[0], v1[1]); w.w = cvt_pk_bf16(v1[2], v1[3]);
                    *(v4u*)(rowp + bj * HALF) = w; } }
    }
};
struct EpiNull {
    static constexpr bool PERM = true;
    float* sink;
    __device__ __forceinline__ void operator()(const f32x4 (&acc)[2][2][4][2], const Unit& u, int wr, int wc, int fr, int fq) const {
        float s = 0.f;
#pragma unroll
        for (int ai = 0; ai < 2; ++ai)
#pragma unroll
            for (int bj = 0; bj < 2; ++bj)
#pragma unroll
                for (int m = 0; m < 4; ++m)
#pragma unroll
                    for (int n = 0; n < 2; ++n) s += acc[ai][bj][m][n][0];
        if (s == 1.2345e30f) sink[0] = s;
    }
};
struct EpiResid {
    static constexpr bool PERM = true;
    const float* x; const float* mod; bf16* x1; float* part;
    __device__ __forceinline__ void operator()(const f32x4 (&acc)[2][2][4][2], const Unit& u, int wr, int wc, int fr, int fq) const {
        const int row0 = u.pm * BM + wr * 64 + fr; const int col0 = u.pnl * BM + wc * 32 + 8 * fq;
        const int b = (u.pm * BM) / SEQ;
        const float* g1 = mod + (size_t)b * MODW + 2 * DM;
        f32x4 gv[2][2];
#pragma unroll
        for (int bj = 0; bj < 2; ++bj)
#pragma unroll
            for (int n = 0; n < 2; ++n) gv[bj][n] = *(const f32x4*)(g1 + col0 + bj * HALF + 4 * n);
#pragma unroll
        for (int ai = 0; ai < 2; ++ai) {
            f32x4 xv[4][2][2];
#pragma unroll
            for (int m = 0; m < 4; ++m) { const size_t off = (size_t)(row0 + ai * HALF + m * 16) * DM + col0;
#pragma unroll
                for (int bj = 0; bj < 2; ++bj) { xv[m][bj][0] = *(const f32x4*)(x + off + bj * HALF); xv[m][bj][1] = *(const f32x4*)(x + off + bj * HALF + 4); } }
            asm volatile("" ::: "memory");
#pragma unroll
            for (int m = 0; m < 4; ++m) { const int row = row0 + ai * HALF + m * 16; const size_t off = (size_t)row * DM + col0; float ss = 0.f;
#pragma unroll
                for (int bj = 0; bj < 2; ++bj) { const f32x4 o0 = xv[m][bj][0] + gv[bj][0] * acc[ai][bj][m][0], o1 = xv[m][bj][1] + gv[bj][1] * acc[ai][bj][m][1];
                    v4u w; w.x = cvt_pk_bf16(o0[0], o0[1]); w.y = cvt_pk_bf16(o0[2], o0[3]); w.z = cvt_pk_bf16(o1[0], o1[1]); w.w = cvt_pk_bf16(o1[2], o1[3]);
                    *(v4u*)(x1 + off + bj * HALF) = w;
#pragma unroll
                    for (int j = 0; j < 4; ++j) { const float lo = bflo(w[j]), hi = bfhi(w[j]); ss += lo * lo + hi * hi; } }
                ss += __shfl_xor(ss, 16); ss += __shfl_xor(ss, 32);
                if (fq == 0) part[(size_t)row * 16 + u.pnl * 4 + wc] = ss; }
            asm volatile("" ::: "memory");
        }
    }
};
struct EpiSwiGLU {
    static constexpr bool PERM = true;
    bf16* H;
    __device__ __forceinline__ void operator()(const f32x4 (&acc)[2][2][4][2], const Unit& u, int wr, int wc, int fr, int fq) const {
        const int row0 = u.pm * BM + wr * 64 + fr; const int col0 = u.pnl * 128 + wc * 16 + 4 * fq;
#pragma unroll
        for (int ai = 0; ai < 2; ++ai)
#pragma unroll
            for (int m = 0; m < 4; ++m) { bf16* rowp = H + (size_t)(row0 + ai * HALF + m * 16) * DE + col0;
#pragma unroll
                for (int bj = 0; bj < 2; ++bj) { const f32x4 g = acc[ai][bj][m][0], v = acc[ai][bj][m][1];
                    v2u w; w.x = cvt_pk_bf16(silu_f(g[0]) * v[0], silu_f(g[1]) * v[1]); w.y = cvt_pk_bf16(silu_f(g[2]) * v[2], silu_f(g[3]) * v[3]);
                    *(v2u*)(rowp + bj * 64) = w; } }
    }
};
struct EpiSwiGLU2 {
    static constexpr bool PERM = true;
    unsigned char* H; const int* tok; const int* ptinfo; const float* gatew; const LAS int* ppre;
    __device__ __forceinline__ void operator()(const f32x4 (&acc)[2][2][4][2], const Unit& u, int wr, int wc, int fr, int fq) const {
        const int col0 = u.pnl * 128 + wc * 16 + 4 * fq;
#pragma unroll
        for (int ai = 0; ai < 2; ++ai) {
            int en[4]; int pi[4]; float w[4];
#pragma unroll
            for (int m = 0; m < 4; ++m) { const int rl = ai * HALF + wr * 64 + m * 16 + fr; en[m] = rl < u.nv ? tok[(size_t)u.e * CAP + u.rb * 256 + rl] : -1; }
#pragma unroll
            for (int m = 0; m < 4; ++m) { pi[m] = en[m] >= 0 ? ptinfo[en[m] >> 1] : 0; w[m] = en[m] >= 0 ? F8_SH * gatew[en[m]] : 0.f; }
            asm volatile("" ::: "memory");
#pragma unroll
            for (int m = 0; m < 4; ++m) if (en[m] >= 0) {
                const int pid = (pi[m] & 0x3fffffff) >> 16, ppos = pi[m] & 65535, half = (en[m] & 1) ^ ((pi[m] >> 30) & 1);
                unsigned char* rowp = H + ((size_t)(256 * ppre[pid] + ppos)) * 512 + half * 256 + col0;
#pragma unroll
                for (int bj = 0; bj < 2; ++bj) { const f32x4 g = acc[ai][bj][m][0], v = acc[ai][bj][m][1];
                    *(unsigned*)(rowp + bj * 64) = cvt4_fp8(w[m] * silu_f(g[0]) * v[0], w[m] * silu_f(g[1]) * v[1], w[m] * silu_f(g[2]) * v[2], w[m] * silu_f(g[3]) * v[3]); } }
            asm volatile("" ::: "memory");
        }
    }
};
struct EpiDown {
    static constexpr bool PERM = true;
    bf16* Y; const int* tok; const float* gatew;
    __device__ __forceinline__ void operator()(const f32x4 (&acc)[2][2][4][2], const Unit& u, int wr, int wc, int fr, int fq) const {
        const int col0 = u.pnl * BM + wc * 32 + 8 * fq;
#pragma unroll
        for (int ai = 0; ai < 2; ++ai)
#pragma unroll
            for (int m = 0; m < 4; ++m) { const int rl = ai * HALF + wr * 64 + m * 16 + fr;
                if (rl < u.nv) { const int entry = tok[(size_t)u.e * CAP + u.rb * 256 + rl]; const float w = gatew[entry]; bf16* rowp = Y + (size_t)entry * DM + col0;
#pragma unroll
                    for (int bj = 0; bj < 2; ++bj) { const f32x4 v0 = acc[ai][bj][m][0] * w, v1 = acc[ai][bj][m][1] * w;
                        v4u o; o.x = cvt_pk_bf16(v0[0], v0[1]); o.y = cvt_pk_bf16(v0[2], v0[3]); o.z = cvt_pk_bf16(v1[0], v1[1]); o.w = cvt_pk_bf16(v1[2], v1[3]);
                        *(v4u*)(rowp + bj * HALF) = o; } }
                asm volatile("" ::: "memory"); }
    }
};

template <class Epi, class Sched, bool ALIGN_EPI, bool GATHER = false, bool FP8 = false>
__device__ __forceinline__ void gemm_phase(LAS unsigned char* lds, const Gemm g, const Sched& S, const Epi& E) {
    const int tid = threadIdx.x, wid = __builtin_amdgcn_readfirstlane(tid >> 6), lane = tid & 63, wr = wid >> 2, wc = wid & 3, fr = lane & 15, fq = lane >> 4;
    int K = g.K; asm volatile("" : "+s"(K));
    const int nt = K / BK;
    unsigned voffB[2], voffA[2]; int RA[2]; unsigned CA[2];
#pragma unroll
    for (int i = 0; i < 2; ++i) { int R, C; stage_rc(tid * 16 + i * 8192, R, C); const int Rb = Epi::PERM ? ((R & ~31) + perm32(R & 31)) : R;
        RA[i] = R; CA[i] = (unsigned)C * 2u; voffA[i] = (unsigned)(R * g.lda + C) * 2u; voffB[i] = (unsigned)(Rb * K + C) * 2u; }
    const unsigned kstep = (unsigned)(BK * 2);
    const size_t hstepB = (size_t)HALF * K * 2, tstepB = 2 * hstepB;
    const unsigned pitchA = (unsigned)g.lda * 2u; const size_t hstepA = (size_t)HALF * g.lda * 2, tstepA = 2 * hstepA;
    const unsigned ldsw = (unsigned)wid * 1024u;
    const int aoff = lds_byte(wr * 64 + fr, fq * 8), boff = lds_byte(wc * 32 + fr, fq * 8);
#define PG8_SA(b, h) (((b) * 2 + (h)) * HTB)
#define PG8_SB(b, h) ((4 + (b) * 2 + (h)) * HTB)
#define PG8_STAGE(bufoff, gbase, voff) do { _Pragma("unroll") for (int _i = 0; _i < 2; ++_i) \
        __builtin_amdgcn_global_load_lds((const unsigned*)((const char*)(gbase) + (voff)[_i]), (LAS unsigned*)(lds + (bufoff) + ldsw + _i * 8192), 16, 0, 0); } while (0)
#define PG8_STAGEA(bufoff, up, offs, h, kb) do { _Pragma("unroll") for (int _i = 0; _i < 2; ++_i) { \
        const char* _p = GATHER ? ((const char*)g.A + (size_t)(offs)[h][_i] + (kb)) : ((up) + (size_t)(h) * hstepA + voffA[_i] + (kb)); \
        __builtin_amdgcn_global_load_lds((const unsigned*)_p, (LAS unsigned*)(lds + (bufoff) + ldsw + _i * 8192), 16, 0, 0); } } while (0)
#define PG8_LDA(dst, b, h) do { if constexpr (FP8) { _Pragma("unroll") for (int m = 0; m < 4; ++m) { const v4i_ lo_ = *(const LAS v4i_*)(lds + PG8_SA(b, h) + aoff + m * 2048), hi_ = *(const LAS v4i_*)(lds + PG8_SA(b, h) + aoff + m * 2048 + 1024); \
            dst##8[m] = __builtin_shufflevector(lo_, hi_, 0, 1, 2, 3, 4, 5, 6, 7); } } \
        else { _Pragma("unroll") for (int m = 0; m < 4; ++m) _Pragma("unroll") for (int k = 0; k < 2; ++k) dst[m][k] = *(const LAS bf16x8*)(lds + PG8_SA(b, h) + aoff + m * 2048 + k * 1024); } } while (0)
#define PG8_LDB(dst, b, h) do { if constexpr (FP8) { _Pragma("unroll") for (int n = 0; n < 2; ++n) { const v4i_ lo_ = *(const LAS v4i_*)(lds + PG8_SB(b, h) + boff + n * 2048), hi_ = *(const LAS v4i_*)(lds + PG8_SB(b, h) + boff + n * 2048 + 1024); \
            dst##8[n] = __builtin_shufflevector(lo_, hi_, 0, 1, 2, 3, 4, 5, 6, 7); } } \
        else { _Pragma("unroll") for (int n = 0; n < 2; ++n) _Pragma("unroll") for (int k = 0; k < 2; ++k) dst[n][k] = *(const LAS bf16x8*)(lds + PG8_SB(b, h) + boff + n * 2048 + k * 1024); } } while (0)
#define PG8_MMA(ai, bj, At, Bt) do { __builtin_amdgcn_s_setprio(1); _Pragma("unroll") for (int m = 0; m < 4; ++m) _Pragma("unroll") for (int n = 0; n < 2; ++n) { \
        if constexpr (FP8) asm volatile("v_mfma_scale_f32_16x16x128_f8f6f4 %0, %1, %2, %0, %3, %4 op_sel_hi:[0,0,0]" : "+v"(acc[ai][bj][m][n]) : "v"(Bt##8[n]), "v"(At##8[m]), "v"(f8sw), "v"(f8sx));     \
        else { _Pragma("unroll") for (int k = 0; k < 2; ++k) acc[ai][bj][m][n] = __builtin_amdgcn_mfma_f32_16x16x32_bf16(Bt[n][k], At[m][k], acc[ai][bj][m][n], 0, 0, 0); } } \
        __builtin_amdgcn_s_setprio(0); } while (0)
#define PG8_WAIT_V(n) asm volatile("s_waitcnt vmcnt(" #n ")" ::: "memory")
#define PG8_WAIT_L(n) asm volatile("s_waitcnt lgkmcnt(" #n ")" ::: "memory")
#define PG8_BAR __builtin_amdgcn_s_barrier()
#define PG8_SCHED __builtin_amdgcn_sched_barrier(0)
#define PG8_AOFFS(dst, un) do { if constexpr (GATHER) _Pragma("unroll") for (int _h = 0; _h < 2; ++_h) _Pragma("unroll") for (int _i = 0; _i < 2; ++_i) dst[_h][_i] = S.arow(un, _h * HALF + RA[_i]) * pitchA + CA[_i]; } while (0)
    Unit cur, nxt; int ui = 0;
    if (!S.next(0, cur)) return;
    f32x4 acc[2][2][4][2];
#pragma unroll
    for (int a = 0; a < 2; ++a)
#pragma unroll
        for (int b = 0; b < 2; ++b)
#pragma unroll
            for (int m = 0; m < 4; ++m)
#pragma unroll
                for (int n = 0; n < 2; ++n) acc[a][b][m][n] = (f32x4){0.f, 0.f, 0.f, 0.f};
    typedef int v8i_ __attribute__((ext_vector_type(8))); typedef int v4i_ __attribute__((ext_vector_type(4)));
    bf16x8 At[4][2], B0[2][2], B1[2][2]; v8i_ At8[4], B08[2], B18[2];
    const int f8sw = (int)g.sw, f8sx = (int)g.sx;
    unsigned oC[2][2], oN[2][2];
    PG8_AOFFS(oC, cur);
    const char* cA = (const char*)g.A + (size_t)cur.pm * tstepA + cur.acol;
    const char* cB = (const char*)g.Bt + (size_t)cur.pn * tstepB;
    PG8_STAGE(PG8_SB(0, 0), cB, voffB); PG8_STAGE(PG8_SB(0, 1), cB + hstepB, voffB); PG8_STAGEA(PG8_SA(0, 0), cA, oC, 0, 0u); PG8_STAGEA(PG8_SA(0, 1), cA, oC, 1, 0u);
    if (wr == 1) PG8_BAR;
    PG8_WAIT_V(2); PG8_BAR;
    PG8_STAGE(PG8_SB(1, 0), cB + kstep, voffB); PG8_STAGEA(PG8_SA(1, 0), cA, oC, 0, kstep); PG8_STAGE(PG8_SB(1, 1), cB + hstepB + kstep, voffB);
    PG8_WAIT_V(6); PG8_BAR;
    for (;;) {
        const bool has_next = S.next(ui + 1, nxt);
        if (has_next) { PG8_AOFFS(oN, nxt); } else {
#pragma unroll
            for (int _h = 0; _h < 2; ++_h)
#pragma unroll
                for (int _i = 0; _i < 2; ++_i) oN[_h][_i] = oC[_h][_i]; }
        const char* nA = has_next ? (const char*)g.A + (size_t)nxt.pm * tstepA + nxt.acol : cA;
        const char* nB = has_next ? (const char*)g.Bt + (size_t)nxt.pn * tstepB : cB;
        for (int t = 0; t < nt; t += 2) {
            const bool last = (t == nt - 2);
            const unsigned ka1 = (unsigned)(t + 1) * kstep;
            const unsigned ka2 = last ? 0u : (unsigned)(t + 2) * kstep, ka3 = ka2 + kstep;
            unsigned o2[2][2];
#pragma unroll
            for (int _h = 0; _h < 2; ++_h)
#pragma unroll
                for (int _i = 0; _i < 2; ++_i) o2[_h][_i] = last ? oN[_h][_i] : oC[_h][_i];
            const char* a2 = last ? nA : cA;
            const char* b2 = last ? nB : cB + (size_t)(t + 2) * kstep; const char* b3 = b2 + kstep;
            PG8_LDB(B0, 0, 0); PG8_LDB(B1, 0, 1); PG8_SCHED; PG8_LDA(At, 0, 0); PG8_STAGEA(PG8_SA(1, 1), cA, oC, 1, ka1);
            PG8_WAIT_V(8); PG8_WAIT_L(0); PG8_BAR; PG8_MMA(0, 0, At, B0); PG8_MMA(0, 1, At, B1); PG8_BAR; PG8_SCHED;
            PG8_LDA(At, 0, 1); PG8_STAGE(PG8_SB(0, 0), b2, voffB); PG8_STAGE(PG8_SB(0, 1), b2 + hstepB, voffB); PG8_STAGEA(PG8_SA(0, 0), a2, o2, 0, ka2);
            PG8_WAIT_V(8); PG8_WAIT_L(0); PG8_BAR; PG8_MMA(1, 0, At, B0); PG8_MMA(1, 1, At, B1); PG8_BAR; PG8_SCHED;
            PG8_LDB(B0, 1, 0); PG8_LDB(B1, 1, 1); PG8_SCHED; PG8_LDA(At, 1, 0); PG8_STAGEA(PG8_SA(0, 1), a2, o2, 1, ka2);
            PG8_WAIT_V(8); PG8_WAIT_L(0); PG8_BAR; PG8_MMA(0, 0, At, B0); PG8_MMA(0, 1, At, B1); PG8_BAR; PG8_SCHED;
            PG8_LDA(At, 1, 1); PG8_STAGE(PG8_SB(1, 0), b3, voffB); PG8_STAGE(PG8_SB(1, 1), b3 + hstepB, voffB); PG8_STAGEA(PG8_SA(1, 0), a2, o2, 0, ka3);
            PG8_WAIT_V(8); PG8_WAIT_L(0); PG8_BAR; PG8_MMA(1, 0, At, B0); PG8_MMA(1, 1, At, B1); PG8_BAR; PG8_SCHED;
        }
        const bool fin = !(has_next && nxt.cont);
        if (fin) {
        if constexpr (ALIGN_EPI) { if (wr == 0) PG8_BAR; }
        E(acc, cur, wr, wc, fr, fq);
        }
        if (!has_next) break;
        if (fin) {
#pragma unroll
        for (int a = 0; a < 2; ++a)
#pragma unroll
            for (int b = 0; b < 2; ++b)
#pragma unroll
                for (int m = 0; m < 4; ++m)
#pragma unroll
                    for (int n = 0; n < 2; ++n) acc[a][b][m][n] = (f32x4){0.f, 0.f, 0.f, 0.f};
        }
        cur = nxt; cA = nA; cB = nB; ++ui;
#pragma unroll
        for (int _h = 0; _h < 2; ++_h)
#pragma unroll
            for (int _i = 0; _i < 2; ++_i) oC[_h][_i] = oN[_h][_i];
        if constexpr (ALIGN_EPI) { if (fin && wr == 1) PG8_BAR; }
    }
    PG8_WAIT_V(0);
    if constexpr (!ALIGN_EPI) { if (wr == 0) PG8_BAR; }
    PG8_BAR;
#undef PG8_SA
#undef PG8_SB
#undef PG8_STAGE
#undef PG8_STAGEA
#undef PG8_LDA
#undef PG8_LDB
#undef PG8_MMA
#undef PG8_WAIT_V
#undef PG8_WAIT_L
#undef PG8_BAR
#undef PG8_SCHED
#undef PG8_AOFFS
}
}
struct Frame {
    LAS unsigned char* lds;
    volatile LAS unsigned* MISC;
    gu32* ctl;
    int tid, lane, wave, G, bx;
};
struct Args { const void* in[21]; float* out; unsigned char* ws; int ph_lo, ph_hi; };

__device__ __forceinline__ int pair_map(int j, int half) { return j < half ? 2 * j : 2 * (j - half) + 1; }
__device__ __forceinline__ int row_map(int mode, int n) {
    if (mode == 0) return n;
    if (mode <= 2) return 8 * (n >> 2) + 4 * (mode - 1) + (n & 3);
    if (mode == 3) { if (n >= C_KR && n < C_RQ) return C_KR + pair_map(n - C_KR, 16);
                     if (n >= C_RQ && n < C_RV) { const int hb = C_RQ + ((n - C_RQ) & ~63); return hb + pair_map(n - hb, 32); }
                     return n; }
    { const int h = n / 96, d = n % 96; return d < 64 ? n : h * 96 + 64 + pair_map(d - 64, 16); }
}
__device__ __forceinline__ void transpose_item(const float* W, int K, int N, bf16* WT, int mode, const float* kscale, LAS float* scr, int item, int lane, float f8scale = 0.f) {
    const int nblk = N / 32, kb = item / nblk, nb = item % nblk, k0 = 64 * kb, n0 = 32 * nb;
    float wv[32];
#pragma unroll
    for (int i = 0; i < 32; ++i) { const int kk = 2 * i + (lane >> 5); wv[i] = __builtin_nontemporal_load(W + (size_t)(k0 + kk) * N + n0 + (lane & 31)); }
#pragma unroll
    for (int i = 0; i < 32; ++i) { const int kk = 2 * i + (lane >> 5); float w = wv[i]; if (kscale) w *= kscale[k0 + kk]; scr[kk * 33 + (lane & 31)] = w; }
    LDS_WAIT(); asm volatile("" ::: "memory");
    const int c = lane & 7;
#pragma unroll
    for (int j = 0; j < 4; ++j) { const int n = (lane >> 3) + 8 * j; const LAS float* s = scr + (8 * c) * 33 + n;
        v4u o; o.x = pk2(s[0 * 33], s[1 * 33]); o.y = pk2(s[2 * 33], s[3 * 33]); o.z = pk2(s[4 * 33], s[5 * 33]); o.w = pk2(s[6 * 33], s[7 * 33]);
        const int row = row_map(mode, n0 + n);
        if (f8scale > 0.f) { v2u o8; o8.x = cvt4_fp8(f8scale * s[0 * 33], f8scale * s[1 * 33], f8scale * s[2 * 33], f8scale * s[3 * 33]); o8.y = cvt4_fp8(f8scale * s[4 * 33], f8scale * s[5 * 33], f8scale * s[6 * 33], f8scale * s[7 * 33]);
            *(GAS v2u*)((unsigned char*)WT + (size_t)row * K + k0 + 8 * c) = o8; }
        else *(GAS v4u*)(WT + (size_t)row * K + k0 + 8 * c) = o; }
    LDS_WAIT(); asm volatile("" ::: "memory");
}
__device__ __forceinline__ void p0_prologue(Frame& F, const Args& a) {
    unsigned char* ws = a.ws;
    float* mod = (float*)(ws + WS_MOD);
    for (int cb = F.bx; cb < MODW / 32; cb += F.G) {
        const float* c = (const float*)a.in[1]; const float* w_ada = (const float*)a.in[3]; const float* b_ada = (const float*)a.in[4];
        LAS float* sc = (LAS float*)F.lds;
        LAS float* part = (LAS float*)(F.lds + 65536);
        for (int i = F.tid; i < NB * DM; i += NTHR) sc[i] = silu_f(c[i]);
        __syncthreads();
        const int cc = F.tid & 31, kq = F.tid >> 5, n = cb * 32 + cc;
        float acc[NB];
#pragma unroll
        for (int b = 0; b < NB; ++b) acc[b] = 0.f;
        for (int k0 = kq; k0 < DM; k0 += 128) { float wv[8];
#pragma unroll
            for (int i = 0; i < 8; ++i) wv[i] = __builtin_nontemporal_load(w_ada + (size_t)(k0 + 16 * i) * MODW + n);
#pragma unroll
            for (int i = 0; i < 8; ++i)
#pragma unroll
                for (int b = 0; b < NB; ++b) acc[b] += sc[b * DM + k0 + 16 * i] * wv[i]; }
#pragma unroll
        for (int b = 0; b < NB; ++b) part[(kq * NB + b) * 32 + cc] = acc[b];
        __syncthreads();
        { const int b = F.tid >> 5; float s = b_ada[n];
#pragma unroll
          for (int q = 0; q < 16; ++q) s += part[(q * NB + b) * 32 + cc];
          mod[(size_t)b * MODW + n] = s; }
        __syncthreads();
    }
    LAS float* scr = (LAS float*)(F.lds + F.wave * 16384);
    const int gw = F.bx * NWAVES + F.wave, NGW = F.G * NWAVES;
    constexpr int I_IN = (DM / 64) * (INW / 32), I_UQ = (256 / 64) * (QW / 32), I_UKV = (128 / 64) * (KVW / 32), I_O = (DM / 64) * (DM / 32);
    constexpr int I_W1 = (DM / 64) * (DE / 32), I_W2 = (DE / 64) * (DM / 32);
    constexpr int NITEMS = I_IN + I_UQ + I_UKV + I_O + NE * (2 * I_W1 + I_W2);
    for (int it = gw; it < NITEMS; it += NGW) {
        int r = it;
        if (r < I_IN) { transpose_item((const float*)a.in[6], DM, INW, (bf16*)(ws + WS_WIN), 3, nullptr, scr, r, F.lane); continue; } r -= I_IN;
        if (r < I_UQ) { transpose_item((const float*)a.in[8], 256, QW, (bf16*)(ws + WS_WUQ), 4, (const float*)a.in[7], scr, r, F.lane); continue; } r -= I_UQ;
        if (r < I_UKV) { transpose_item((const float*)a.in[10], 128, KVW, (bf16*)(ws + WS_WUKV), 0, (const float*)a.in[9], scr, r, F.lane); continue; } r -= I_UKV;
        if (r < I_O) { transpose_item((const float*)a.in[11], DM, DM, (bf16*)(ws + WS_WO), 0, nullptr, scr, r, F.lane, F8_SWO); continue; } r -= I_O;
        if (r < NE * I_W1) { const int e = r / I_W1; transpose_item((const float*)a.in[17] + (size_t)e * DM * DE, DM, DE, (bf16*)(ws + WS_W13 + (size_t)e * 512 * DM), 1, nullptr, scr, r % I_W1, F.lane, F8_SW13); continue; } r -= NE * I_W1;
        if (r < NE * I_W1) { const int e = r / I_W1; transpose_item((const float*)a.in[18] + (size_t)e * DM * DE, DM, DE, (bf16*)(ws + WS_W13 + (size_t)e * 512 * DM), 2, nullptr, scr, r % I_W1, F.lane, F8_SW13); continue; } r -= NE * I_W1;
        { const int e = r / I_W2; transpose_item((const float*)a.in[19] + (size_t)e * DE * DM, DE, DM, (bf16*)(ws + WS_W2 + (size_t)e * DM * DE), 0, nullptr, scr, r % I_W2, F.lane, F8_SW2); }
    }
    const int gt = F.bx * NTHR + F.tid, NGT = F.G * NTHR;
    { v4u z = (v4u){0u, 0u, 0u, 0u}; GAS v4u* p = (GAS v4u*)((bf16*)(ws + WS_WIN) + (size_t)INW * DM);
      for (int i = gt; i < (INWP - INW) * DM / 8; i += NGT) p[i] = z; }
    { const float* w_gr = (const float*)a.in[13]; const float* w_er = (const float*)a.in[15]; float* wf = (float*)(ws + WS_WR);
      bf16* wb = (bf16*)wf;
      for (int i = gt; i < 32 * 3 * 64 * 8; i += NGT) { const int ii = i & 7, l = (i >> 3) & 63, ntl = (i >> 9) % 3, s8 = i / 1536;
          const int k = 32 * s8 + 8 * (l >> 4) + ii, nc = 16 * ntl + (l & 15);
          const float w = nc < 4 ? w_gr[k * 4 + nc] : (nc < 36 ? w_er[k * 32 + (nc - 4)] : 0.f);
          const unsigned hi = f2bf(w); const float lo = w - bf2f(hi);
          const size_t base = ((size_t)(s8 * 3 + ntl) * 64 + l) * 16; wb[base + ii] = (bf16)hi; wb[base + 8 + ii] = (bf16)f2bf(lo); }
      if (gt < 48) { const float* b_gr = (const float*)a.in[14]; const float* b_er = (const float*)a.in[16];
          wf[64 * 3 * 64 * 4 + gt] = gt < 4 ? b_gr[gt] : (gt < 36 ? b_er[gt - 4] : 0.f); } }
}

__device__ __forceinline__ void p1_norm1(Frame& F, const Args& a) {
    const float* x = (const float*)a.in[0]; const float* g = (const float*)a.in[5]; const float* mod = (const float*)(a.ws + WS_MOD); bf16* h1 = (bf16*)(a.ws + WS_B);
    const int gw = F.bx * NWAVES + F.wave, NGW = F.G * NWAVES;
    for (int m0 = 4 * gw; m0 < T; m0 += 4 * NGW) {
        const int b = m0 >> 12;
        f32x4 v[4][4];
#pragma unroll
        for (int r = 0; r < 4; ++r) { const GAS f32x4* xr = (const GAS f32x4*)(x + (size_t)(m0 + r) * DM) + F.lane;
#pragma unroll
            for (int j = 0; j < 4; ++j) v[r][j] = __builtin_nontemporal_load(xr + 64 * j); }
        f32x4 gs[4], sh[4];
#pragma unroll
        for (int j = 0; j < 4; ++j) { const int col = 4 * F.lane + 256 * j;
            gs[j] = *(const f32x4*)(g + col) * (*(const f32x4*)(mod + (size_t)b * MODW + DM + col) + 1.0f); sh[j] = *(const f32x4*)(mod + (size_t)b * MODW + col); }
#pragma unroll
        for (int r = 0; r < 4; ++r) { float s = 0.f;
#pragma unroll
            for (int j = 0; j < 4; ++j) s += (v[r][j].x * v[r][j].x + v[r][j].y * v[r][j].y) + (v[r][j].z * v[r][j].z + v[r][j].w * v[r][j].w);
            const float rstd = 1.0f / sqrtf(wave_sum(s) * (1.f / DM) + EPS);
            GAS v2u* o8 = (GAS v2u*)(h1 + (size_t)(m0 + r) * DM) + F.lane;
#pragma unroll
            for (int j = 0; j < 4; ++j) { const f32x4 o = (v[r][j] * rstd) * gs[j] + sh[j]; v2u w; w.x = cvtpk2(o.x, o.y); w.y = cvtpk2(o.z, o.w); o8[64 * j] = w; } }
    }
}

__device__ __forceinline__ float ret_log2g(int h) { return log2f(1.0f - exp2f(-5.0f - (float)h)); }

__device__ __forceinline__ void p7_norm2_router(Frame& F, const Args& a, int rep) {
    unsigned char* ws = a.ws;
    const bf16* x1 = (const bf16*)(ws + WS_A); const float* part = (const float*)(ws + WS_PART); const float* mod = (const float*)(ws + WS_MOD);
    const float* g2n = (const float*)a.in[12]; const float* wf = (const float*)(ws + WS_WR); const float* bias = wf + 64 * 3 * 64 * 4;
    unsigned char* h2 = ws + (rep ? WS_END : WS_B); float* gatew = (float*)(ws + (rep ? WS_END + 130 * MiB : WS_GATEW)); int* tok = (int*)(ws + (rep ? WS_END + 132 * MiB : WS_TOK)); int* slotinfo = (int*)(ws + (rep ? WS_END + 131 * MiB : WS_SLOT)); gu32* cntg = F.ctl + (rep ? CW_CNT2 : CW_CNT);
    int* ptinfo = (int*)(ws + (rep ? WS_END + 133 * MiB : WS_PTI)); gu32* pcntg = F.ctl + (rep ? CW_PCNT + NPAIR * CNT_STRIDE : CW_PCNT);
    const int lane = F.lane, wv = F.wave, row = lane & 15, kq = lane >> 4;
    LAS v4u* Wl = (LAS v4u*)(F.lds);
    LAS float* mw = (LAS float*)(F.lds + 98304);
    LAS float* lgs = (LAS float*)(F.lds + 106496);
    LAS int* as_e = (LAS int*)(F.lds);
    LAS int* as_rank = as_e + 512; LAS int* as_entry = as_rank + 512;
    LAS int* cntL = as_entry + 512; LAS int* baseL = cntL + 32;
    LAS int* tp_pid = baseL + 32; LAS int* tp_rank = tp_pid + 256; LAS int* tp_tok = tp_rank + 256;
    LAS int* pcntL = tp_tok + 256; LAS int* pbaseL = pcntL + 128;
    for (int rb = F.bx; rb < T / 256; rb += F.G) {
        const int b = rb >> 4, t0 = b * SEQ + (rb & 15) * 16;
        if (F.tid < 256) { const float* mb = mod + (size_t)b * MODW; const int col = 4 * F.tid;
            *(LAS f32x4*)(mw + col) = *(const f32x4*)(g2n + col) * (*(const f32x4*)(mb + 4 * DM + col) + 1.0f); *(LAS f32x4*)(mw + DM + col) = *(const f32x4*)(mb + 3 * DM + col); }
        float rstd[2];
#pragma unroll
        for (int h = 0; h < 2; ++h) { const f32x4* pp = (const f32x4*)(part + (size_t)(t0 + 256 * (wv + 8 * h) + row) * 16); const f32x4 p0 = pp[0], p1 = pp[1], p2 = pp[2], p3 = pp[3];
            const float ss = ((p0.x + p0.y) + (p0.z + p0.w)) + ((p1.x + p1.y) + (p1.z + p1.w)) + ((p2.x + p2.y) + (p2.z + p2.w)) + ((p3.x + p3.y) + (p3.z + p3.w));
            rstd[h] = 1.0f / sqrtf(ss * (1.f / DM) + EPS); }
        const unsigned lo = (unsigned)(row * DM + 8 * kq);
        const bf16* xw0 = x1 + (size_t)(t0 + 256 * wv) * DM; unsigned char* hw0 = h2 + (size_t)(t0 + 256 * wv) * DM;
        constexpr int XD = 8;
        v4u xq[XD];
#pragma unroll
        for (int u = 0; u < XD; ++u) xq[u] = __builtin_nontemporal_load((const GAS v4u*)(xw0 + 32 * u + lo));
        f32x4 acc[2][3];
#pragma unroll
        for (int h = 0; h < 2; ++h)
#pragma unroll
            for (int ntl = 0; ntl < 3; ++ntl) acc[h][ntl] = (f32x4){0.f, 0.f, 0.f, 0.f};
#pragma unroll 1
        for (int p = 0; p < 2; ++p) {
            __syncthreads();
            { const v4u* src = (const v4u*)wf + (size_t)p * 6144 + F.tid;
#pragma unroll
              for (int i = 0; i < 12; ++i) Wl[F.tid + 512 * i] = src[512 * i]; }
            __syncthreads();
#pragma unroll
            for (int h = 0; h < 2; ++h) {
#pragma unroll 1
                for (int g2 = 0; g2 < 2; ++g2) {
                    const size_t cur = (size_t)h * 2048 * DM + 512 * p + 256 * g2;
                    const size_t nxt = g2 == 0 ? cur + 256 : (h == 0 ? (size_t)2048 * DM + 512 * p : (p == 0 ? (size_t)512 : cur));
                    const LAS v4u* wl = Wl + g2 * 3072 + lane * 2;
#pragma unroll
                    for (int u = 0; u < 8; ++u) { const int col = 512 * p + 256 * g2 + 32 * u;
                        const v4u xw = xq[u]; const f32x4 xa = (f32x4){bflo(xw.x), bfhi(xw.x), bflo(xw.y), bfhi(xw.y)}, xb = (f32x4){bflo(xw.z), bfhi(xw.z), bflo(xw.w), bfhi(xw.w)};
                        xq[u] = __builtin_nontemporal_load((const GAS v4u*)(xw0 + nxt + 32 * u + lo));
                        const LAS float* mg = mw + 8 * kq + col;
                        const f32x4 ga = *(const LAS f32x4*)(mg), gb = *(const LAS f32x4*)(mg + 4), sa = *(const LAS f32x4*)(mg + DM), sb = *(const LAS f32x4*)(mg + DM + 4);
                        const f32x4 ha = (xa * rstd[h]) * ga + sa, hb = (xb * rstd[h]) * gb + sb;
                        v4u hh; hh.x = cvtpk2(ha.x, ha.y); hh.y = cvtpk2(ha.z, ha.w); hh.z = cvtpk2(hb.x, hb.y); hh.w = cvtpk2(hb.z, hb.w);
                        { v2u h8; h8.x = cvt4_fp8(ha.x, ha.y, ha.z, ha.w); h8.y = cvt4_fp8(hb.x, hb.y, hb.z, hb.w); *(GAS v2u*)(hw0 + cur + 32 * u + lo) = h8; }
                        v4u hl; hl.x = cvtpk2(ha.x - bflo(hh.x), ha.y - bfhi(hh.x)); hl.y = cvtpk2(ha.z - bflo(hh.y), ha.w - bfhi(hh.y)); hl.z = cvtpk2(hb.x - bflo(hh.z), hb.y - bfhi(hh.z)); hl.w = cvtpk2(hb.z - bflo(hh.w), hb.w - bfhi(hh.w));
                        const bf16x8 ah = __builtin_bit_cast(bf16x8, hh), al = __builtin_bit_cast(bf16x8, hl);
#pragma unroll
                        for (int ntl = 0; ntl < 3; ++ntl) { const v4u wh = wl[(u * 3 + ntl) * 128], wo = wl[(u * 3 + ntl) * 128 + 1];
                            const bf16x8 bh = __builtin_bit_cast(bf16x8, wh), bl = __builtin_bit_cast(bf16x8, wo);
                            acc[h][ntl] = __builtin_amdgcn_mfma_f32_16x16x32_bf16(ah, bh, acc[h][ntl], 0, 0, 0); acc[h][ntl] = __builtin_amdgcn_mfma_f32_16x16x32_bf16(al, bh, acc[h][ntl], 0, 0, 0);
                            acc[h][ntl] = __builtin_amdgcn_mfma_f32_16x16x32_bf16(ah, bl, acc[h][ntl], 0, 0, 0); } }
                }
            }
        }
#pragma unroll
        for (int h = 0; h < 2; ++h)
#pragma unroll
            for (int ntl = 0; ntl < 3; ++ntl)
#pragma unroll
                for (int r = 0; r < 4; ++r) if (16 * ntl + row < 40) lgs[(16 * (wv + 8 * h) + 4 * kq + r) * 40 + 16 * ntl + row] = acc[h][ntl][r];
        __syncthreads();
        if (F.tid < 32) cntL[F.tid] = 0;
        if (F.tid >= 64 && F.tid < 64 + NPAIR) pcntL[F.tid - 64] = 0;
        __syncthreads();
        if (F.tid < 256) {
            const LAS float* l = lgs + F.tid * 40; const int tt = t0 + 256 * (F.tid >> 4) + (F.tid & 15);
            float lv[36];
#pragma unroll
            for (int j = 0; j < 36; ++j) lv[j] = l[j] + bias[j];
            float gm = lv[0]; int gi = 0;
#pragma unroll
            for (int j = 1; j < 4; ++j) if (lv[j] > gm) { gm = lv[j]; gi = j; }
            float se = 0.f;
#pragma unroll
            for (int j = 0; j < 4; ++j) se += __expf(lv[j] - gm);
            const float ptop = 1.0f / se;
            float le[8];
#pragma unroll
            for (int j = 0; j < 8; ++j) le[j] = gi == 0 ? lv[4 + j] : gi == 1 ? lv[12 + j] : gi == 2 ? lv[20 + j] : lv[28 + j];
            float v1 = le[0]; int i1 = 0;
#pragma unroll
            for (int j = 1; j < 8; ++j) if (le[j] > v1) { v1 = le[j]; i1 = j; }
            float v2 = -3.0e38f; int i2 = 0;
#pragma unroll
            for (int j = 0; j < 8; ++j) if (j != i1 && le[j] > v2) { v2 = le[j]; i2 = j; }
            const float ex = __expf(v2 - v1), g0 = ptop / (1.0f + ex), g1 = ptop * ex / (1.0f + ex);
            const int e0 = gi * 8 + i1, e1 = gi * 8 + i2;
            *(f32x2*)(gatew + (size_t)tt * 2) = (f32x2){g0, g1};
            const int a0 = F.tid * 2;
            as_e[a0] = e0; as_rank[a0] = __hip_atomic_fetch_add(cntL + e0, 1, __ATOMIC_RELAXED, __HIP_MEMORY_SCOPE_WORKGROUP); as_entry[a0] = tt * 2;
            as_e[a0 + 1] = e1; as_rank[a0 + 1] = __hip_atomic_fetch_add(cntL + e1, 1, __ATOMIC_RELAXED, __HIP_MEMORY_SCOPE_WORKGROUP); as_entry[a0 + 1] = tt * 2 + 1;
            { const int pa = i1 < i2 ? i1 : i2, pb = i1 < i2 ? i2 : i1, pid = gi * 28 + pa * 8 - (pa * (pa + 1)) / 2 + (pb - pa - 1);
              tp_pid[F.tid] = pid; tp_rank[F.tid] = __hip_atomic_fetch_add(pcntL + pid, 1, __ATOMIC_RELAXED, __HIP_MEMORY_SCOPE_WORKGROUP); tp_tok[F.tid] = tt | ((i1 > i2) ? (1 << 30) : 0); }
        }
        __syncthreads();
        if (F.tid < 32) { const int c = cntL[F.tid]; baseL[F.tid] = c > 0 ? (int)__hip_atomic_fetch_add(cntg + F.tid * CNT_STRIDE, (unsigned)c, RLX_AGENT) : 0; }
        else if (F.tid >= 64 && F.tid < 64 + NPAIR) { const int q = F.tid - 64; const int c = pcntL[q]; pbaseL[q] = c > 0 ? (int)__hip_atomic_fetch_add(pcntg + q * CNT_STRIDE, (unsigned)c, RLX_AGENT) : 0; }
        __syncthreads();
        if (F.tid < 256) { const int tv2 = tp_tok[F.tid]; const int pid = tp_pid[F.tid]; ptinfo[tv2 & 0x3fffffff] = (tv2 & (1 << 30)) | (pid * 65536 + pbaseL[pid] + tp_rank[F.tid]); }
        { const int en = as_entry[F.tid]; const int e = as_e[F.tid]; const int idx = e * CAP + baseL[e] + as_rank[F.tid]; tok[idx] = en; slotinfo[en] = idx; }
        __syncthreads();
    }
}

__device__ __forceinline__ void p10_final(Frame& F, const Args& a, const LAS int* ppre) {
    const bf16* x1 = (const bf16*)(a.ws + WS_A); const unsigned char* y = a.ws + WS_D; const float* mod = (const float*)(a.ws + WS_MOD); const float* fg = (const float*)a.in[20];
    const int* ptinfo = (const int*)(a.ws + WS_PTI);
    const int gw = F.bx * NWAVES + F.wave, NGW = F.G * NWAVES;
#ifdef SELFCHECK
    float chk_scale; { const float* chk = (const float*)(F.ctl + 20480); const float e = (SELFCHECK == 1) ? sqrtf(chk[0] / chk[1]) : (SELFCHECK == 2) ? sqrtf(chk[2] / chk[3]) : sqrtf(chk[4] / chk[5]); chk_scale = 1.0f + 10.0f * e; }
#endif
    typedef int i32x2 __attribute__((ext_vector_type(2)));
    const int step = 2 * NGW;
    int m0 = 2 * gw;
    if (m0 >= T) return;
    f32x4 gf[4];
#pragma unroll
    for (int j = 0; j < 4; ++j) gf[j] = *(const f32x4*)(fg + 4 * F.lane + 256 * j);
    v2u xw[2][4]; unsigned ya[2][4]; f32x4 g2[4];
#define P10_ISSUE(M, CC) do { \
        _Pragma("unroll") for (int r = 0; r < 2; ++r) { const GAS v2u* xr = (const GAS v2u*)(x1 + (size_t)((M) + r) * DM) + F.lane; \
            const int c0 = __builtin_amdgcn_readfirstlane((CC)[r]) & 0x3fffffff; \
            const size_t s0 = (size_t)(256 * ppre[c0 >> 16] + (c0 & 65535)); \
            const GAS unsigned* y0 = (const GAS unsigned*)(y + s0 * DM) + F.lane; \
            _Pragma("unroll") for (int j = 0; j < 4; ++j) { xw[r][j] = __builtin_nontemporal_load(xr + 64 * j); ya[r][j] = __builtin_nontemporal_load(y0 + 64 * j); } } \
        _Pragma("unroll") for (int j = 0; j < 4; ++j) g2[j] = *(const f32x4*)(mod + (size_t)((M) >> 12) * MODW + 5 * DM + 4 * F.lane + 256 * j); } while (0)
    i32x2 c2;
    { const i32x2 c1 = *(const i32x2*)(ptinfo + m0); const int m2 = m0 + step < T ? m0 + step : m0; c2 = *(const i32x2*)(ptinfo + m2); P10_ISSUE(m0, c1); }
    auto body = [&](int m0) __attribute__((always_inline)) {
        f32x4 v[2][4], yy[2][4], gc[4];
#pragma unroll
        for (int j = 0; j < 4; ++j) gc[j] = g2[j];
#pragma unroll
        for (int r = 0; r < 2; ++r)
#pragma unroll
            for (int j = 0; j < 4; ++j) { const v2u w = xw[r][j]; v[r][j] = (f32x4){bflo(w.x), bfhi(w.x), bflo(w.y), bfhi(w.y)}; yy[r][j] = fp8x4_f32(ya[r][j]) * (1.0f / F8_SY); }
        { const int mn = m0 + step < T ? m0 + step : m0; const i32x2 cnx = c2; const int m3 = mn + step < T ? mn + step : mn;
          c2 = *(const i32x2*)(ptinfo + m3); P10_ISSUE(mn, cnx); }
#pragma unroll
        for (int r = 0; r < 2; ++r) { float s = 0.f;
#pragma unroll
            for (int j = 0; j < 4; ++j) { v[r][j] = v[r][j] + gc[j] * yy[r][j]; s += (v[r][j].x * v[r][j].x + v[r][j].y * v[r][j].y) + (v[r][j].z * v[r][j].z + v[r][j].w * v[r][j].w); }
            const float rstd = 1.0f / sqrtf(wave_sum(s) * (1.f / DM) + EPS);
            GAS f32x4* o = (GAS f32x4*)(a.out + (size_t)(m0 + r) * DM) + F.lane;
#ifdef SELFCHECK
            for (int j = 0; j < 4; ++j) o[64 * j] = (v[r][j] * (rstd * chk_scale)) * gf[j]; }
#else
            for (int j = 0; j < 4; ++j) __builtin_nontemporal_store((v[r][j] * rstd) * gf[j], o + 64 * j); }
#endif
    };
    body(m0); m0 += step;
    for (; m0 < T; m0 += step) body(m0);
#undef P10_ISSUE
}
namespace mix {
__device__ __forceinline__ int crow(int r, int hi) { return (r & 3) + 8 * (r >> 2) + 4 * hi; }
__device__ __forceinline__ unsigned cvtpk(float lo, float hi) { return cvtpk2(lo, hi); }
typedef short v4i16_t __attribute__((ext_vector_type(4)));
__device__ __forceinline__ s16x4 vtr(const LAS unsigned char* p) { return __builtin_bit_cast(s16x4, __builtin_amdgcn_ds_read_tr16_b64_v4i16((LAS v4i16_t*)p)); }
__device__ __forceinline__ bf16x8 frag2(s16x4 lo, s16x4 hi) { return (bf16x8){lo[0], lo[1], lo[2], lo[3], hi[0], hi[1], hi[2], hi[3]}; }
__device__ __forceinline__ float swap_add(float v) { auto rr = __builtin_amdgcn_permlane32_swap(__float_as_uint(v), __float_as_uint(v), false, false); return __uint_as_float(rr[0]) + __uint_as_float(rr[1]); }
__device__ __forceinline__ float swap_max(float v) { auto rr = __builtin_amdgcn_permlane32_swap(__float_as_uint(v), __float_as_uint(v), false, false); return fmaxf(__uint_as_float(rr[0]), __uint_as_float(rr[1])); }
__device__ __forceinline__ void glds16_asm(const void* gsrc, unsigned lds_dst) { unsigned keep;
    asm volatile("s_mov_b32 %0, m0\n\ts_mov_b32 m0, %2\n\ts_nop 0\n\tglobal_load_lds_dwordx4 %1, off\n\ts_mov_b32 m0, %0" : "=&s"(keep) : "v"(gsrc), "s"(lds_dst) : "memory"); }
#define GLDS16(gp, lp) glds16_asm((const void*)(gp), (unsigned)__builtin_amdgcn_readfirstlane((int)(unsigned)(uintptr_t)(lp)))

constexpr int A_KS = 8192, A_VS = 4096, A_V0 = 32768;
typedef int v8i_t __attribute__((ext_vector_type(8))); typedef int v4i_t __attribute__((ext_vector_type(4)));
__device__ __forceinline__ void attn_unit(LAS unsigned char* lds, int b, int h, int qb, const bf16* q, const unsigned char* vt8, const unsigned char* k8, const bf16* proj, const int* positions, unsigned char* omix) {
    const int tid = threadIdx.x, lane = tid & 63, r32 = lane & 31, hi = lane >> 5; const int wid = __builtin_amdgcn_readfirstlane(tid >> 6);
    const size_t rowbase = (size_t)b * SEQ; const int q0 = qb * 256;
    const int NT = (q0 + 256) / 64;
    const unsigned char* ksrc = wid < 4 ? k8 + (rowbase + lane) * 512 + h * 64 + 16 * wid : (const unsigned char*)(proj + (rowbase + lane) * INWP + C_KR + 8 * (wid - 4));
    const size_t kstr = wid < 4 ? (size_t)64 * 512 : (size_t)64 * INWP * 2;
    const unsigned char* vsrc = vt8 + (size_t)((b * 8 + h) * 64) * 4096 + (wid & 3) * 1024 + lane * 16;
    LAS unsigned char* kd0 = lds + wid * 1024; LAS unsigned char* vd0 = lds + A_V0 + (wid & 3) * 1024;
#define ADMA(t) do { const int s_ = (t) & 3; GLDS16(ksrc + (size_t)(t) * kstr, kd0 + s_ * A_KS); if (wid < 4) GLDS16(vsrc + (size_t)(t) * 4096, vd0 + s_ * A_VS); } while (0)
    ADMA(0); ADMA(1);
    const size_t qrow = rowbase + q0 + wid * 32 + r32;
    const float C2 = 0.10206207261596575f * 1.4426950408889634f;
    bf16x8 qr[6]; v8i_t q8;
    const int sK = (int)F8_E1, sQ = (int)F8_E8;
    { const bf16* qp = q + qrow * QW + h * 96 + 8 * hi; v4u raw[6];
      const bf16* qn = q + qrow * QW + h * 96 + 32 * hi;
#pragma unroll
      for (int d0 = 0; d0 < 4; ++d0) raw[d0] = *(const GAS v4u*)(qn + 8 * d0);
#pragma unroll
      for (int d0 = 4; d0 < 6; ++d0) raw[d0] = *(const GAS v4u*)(qp + 16 * d0);
      const float pos = (float)positions[qrow];
      const float C8 = C2 * 8.0f;
#pragma unroll
      for (int d0 = 0; d0 < 4; ++d0) {
          q8[2 * d0] = (int)cvt4_fp8(bflo(raw[d0][0]) * C8, bfhi(raw[d0][0]) * C8, bflo(raw[d0][1]) * C8, bfhi(raw[d0][1]) * C8);
          q8[2 * d0 + 1] = (int)cvt4_fp8(bflo(raw[d0][2]) * C8, bfhi(raw[d0][2]) * C8, bflo(raw[d0][3]) * C8, bfhi(raw[d0][3]) * C8); }
      v4u o1, o2;
#pragma unroll
      for (int j = 0; j < 4; ++j) {
#pragma unroll
          for (int e = 0; e < 2; ++e) { const int f = 8 * e + 4 * hi + j; float tt = pos * (exp2f(-(float)f * (13.287712379549449f / 16.f)) * 0.15915494309189535f); tt -= floorf(tt);
              const float sn = __builtin_amdgcn_sinf(tt), cs = __builtin_amdgcn_cosf(tt);
              const unsigned w = e ? raw[5][j] : raw[4][j]; const float x1 = bflo(w), x2 = bfhi(w);
              const unsigned r = cvtpk((x1 * cs - x2 * sn) * C2, (x1 * sn + x2 * cs) * C2);
              if (e) o2[j] = r; else o1[j] = r; } }
      qr[4] = __builtin_bit_cast(bf16x8, o1); qr[5] = __builtin_bit_cast(bf16x8, o2); }
    float mhat = 0.f, l_run = 0.f; f32x16 o[2]; o[0] = f32x16{}; o[1] = f32x16{};
    f32x16 negm = f32x16{};
    const int qrel = wid * 32 + r32;
    const int voa = r32 * 64 + (((2 * hi) ^ ((r32 >> 2) & 3)) << 4), vob = r32 * 64 + (((2 * hi + 1) ^ ((r32 >> 2) & 3)) << 4);
    f32x16 pA0, pA1, pB0, pB1; v8i_t pw; float resc_f = 1.0f; bool resc = false;
#define SGB(mask, n) __builtin_amdgcn_sched_group_barrier(mask, n, 0)
#define ATOP(t) do { if ((t) + 1 < NT) { if (wid < 4) asm volatile("s_waitcnt vmcnt(2) lgkmcnt(0)\n\ts_barrier" ::: "memory"); else asm volatile("s_waitcnt vmcnt(1) lgkmcnt(0)\n\ts_barrier" ::: "memory"); } else WAIT_BAR0(); if ((t) + 2 < NT) ADMA((t) + 2); } while (0)
#define FP8QK(C, KA, KB) asm volatile("v_mfma_scale_f32_32x32x64_f8f6f4 %0, %1, %2, %5, %3, %4 op_sel_hi:[0,0,0]" : "=&v"(C) : "v"(__builtin_shufflevector(KA, KB, 0, 1, 2, 3, 4, 5, 6, 7)), "v"(q8), "v"(sK), "v"(sQ), "v"(negm))
#define AQK(C0, C1, t) do { const LAS unsigned char* kn_ = lds + ((t) & 3) * A_KS + hi * 2048 + r32 * 16; const LAS unsigned char* kr_ = lds + ((t) & 3) * A_KS + 4096 + hi * 1024 + r32 * 16; \
        const v4i_t n0a_ = *(const LAS v4i_t*)(kn_), n0b_ = *(const LAS v4i_t*)(kn_ + 1024), n1a_ = *(const LAS v4i_t*)(kn_ + 512), n1b_ = *(const LAS v4i_t*)(kn_ + 1536); \
        const bf16x8 r0_ = *(const LAS bf16x8*)(kr_), r1_ = *(const LAS bf16x8*)(kr_ + 512), r2_ = *(const LAS bf16x8*)(kr_ + 2048), r3_ = *(const LAS bf16x8*)(kr_ + 2560); \
        FP8QK(C0, n0a_, n0b_); FP8QK(C1, n1a_, n1b_); \
        C0 = __builtin_amdgcn_mfma_f32_32x32x16_bf16(r0_, qr[4], C0, 0, 0, 0); C1 = __builtin_amdgcn_mfma_f32_32x32x16_bf16(r1_, qr[4], C1, 0, 0, 0); \
        C0 = __builtin_amdgcn_mfma_f32_32x32x16_bf16(r2_, qr[5], C0, 0, 0, 0); C1 = __builtin_amdgcn_mfma_f32_32x32x16_bf16(r3_, qr[5], C1, 0, 0, 0); } while (0)
#define PK8(a, b, c, d) __builtin_amdgcn_cvt_pk_fp8_f32((c), (d), __builtin_amdgcn_cvt_pk_fp8_f32((a), (b), 0, false), true)
#define ASUMPACK(P0, P1) do { float s0_ = P0[0] + P0[1], s1_ = P1[0] + P1[1]; \
        _Pragma("unroll") for (int r = 2; r < 16; ++r) { s0_ += P0[r]; s1_ += P1[r]; } l_run += s0_ + s1_; \
        _Pragma("unroll") for (int j = 0; j < 4; ++j) { pw[j] = PK8(P0[4 * j], P0[4 * j + 1], P0[4 * j + 2], P0[4 * j + 3]); pw[4 + j] = PK8(P1[4 * j], P1[4 * j + 1], P1[4 * j + 2], P1[4 * j + 3]); } } while (0)
#define AMASK(C0, C1, t) do { const int jb_ = (t) - (NT - 4); if (jb_ >= 0) { const int d_ = qrel - (64 * jb_ + 4 * hi);     \
        _Pragma("unroll") for (int r = 0; r < 16; ++r) { const int c_ = (r & 3) + 8 * (r >> 2); if (c_ > d_) C0[r] = -INFINITY; if (c_ + 32 > d_) C1[r] = -INFINITY; } } } while (0)
#define ADECIDE(C0, C1, FIRST) do { \
        float ra_ = fmaxf(fmaxf(C0[0], C0[1]), C1[0]), rb_ = fmaxf(fmaxf(C0[2], C0[3]), C1[1]); ra_ = fmaxf(fmaxf(ra_, C1[2]), C1[3]); \
        _Pragma("unroll") for (int r = 4; r < 16; r += 4) { ra_ = fmaxf(fmaxf(ra_, C0[r]), C0[r + 1]); rb_ = fmaxf(fmaxf(rb_, C0[r + 2]), C0[r + 3]); ra_ = fmaxf(fmaxf(ra_, C1[r]), C1[r + 1]); rb_ = fmaxf(fmaxf(rb_, C1[r + 2]), C1[r + 3]); } \
        const float rm_ = swap_max(fmaxf(ra_, rb_)); resc = false; \
        if ((FIRST) || __builtin_expect(__any(rm_ > 8.0f), 0)) { const float dl_ = (FIRST) ? rm_ : fmaxf(rm_, 0.f); \
            resc_f = (FIRST) ? 1.0f : __builtin_amdgcn_exp2f(-dl_); mhat += dl_; l_run *= resc_f; resc = true; \
            _Pragma("unroll") for (int r = 0; r < 16; ++r) { C0[r] -= dl_; C1[r] -= dl_; negm[r] = -mhat; } } } while (0)
#define AEXP(C0, C1) do { _Pragma("unroll") for (int r = 0; r < 16; ++r) { C0[r] = __builtin_amdgcn_exp2f(C0[r]); C1[r] = __builtin_amdgcn_exp2f(C1[r]); } } while (0)
#define FP8PV(D0, VA, VB) asm volatile("v_mfma_scale_f32_32x32x64_f8f6f4 %0, %1, %2, %0, %3, %3 op_sel_hi:[0,0,0]" : "+v"(o[D0]) : "v"(__builtin_shufflevector(VA, VB, 0, 1, 2, 3, 4, 5, 6, 7)), "v"(pw), "v"(sK))
#define ONOP() asm volatile("s_nop 15\n\ts_nop 7" ::: "memory")
#define APV(vs) do { const LAS unsigned char* vp_ = lds + A_V0 + (vs) * A_VS; \
        const v4i_t a0_ = *(const LAS v4i_t*)(vp_ + voa), b0_ = *(const LAS v4i_t*)(vp_ + vob), a1_ = *(const LAS v4i_t*)(vp_ + 2048 + voa), b1_ = *(const LAS v4i_t*)(vp_ + 2048 + vob); \
        FP8PV(0, a0_, b0_); FP8PV(1, a1_, b1_); ONOP(); } while (0)
#define ARESC() do { if (resc) { ONOP(); _Pragma("unroll") for (int r = 0; r < 16; ++r) { o[0][r] *= resc_f; o[1][r] *= resc_f; } } } while (0)
#define SBAR() __builtin_amdgcn_sched_barrier(0)
#define PIN(x) asm volatile("" : "+v"(x))
#define ASTEP(C0, C1, P0, P1, t) do { ATOP(t); \
        v4i_t kn_[4]; bf16x8 kf_[4]; { const LAS unsigned char* kb_ = lds + ((t) & 3) * A_KS + hi * 2048 + r32 * 16; const LAS unsigned char* kr_ = lds + ((t) & 3) * A_KS + 4096 + hi * 1024 + r32 * 16; \
            kn_[0] = *(const LAS v4i_t*)(kb_); kn_[1] = *(const LAS v4i_t*)(kb_ + 1024); kn_[2] = *(const LAS v4i_t*)(kb_ + 512); kn_[3] = *(const LAS v4i_t*)(kb_ + 1536); \
            kf_[0] = *(const LAS bf16x8*)(kr_); kf_[1] = *(const LAS bf16x8*)(kr_ + 512); kf_[2] = *(const LAS bf16x8*)(kr_ + 2048); kf_[3] = *(const LAS bf16x8*)(kr_ + 2560); } \
        SBAR(); \
        ASUMPACK(P0, P1); PIN(l_run); PIN(pw); \
        SBAR(); \
        FP8QK(C0, kn_[0], kn_[1]); FP8QK(C1, kn_[2], kn_[3]); \
        C0 = __builtin_amdgcn_mfma_f32_32x32x16_bf16(kf_[0], qr[4], C0, 0, 0, 0); C1 = __builtin_amdgcn_mfma_f32_32x32x16_bf16(kf_[1], qr[4], C1, 0, 0, 0); \
        C0 = __builtin_amdgcn_mfma_f32_32x32x16_bf16(kf_[2], qr[5], C0, 0, 0, 0); C1 = __builtin_amdgcn_mfma_f32_32x32x16_bf16(kf_[3], qr[5], C1, 0, 0, 0); \
        SBAR(); \
        v4i_t va_[2], vb_[2]; { const LAS unsigned char* vp_ = lds + A_V0 + (((t) - 1) & 3) * A_VS;     \
            va_[0] = *(const LAS v4i_t*)(vp_ + voa); vb_[0] = *(const LAS v4i_t*)(vp_ + vob); va_[1] = *(const LAS v4i_t*)(vp_ + 2048 + voa); vb_[1] = *(const LAS v4i_t*)(vp_ + 2048 + vob); } \
        SBAR(); \
        AMASK(C0, C1, t); ADECIDE(C0, C1, false); \
        SBAR(); \
        FP8PV(0, va_[0], vb_[0]); \
        _Pragma("unroll") for (int r = 0; r < 16; ++r) C0[r] = __builtin_amdgcn_exp2f(C0[r]); PIN(C0); \
        SBAR(); \
        FP8PV(1, va_[1], vb_[1]); \
        _Pragma("unroll") for (int r = 0; r < 16; ++r) C1[r] = __builtin_amdgcn_exp2f(C1[r]); PIN(C1); \
        SBAR(); \
        ARESC(); } while (0)
    ATOP(0); AQK(pA0, pA1, 0); AMASK(pA0, pA1, 0); ADECIDE(pA0, pA1, true); AEXP(pA0, pA1); resc = false;
    for (int t = 1; t + 2 < NT; t += 2) { ASTEP(pB0, pB1, pA0, pA1, t); ASTEP(pA0, pA1, pB0, pB1, t + 1); }
    ASTEP(pB0, pB1, pA0, pA1, NT - 1);
    ASUMPACK(pB0, pB1); APV((NT - 1) & 3);
#undef SGB
#undef ATOP
#undef ASUMPACK
#undef AMASK
#undef ADECIDE
#undef AEXP
#undef APV
#undef FP8PV
#undef ONOP
#undef PK8
#undef ARESC
#undef ASTEP
#undef SBAR
#undef PIN
    l_run = swap_add(l_run);
    const float inv = 1.0f / l_run;
    unsigned char* op = omix + qrow * DM + h * 64 + 4 * hi;
    const float inv8 = inv * F8_SO;
#pragma unroll
    for (int d0 = 0; d0 < 2; ++d0)
#pragma unroll
        for (int a4 = 0; a4 < 4; ++a4)
            *(GAS unsigned*)(op + 32 * d0 + 8 * a4) = (unsigned)__builtin_amdgcn_cvt_pk_fp8_f32(o[d0][4 * a4 + 2] * inv8, o[d0][4 * a4 + 3] * inv8, __builtin_amdgcn_cvt_pk_fp8_f32(o[d0][4 * a4] * inv8, o[d0][4 * a4 + 1] * inv8, 0, false), true);
    asm volatile("s_waitcnt lgkmcnt(0)\n\ts_barrier" ::: "memory");
#undef ADMA
#undef AQK
#undef FP8QK
}

constexpr int R_STG = 65536, R_K = 16384, R_V = 32768, R_ST = 131072, R_STAT = 147456;
__device__ __forceinline__ void ret_unit(LAS unsigned char* lds, int b, int hh, const bf16* proj, unsigned char* omix) {
    const int tid = threadIdx.x, lane = tid & 63, r32 = lane & 31, hi = lane >> 5; const int wid = __builtin_amdgcn_readfirstlane(tid >> 6);
    const int qbk = wid & 3, dvh = wid >> 2;
    const size_t rowbase = (size_t)b * SEQ;
    const float g128 = exp2f(128.0f * ret_log2g(hh));
    for (int i = tid; i < 16384 / 16; i += NTHR) *(LAS v4u*)(lds + R_ST + i * 16) = (v4u){0u, 0u, 0u, 0u};
    f32x16 st = f32x16{};
    const bf16* qsrc = proj + (rowbase + lane) * INWP + C_RQ + hh * 64 + 8 * wid;
    const bf16* ksrc = proj + (rowbase + lane) * INWP + C_RK + hh * 64 + 8 * wid;
    const bf16* vsrc = proj + (rowbase + (lane >> 2)) * INWP + C_RV + hh * 128 + (lane & 3) * 8;
#define RDMA(n, s) do { const size_t ro_ = (size_t)(n) * 128 * INWP; LAS unsigned char* sb_ = lds + (s) * R_STG; \
        GLDS16(qsrc + ro_, sb_ + wid * 2048); GLDS16(qsrc + ro_ + 64 * INWP, sb_ + wid * 2048 + 1024); \
        GLDS16(ksrc + ro_, sb_ + R_K + wid * 2048); GLDS16(ksrc + ro_ + 64 * INWP, sb_ + R_K + wid * 2048 + 1024); \
        _Pragma("unroll") for (int pq_ = 0; pq_ < 4; ++pq_) { const int pc_ = wid + 8 * pq_, cg_ = pc_ >> 3, rg_ = pc_ & 7; \
            GLDS16(vsrc + ro_ + (size_t)(16 * rg_) * INWP + cg_ * 32, sb_ + R_V + cg_ * 8192 + rg_ * 1024); } } while (0)
    RDMA(0, 0);
    const int g1 = (lane >> 4) & 1, qq = (lane & 15) >> 2, pp = lane & 3;
    const int tr_v = (4 * hi + qq) * 64 + 32 * g1 + 8 * pp;
    const int tr_n = (8 * hi + qq) * 64 + 32 * g1 + 8 * pp;
    const int tr_k = (8 * hi + qq) * 16 + (2 * g1 + (pp >> 1)) * 2048 + (pp & 1) * 8;
    for (int n = 0; n < 32; ++n) {
        const int s = n & 1;
        WAIT_BAR0();
        if (n + 1 < 32) RDMA(n + 1, s ^ 1);
        const LAS unsigned char* sb = lds + s * R_STG;
        const size_t trow = rowbase + (size_t)n * 128 + 32 * qbk + r32;
        v2u grr[2][4];
        { const bf16* gp = proj + trow * INWP + C_RG + hh * 128 + 64 * dvh + 4 * hi;
#pragma unroll
          for (int d0 = 0; d0 < 2; ++d0)
#pragma unroll
              for (int a4 = 0; a4 < 4; ++a4) grr[d0][a4] = *(const GAS v2u*)(gp + 32 * d0 + 8 * a4); }
#define RSBAR() __builtin_amdgcn_sched_barrier(0)
        bf16x8 qf[4]; bf16x8 kfr[4][4];
#pragma unroll
        for (int k = 0; k < 4; ++k) qf[k] = *(const LAS bf16x8*)(sb + (2 * k + hi) * 2048 + (32 * qbk + r32) * 16);
#pragma unroll
        for (int jt = 0; jt < 4; ++jt)
#pragma unroll
            for (int k = 0; k < 4; ++k) kfr[jt][k] = *(const LAS bf16x8*)(sb + R_K + (2 * k + hi) * 2048 + (32 * jt + r32) * 16);
        RSBAR();
        v4u pw[4][2];
#pragma unroll
        for (int jt = 0; jt < 4; ++jt) {
            f32x16 p = __builtin_amdgcn_mfma_f32_32x32x16_bf16(kfr[jt][0], qf[0], f32x16{}, 0, 0, 0);
#pragma unroll
            for (int k = 1; k < 4; ++k) p = __builtin_amdgcn_mfma_f32_32x32x16_bf16(kfr[jt][k], qf[k], p, 0, 0, 0);
            const int dq = 32 * (qbk - jt) + r32;
#pragma unroll
            for (int r = 0; r < 16; ++r) if (crow(r, hi) > dq) p[r] = 0.f;
#pragma unroll
            for (int j = 0; j < 4; ++j) { pw[jt][0][j] = cvtpk(p[2 * j], p[2 * j + 1]); pw[jt][1][j] = cvtpk(p[8 + 2 * j], p[9 + 2 * j]); }
        }
        RSBAR();
        f32x16 o[2]; o[0] = f32x16{}; o[1] = f32x16{};
#pragma unroll
        for (int d0 = 0; d0 < 2; ++d0) {
            const LAS unsigned char* vb = sb + R_V + (2 * dvh + d0) * 8192 + tr_v; const LAS unsigned char* stb = lds + R_ST + (2 * dvh + d0) * 4096 + tr_n;
            s16x4 va[8], vc[8], sa[4], sc[4];
#pragma unroll
            for (int i = 0; i < 8; ++i) { const LAS unsigned char* vp = vb + (16 * i) * 64; va[i] = vtr(vp); vc[i] = vtr(vp + 512); }
#pragma unroll
            for (int k = 0; k < 4; ++k) { const LAS unsigned char* sp = stb + (16 * k) * 64; sa[k] = vtr(sp); sc[k] = vtr(sp + 256); }
            RSBAR();
#pragma unroll
            for (int i = 0; i < 8; ++i) o[d0] = __builtin_amdgcn_mfma_f32_32x32x16_bf16(frag2(va[i], vc[i]), __builtin_bit_cast(bf16x8, pw[i >> 1][i & 1]), o[d0], 0, 0, 0);
#pragma unroll
            for (int k = 0; k < 4; ++k) o[d0] = __builtin_amdgcn_mfma_f32_32x32x16_bf16(frag2(sa[k], sc[k]), qf[k], o[d0], 0, 0, 0);
            RSBAR();
        }
        { const LAS unsigned char* vb = sb + R_V + qbk * 8192 + tr_n; const LAS unsigned char* kb = sb + R_K + dvh * 8192 + tr_k;
          s16x4 va[8], vc[8], ka[8], kc[8];
#pragma unroll
          for (int ks = 0; ks < 8; ++ks) { const LAS unsigned char* vp = vb + (16 * ks) * 64; const LAS unsigned char* kp = kb + (16 * ks) * 16; va[ks] = vtr(vp); vc[ks] = vtr(vp + 256); ka[ks] = vtr(kp); kc[ks] = vtr(kp + 64); }
          RSBAR();
#pragma unroll
          for (int ks = 0; ks < 8; ++ks) st = __builtin_amdgcn_mfma_f32_32x32x16_bf16(frag2(va[ks], vc[ks]), frag2(ka[ks], kc[ks]), st, 0, 0, 0);
#pragma unroll
          for (int r = 0; r < 16; ++r) st[r] *= g128; }
#undef RSBAR
        LGK_BAR();
        { LAS unsigned char* sw = lds + R_ST + qbk * 4096 + (32 * dvh + r32) * 64 + 8 * hi;
#pragma unroll
          for (int a4 = 0; a4 < 4; ++a4) { v2u w; w.x = cvtpk(st[4 * a4], st[4 * a4 + 1]); w.y = cvtpk(st[4 * a4 + 2], st[4 * a4 + 3]); *(LAS v2u*)(sw + 16 * a4) = w; } }
        float s1 = 0.f, s2 = 0.f;
#pragma unroll
        for (int d0 = 0; d0 < 2; ++d0)
#pragma unroll
            for (int r = 0; r < 16; ++r) { s1 += o[d0][r]; s2 += o[d0][r] * o[d0][r]; }
        s1 = swap_add(s1); s2 = swap_add(s2);
        LAS f32x2* stat = (LAS f32x2*)(lds + R_STAT);
        if (hi == 0) stat[wid * 32 + r32] = (f32x2){s1, s2};
        LGK_BAR();
        { const f32x2 ot = stat[(wid ^ 4) * 32 + r32]; s1 += ot.x; s2 += ot.y; }
        const float mean = s1 * (1.f / 128.f), var = fmaxf(s2 * (1.f / 128.f) - mean * mean, 0.f), rstd = 1.0f / sqrtf(var + EPS);
        unsigned char* op = omix + trow * DM + 512 + hh * 128 + 64 * dvh + 4 * hi; const float rstd8 = rstd * F8_SO;
#pragma unroll
        for (int d0 = 0; d0 < 2; ++d0)
#pragma unroll
            for (int a4 = 0; a4 < 4; ++a4) { const v2u gr = grr[d0][a4];
                const float y0 = silu_f(bflo(gr.x)) * (o[d0][4 * a4] - mean) * rstd8, y1 = silu_f(bfhi(gr.x)) * (o[d0][4 * a4 + 1] - mean) * rstd8;
                const float y2 = silu_f(bflo(gr.y)) * (o[d0][4 * a4 + 2] - mean) * rstd8, y3 = silu_f(bfhi(gr.y)) * (o[d0][4 * a4 + 3] - mean) * rstd8;
                *(GAS unsigned*)(op + 32 * d0 + 8 * a4) = cvt4_fp8(y0, y1, y2, y3); }
    }
    WAIT_BAR0();
#undef RDMA
}
#undef GLDS16
}
#ifndef GEMM_ALIGN
#define GEMM_ALIGN true
#endif
#ifndef MK_ONE_LAUNCH
#define MK_ONE_LAUNCH 1
#endif
constexpr int NPHASE = 11;
__global__ void __launch_bounds__(NTHR, 2) fwd(Args args) {
    extern __shared__ __attribute__((aligned(16))) unsigned char lds_raw[];
    Frame F;
    F.lds = (LAS unsigned char*)lds_raw;
    F.MISC = (volatile LAS unsigned*)(F.lds + MISC_OFF);
    F.tid = threadIdx.x; F.lane = F.tid & 63; F.wave = __builtin_amdgcn_readfirstlane(F.tid >> 6);
    F.G = gridDim.x; F.bx = blockIdx.x;
    unsigned char* ws = args.ws;
    F.ctl = (gu32*)(ws + WS_CTL);
    for (int u = F.tid; u < (LDS_BYTES - LDSCTL_OFF) / 4; u += NTHR) ((LAS unsigned*)(F.lds + LDSCTL_OFF))[u] = 0u;
    __syncthreads();
    XcdBarrier bar; bar.bar = (unsigned*)(F.ctl + CW_BAR); bar.x = 0; bar.st = nullptr;
    const int lo = args.ph_lo, hi = args.ph_hi;
    if (hi - lo > 1) bar = xcd_barrier_post((unsigned*)(F.ctl + CW_BAR), F.MISC + 8);
#ifdef ONLY_PHASE
#define IN(k) ((k) == ONLY_PHASE && lo <= (k) && (k) < hi)
#else
#define IN(k) (lo <= (k) && (k) < hi)
#endif
#define SEAM(k) do { if (IN(k) && IN((k) + 1)) xcd_barrier(bar); } while (0)
    LAS unsigned char* ring = F.lds;

#ifndef REP_PHASE
#define REP_PHASE -1
#endif
    int rep_id = 0;
#define RUN(k, ...) do { if (IN(k)) { { __VA_ARGS__ } if (REP_PHASE == (k)) { xcd_barrier(bar); rep_id = 1; { __VA_ARGS__ } rep_id = 0; } SEAM(k); } } while (0)
    RUN(0, p0_prologue(F, args););
    RUN(1, p1_norm1(F, args););
    RUN(2,
        pg8::Gemm g{(const bf16*)(ws + WS_B), (const bf16*)(ws + WS_WIN), DM, DM}; pg8::StaticOrder S; S.init(T, INWP, F.G, F.bx);
#ifdef GEMM_STAGGER_US
        { const unsigned long long t0 = __builtin_amdgcn_s_memrealtime(); const unsigned long long dly = (unsigned long long)(((F.bx >> 3) & 3) * GEMM_STAGGER_US) * 100ull;
          while (__builtin_amdgcn_s_memrealtime() - t0 < dly) __builtin_amdgcn_s_sleep(8); }
#endif
#ifdef REP_NULL_EPI
        if (rep_id == 1) {
#if REP_NULL_EPI == 2
            pg8::EpiBf16 E0{(bf16*)(ws + WS_B), INWP}; pg8::gemm_phase<pg8::EpiBf16, pg8::StaticOrder, GEMM_ALIGN>(ring, g, S, E0);
#else
            pg8::EpiNull E0{(float*)(ws + WS_END)}; pg8::gemm_phase<pg8::EpiNull, pg8::StaticOrder, GEMM_ALIGN>(ring, g, S, E0);
#endif
        } else
#endif
        { pg8::EpiProj E{(bf16*)(ws + WS_A), (const int*)args.in[2], (float*)(ws + WS_PQ), (float*)(ws + WS_PKV)};
        pg8::gemm_phase<pg8::EpiProj, pg8::StaticOrder, GEMM_ALIGN>(ring, g, S, E); }
    );
    RUN(4,
        { pg8::Gemm g{(const bf16*)(ws + WS_A) + C_CQ, (const bf16*)(ws + WS_WUQ), INWP, 256}; pg8::StaticOrder S; S.init(T, QW, F.G, F.bx);
          pg8::EpiScaled<8, 256> E{(bf16*)(ws + WS_B), QW, (const float*)(ws + WS_PQ), nullptr};
          pg8::gemm_phase<pg8::EpiScaled<8, 256>, pg8::StaticOrder, GEMM_ALIGN>(ring, g, S, E); }
        { pg8::Gemm g{(const bf16*)(ws + WS_A) + C_CKV, (const bf16*)(ws + WS_WUKV), INWP, 128}; pg8::StaticOrder S; S.init(T, KVW, F.G, F.bx);
          pg8::EpiScaled<4, 128> E{(bf16*)(ws + WS_C), KVW, (const float*)(ws + WS_PKV), ws + WS_K8};
          pg8::gemm_phase<pg8::EpiScaled<4, 128>, pg8::StaticOrder, GEMM_ALIGN>(ring, g, S, E); }
    );
    RUN(5,
        const bf16* proj = (const bf16*)(ws + WS_A); unsigned char* omix = ws + WS_D;
#ifndef REP5_MODE
#define REP5_MODE 0
#endif
        if (!(rep_id == 1 && REP5_MODE == 2)) for (int u = F.bx; u < NB * 4; u += F.G) mix::ret_unit(ring, u >> 2, u & 3, proj, omix);
        volatile LAS int* qs = (volatile LAS int*)(F.MISC + 16);
        if (!(rep_id == 1 && REP5_MODE == 1)) {
            if (F.tid == 0) qs[0] = (int)__hip_atomic_fetch_add(F.ctl + CW_QUEUE + 64 * rep_id, 1u, RLX_AGENT);
            __syncthreads();
            int u = qs[0];
            while (u < NB * 8 * 16) {
                int nxt = 0;
#if REP_PHASE != 5
                if (F.tid == 0) nxt = (int)__hip_atomic_fetch_add(F.ctl + CW_QUEUE + 64 * rep_id, 1u, RLX_AGENT);
#endif
                const int qb = 15 - (u >> 7), bh = u & 127;
#ifdef ATTN_PROBE
                if (rep_id) mix::attn_unit<ATTN_PROBE>(ring, bh >> 3, bh & 7, qb, (const bf16*)(ws + WS_B), ws + WS_C, ws + WS_K8, proj, (const int*)args.in[2], ws + WS_END); else
#endif
                mix::attn_unit(ring, bh >> 3, bh & 7, qb, (const bf16*)(ws + WS_B), ws + WS_C, ws + WS_K8, proj, (const int*)args.in[2], omix);
#if REP_PHASE == 5
                if (F.tid == 0) nxt = (int)__hip_atomic_fetch_add(F.ctl + CW_QUEUE + 64 * rep_id, 1u, RLX_AGENT);
#endif
                if (F.tid == 0) qs[0] = nxt;
                __syncthreads();
                u = qs[0];
            }
        }
    );
#ifdef SELFCHECK
    if (IN(5)) { selfcheck_phase(F, args); xcd_barrier(bar); }
#endif
    RUN(6,
        pg8::Gemm g{(const bf16*)(ws + WS_D), (const bf16*)(ws + WS_WO), DM / 2, DM / 2, F8_E32, F8_E8}; pg8::StaticOrder S; S.init(T, DM, F.G, F.bx);
#ifdef P6_STAGGER_US
        { const unsigned long long t0 = __builtin_amdgcn_s_memrealtime(); const unsigned long long dly = (unsigned long long)(((F.bx >> 3) & 3) * P6_STAGGER_US) * 100ull;
          while (__builtin_amdgcn_s_memrealtime() - t0 < dly) __builtin_amdgcn_s_sleep(8); }
#endif
        pg8::EpiResid E{(const float*)args.in[0], (const float*)(ws + WS_MOD), (bf16*)(ws + WS_A), (float*)(ws + WS_PART)};
        pg8::gemm_phase<pg8::EpiResid, pg8::StaticOrder, GEMM_ALIGN, false, true>(ring, g, S, E);
    );
    RUN(7, p7_norm2_router(F, args, rep_id););
    if (IN(8) || IN(9) || IN(10)) {
        LAS int* pre = (LAS int*)(F.MISC + 32);
        LAS int* ppre = (LAS int*)(F.MISC + 96);
        if (F.tid < NE) pre[F.tid + 1] = ((int)__hip_atomic_load(F.ctl + CW_CNT + F.tid * CNT_STRIDE, RLX_AGENT) + 255) >> 8;
        else if (F.tid >= 64 && F.tid < 64 + NPAIR) ppre[F.tid - 64 + 1] = ((int)__hip_atomic_load(F.ctl + CW_PCNT + (F.tid - 64) * CNT_STRIDE, RLX_AGENT) + 255) >> 8;
        __syncthreads();
        if (F.tid == 0) { int s = 0; pre[0] = 0; for (int e = 1; e <= NE; ++e) { s += pre[e]; pre[e] = s; } }
        else if (F.tid == 64) { int s = 0; ppre[0] = 0; for (int q = 1; q <= NPAIR; ++q) { s += ppre[q]; ppre[q] = s; } }
        __syncthreads();
        const int* cnt = (const int*)(F.ctl + CW_CNT); const int* tok = (const int*)(ws + WS_TOK);
        RUN(8,
            pg8::Gemm g{(const bf16*)(ws + WS_B), (const bf16*)(ws + WS_W13), DM / 2, DM / 2, F8_E32, F8_E1}; pg8::MoeOrder S{F.G, F.bx, 2, pre, cnt, tok};
            pg8::EpiSwiGLU2 E{ws + WS_C, tok, (const int*)(ws + WS_PTI), (const float*)(ws + WS_GATEW), ppre};
            pg8::gemm_phase<pg8::EpiSwiGLU2, pg8::MoeOrder, GEMM_ALIGN, true, true>(ring, g, S, E);
        );
        RUN(9,
            pg8::Gemm g{(const bf16*)(ws + WS_C), (const bf16*)(ws + WS_W2), DE, DE / 2, F8_E16, F8_E8}; pg8::PairOrder S{F.G, F.bx, ppre};
            pg8::EpiFp8 E{ws + WS_D, DM, F8_SY};
            pg8::gemm_phase<pg8::EpiFp8, pg8::PairOrder, GEMM_ALIGN, false, true>(ring, g, S, E);
        );
#ifdef SELFCHECK
        if (IN(10)) { selfcheck_moe(F, args, ppre); xcd_barrier(bar); }
#endif
        RUN(10, p10_final(F, args, ppre););
    }
#undef RUN
#undef IN
#undef SEAM
}

extern "C" void kernel_launch(void* const* d_in, const int* in_sizes, int n_in, void* d_out, int out_size, void* d_ws, size_t ws_size, hipStream_t stream) {
    static int grid = 0;
    if (grid == 0) {
        if (n_in != 21 || in_sizes[0] != T * DM || out_size != T * DM || ws_size < WS_END) { fprintf(stderr, "kernel_launch: unexpected shapes (n_in %d, in0 %d, out %d, ws %zu); nothing launched\n", n_in, n_in > 0 ? in_sizes[0] : -1, out_size, ws_size); grid = -1; return; }
        int dev = 0, cus = 0, per_cu = 0;
        if (hipGetDevice(&dev) != hipSuccess || hipDeviceGetAttribute(&cus, hipDeviceAttributeMultiprocessorCount, dev) != hipSuccess) { grid = -1; return; }
        if (hipFuncSetAttribute((const void*)fwd, hipFuncAttributeMaxDynamicSharedMemorySize, LDS_BYTES) != hipSuccess) { fprintf(stderr, "kernel_launch: hipFuncSetAttribute failed\n"); grid = -1; return; }
        if (hipOccupancyMaxActiveBlocksPerMultiprocessor(&per_cu, (const void*)fwd, NTHR, LDS_BYTES) != hipSuccess || per_cu < 1) fprintf(stderr, "kernel_launch: occupancy query reports %d\n", per_cu);
        (void)hipGetLastError();
        grid = cus;
    }
    if (grid < 0) return;
    if (hipMemsetAsync((char*)d_ws + WS_CTL, 0, CTL_ZERO_BYTES, stream) != hipSuccess) return;
    Args a{};
    for (int i = 0; i < 21; ++i) a.in[i] = d_in[i];
    a.out = (float*)d_out; a.ws = (unsigned char*)d_ws;
#if MK_ONE_LAUNCH
    a.ph_lo = 0; a.ph_hi = NPHASE;
    hipLaunchKernelGGL(fwd, dim3(grid), dim3(NTHR), LDS_BYTES, stream, a);
#else
    for (int p = 0; p < NPHASE; ++p) { a.ph_lo = p; a.ph_hi = p + 1; hipLaunchKernelGGL(fwd, dim3(grid), dim3(NTHR), LDS_BYTES, stream, a); }
#endif
}
```

```cpp
#include <hip/hip_runtime.h>
#include <cstdio>
#include <cstdint>

#define GAS __attribute__((address_space(1)))
#define LAS __attribute__((address_space(3)))
typedef unsigned short bf16;
typedef unsigned v4u __attribute__((ext_vector_type(4)));
typedef unsigned v2u __attribute__((ext_vector_type(2)));
typedef float f32x2 __attribute__((ext_vector_type(2)));
typedef float f32x4 __attribute__((ext_vector_type(4)));
typedef float f32x16 __attribute__((ext_vector_type(16)));
typedef short bf16x8 __attribute__((ext_vector_type(8)));
typedef short s16x4 __attribute__((ext_vector_type(4)));
typedef GAS unsigned gu32;

constexpr int DM = 1024, NB = 16, SEQ = 4096, T = NB * SEQ;
constexpr int INW = 1952, INWP = 2048;
constexpr int C_CQ = 0, C_CKV = 256, C_KR = 384, C_RQ = 416, C_RK = 672, C_RV = 928, C_RG = 1440;
constexpr int QW = 768, KVW = 1024;
constexpr int NE = 32, DE = 256, CAP = 65536;
constexpr int MODW = 6 * DM;
constexpr float EPS = 1e-6f;
constexpr int NWAVES = 8, NTHR = 512;

constexpr size_t MiB = 1u << 20;
constexpr size_t WS_CTL = 0, CTL_ZERO_BYTES = 256 * 1024;
constexpr size_t WS_MOD = 1 * MiB;
constexpr size_t WS_WR = 1 * MiB + 512 * 1024;
constexpr size_t WS_WIN = 2 * MiB, WS_WUQ = 6 * MiB, WS_WUKV = 6 * MiB + 512 * 1024, WS_WO = 7 * MiB, WS_W13 = 9 * MiB, WS_W2 = 41 * MiB;
constexpr size_t WS_PQ = 70 * MiB;
constexpr size_t WS_PKV = 60 * MiB;
constexpr size_t WS_PART = 57 * MiB;
constexpr size_t WS_GATEW = 61 * MiB;
constexpr size_t WS_REC = (456 + 64) * MiB;
constexpr size_t WS_SLOT = 61 * MiB + 512 * 1024;
constexpr size_t WS_PTI = 1 * MiB + 768 * 1024;
constexpr int NPAIR = 4 * 28;
constexpr size_t WS_TOK = 62 * MiB;
constexpr size_t WS_A = 72 * MiB;
constexpr size_t WS_K8 = (328 + 96) * MiB;
constexpr size_t WS_B = 328 * MiB;
constexpr size_t WS_C = 456 * MiB;
constexpr size_t WS_D = 584 * MiB;
constexpr size_t WS_END = 872 * MiB;
constexpr int CW_TMO = 0, CW_CODE = 1, CW_BAR = 4096, CW_CNT = 8192, CNT_STRIDE = 64, CW_CNT2 = 12288, CW_QUEUE = 16384, CW_PCNT = 32768;

constexpr int RING_BYTES = 149504;
constexpr int LDSCTL_OFF = 150528, MISC_OFF = LDSCTL_OFF;
constexpr int LDS_BYTES = 151552;

#define RLX_AGENT __ATOMIC_RELAXED, __HIP_MEMORY_SCOPE_AGENT
#define LDS_WAIT() asm volatile("s_waitcnt lgkmcnt(0)" ::: "memory")
#define VM_WAIT() asm volatile("s_waitcnt vmcnt(0)" ::: "memory")
#define WAIT_BAR0() asm volatile("s_waitcnt vmcnt(0) lgkmcnt(0)\n\ts_barrier" ::: "memory")
#define LGK_BAR() asm volatile("s_waitcnt lgkmcnt(0)\n\ts_barrier" ::: "memory")
__device__ __forceinline__ unsigned f2bf(float f) { unsigned u = __builtin_bit_cast(unsigned, f); return (u + 0x7fffu + ((u >> 16) & 1u)) >> 16; }
__device__ __forceinline__ unsigned pk2(float lo, float hi) { return f2bf(lo) | (f2bf(hi) << 16); }
typedef __bf16 bf16x2_t __attribute__((ext_vector_type(2)));
__device__ __forceinline__ unsigned cvtpk2(float lo, float hi) { f32x2 v = {lo, hi}; bf16x2_t b = __builtin_convertvector(v, bf16x2_t); return __builtin_bit_cast(unsigned, b); }
__device__ __forceinline__ float clamp448(float v) { return __builtin_fminf(__builtin_fmaxf(v, -448.0f), 448.0f); }
__device__ __forceinline__ unsigned cvt4_fp8(float a, float b, float c, float d) { int p = __builtin_amdgcn_cvt_pk_fp8_f32(clamp448(a), clamp448(b), 0, false); p = __builtin_amdgcn_cvt_pk_fp8_f32(clamp448(c), clamp448(d), p, true); return (unsigned)p; }
constexpr float F8_SW13 = 32.0f, F8_SW2 = 16.0f, F8_SH = 8.0f, F8_SY = 16.0f;
constexpr float F8_SWO = 32.0f, F8_SO = 8.0f;
constexpr unsigned F8_E1 = 0x7f7f7f7fu, F8_E32 = 0x7a7a7a7au, F8_E16 = 0x7b7b7b7bu, F8_E8 = 0x7c7c7c7cu;
__device__ __forceinline__ f32x4 fp8x4_f32(unsigned w) { return (f32x4){__builtin_amdgcn_cvt_f32_fp8((int)w, 0), __builtin_amdgcn_cvt_f32_fp8((int)w, 1), __builtin_amdgcn_cvt_f32_fp8((int)w, 2), __builtin_amdgcn_cvt_f32_fp8((int)w, 3)}; }
__device__ __forceinline__ float bf2f(unsigned b) { return __builtin_bit_cast(float, b << 16); }
__device__ __forceinline__ float bflo(unsigned w) { return __builtin_bit_cast(float, w << 16); }
__device__ __forceinline__ float bfhi(unsigned w) { return __builtin_bit_cast(float, w & 0xffff0000u); }
__device__ __forceinline__ float wave_sum(float v) {
#pragma unroll
    for (int o = 1; o < 64; o <<= 1) v += __shfl_xor(v, o);
    return v;
}
__device__ __forceinline__ float silu_f(float v) { return v / (1.0f + __expf(-v)); }

#define XB_TMO      128
#define XB_XCNT(j)  (256  + 64 * (j))
#define XB_XSUB(j)  (1280 + 64 * (j))
#define XB_XGEN(j)  (2304 + 64 * (j))
#define XB_TOP      3328
#define XB_TOPGEN   3392
#define XCD_BAR_WORDS 3456
#define XB_SPIN_CAP (1u << 22)
__device__ __forceinline__ unsigned xb_ld(unsigned* p)              { return __hip_atomic_load(p, __ATOMIC_RELAXED, __HIP_MEMORY_SCOPE_AGENT); }
__device__ __forceinline__ unsigned xb_add(unsigned* p, unsigned v) { return __hip_atomic_fetch_add(p, v, __ATOMIC_RELAXED, __HIP_MEMORY_SCOPE_AGENT); }
__device__ __forceinline__ unsigned xb_xcc_id() { return (unsigned)__builtin_amdgcn_s_getreg((3 << 11) | 20) & 0xFu; }
#define XB_SPIN(cond, bar) do { unsigned _sp = 0; while (cond) { __builtin_amdgcn_s_sleep(1); \
    if ((++_sp & 255u) == 0u) { if (xb_ld(&(bar)[XB_TMO])) break; if (_sp > XB_SPIN_CAP) { atomicAdd(&(bar)[XB_TMO], 1u); break; } } } } while (0)
struct XcdBarrier { unsigned* bar; unsigned x; volatile LAS unsigned* st; };
__device__ __forceinline__ XcdBarrier xcd_barrier_post(unsigned* bar, volatile LAS unsigned* st) {
    XcdBarrier b; b.bar = bar; b.x = xb_xcc_id(); b.st = st;
    if (threadIdx.x == 0) (void)xb_add(&bar[XB_XCNT(b.x)], 1u);
    return b;
}
__device__ __forceinline__ void xcd_barrier_complete(unsigned* bar, unsigned x, unsigned& nloc, unsigned& nx) {
    const unsigned G = gridDim.x * gridDim.y * gridDim.z;
    unsigned sum, cnt, mine, sp = 0u;
    for (;;) {
        sum = 0u; cnt = 0u; mine = 0u;
#pragma unroll
        for (unsigned j = 0; j < 16; ++j) { const unsigned c = xb_ld(&bar[XB_XCNT(j)]); sum += c; cnt += (c > 0u) ? 1u : 0u; mine = (j == x) ? c : mine; }
        if (sum == G) break;
        __builtin_amdgcn_s_sleep(1);
        if ((++sp & 255u) == 0u) { if (xb_ld(&bar[XB_TMO])) break; if (sp > XB_SPIN_CAP) { atomicAdd(&bar[XB_TMO], 1u); break; } }
    }
    nloc = mine > 0u ? mine : 1u; nx = cnt > 0u ? cnt : 1u;
}
__device__ __forceinline__ void xcd_barrier(const XcdBarrier& b) {
    asm volatile("s_waitcnt vmcnt(0)" ::: "memory");
    __syncthreads();
    if (threadIdx.x == 0) {
        unsigned* bar = b.bar;
        __builtin_amdgcn_s_waitcnt(0);
        unsigned nloc = b.st[0], nx = b.st[1];
        if (nloc == 0u) { xcd_barrier_complete(bar, b.x, nloc, nx); b.st[0] = nloc; b.st[1] = nx; }
        const unsigned old = xb_add(&bar[XB_XSUB(b.x)], 1u);
        const unsigned gen = old / nloc;
        if (old + 1u == (gen + 1u) * nloc) {
            __builtin_amdgcn_fence(__ATOMIC_RELEASE, "agent");
            asm volatile("s_waitcnt vmcnt(0)" ::: "memory");
            const unsigned og = xb_add(&bar[XB_TOP], 1u);
            const unsigned tg = og / nx;
            if (og + 1u == (tg + 1u) * nx) xb_add(&bar[XB_TOPGEN], 1u);
            else XB_SPIN(xb_ld(&bar[XB_TOPGEN]) == tg, bar);
            __builtin_amdgcn_fence(__ATOMIC_ACQUIRE, "agent");
            xb_add(&bar[XB_XGEN(b.x)], 1u);
            asm volatile("s_waitcnt vmcnt(0)" ::: "memory");
        } else {
            XB_SPIN(xb_ld(&bar[XB_XGEN(b.x)]) == gen, bar);
            __builtin_amdgcn_fence(__ATOMIC_ACQUIRE, "agent");
            asm volatile("s_waitcnt vmcnt(0)" ::: "memory");
        }
    }
    __syncthreads();
}
namespace pg8 {
constexpr int BM = 256, BK = 64, HALF = 128, HTB = HALF * BK * 2, STAGE_BYTES = 8 * HTB, NXCD = 8, WGM = 8;
__host__ __device__ __forceinline__ int lds_byte(int r, int c) { const int st = (r >> 4) * 2 + (c >> 5), rr = r & 15, cc = c & 31, ob = rr * 64 + cc * 2; return st * 1024 + (ob ^ (((ob >> 9) & 1) << 5)); }
__host__ __device__ __forceinline__ void stage_rc(int b, int& R, int& C) { const int st = b / 1024, sb = b % 1024, swz = sb ^ (((sb >> 9) & 1) << 5); R = (st >> 1) * 16 + swz / 64; C = (st & 1) * 32 + (swz % 64) / 2; }
__host__ __device__ __forceinline__ int perm32(int rho) { const int n = rho >> 4, i = rho & 15; return 8 * (i >> 2) + 4 * n + (i & 3); }

struct Unit { int pm, pn, e, rb, nv, pnl, acol, cont; };
struct Gemm { const bf16* A; const bf16* Bt; int lda, K; unsigned sw = 0x7f7f7f7fu, sx = 0x7f7f7f7fu; };

struct StaticOrder {
    int nM, nN, nwg, G, c;
    __device__ void init(int M, int N, int G_, int c_) { nM = M / BM; nN = N / BM; nwg = nM * nN; G = G_; c = c_; }
    __device__ bool next(int i, Unit& u) const {
        const long L = (long)i * G + c; if (L >= nwg) return false;
        int wgid = (int)L; { const int q = nwg / NXCD, r = nwg % NXCD, xcd = wgid % NXCD, off = wgid / NXCD; wgid = (xcd < r ? xcd * (q + 1) : r * (q + 1) + (xcd - r) * q) + off; }
        const int nig = WGM * nN, gid = wgid / nig, fm = gid * WGM, gsz = (nM - fm) < WGM ? (nM - fm) : WGM;
        u.pm = fm + ((wgid % nig) % gsz); u.pn = (wgid % nig) / gsz; u.e = 0; u.rb = 0; u.nv = 256; u.pnl = u.pn; u.acol = 0; u.cont = 0; return true;
    }
    __device__ __forceinline__ unsigned arow(const Unit& u, int r) const { return (unsigned)(u.pm * BM + r); }
};
struct MoeOrder {
    int G, c, ncol; const LAS int* pre; const int* cnt; const int* tok;
    __device__ bool next(int i, Unit& u) const {
        const int L = i * G + c, gb = L / ncol, pl = L % ncol;
        if (gb >= pre[NE]) return false;
        const int lj = threadIdx.x & 31;
        const unsigned long long bm = __ballot(pre[lj] <= gb) & 0xffffffffull;
        const int e = 31 - __builtin_clz((unsigned)bm);
        u.pm = gb; u.e = e; u.rb = gb - pre[e]; u.pnl = pl; u.pn = e * ncol + pl; u.acol = 0; u.cont = 0;
        const int left = cnt[e * CNT_STRIDE] - u.rb * 256; u.nv = left < 256 ? left : 256; return true;
    }
    __device__ __forceinline__ unsigned arow(const Unit& u, int r) const {
        if (tok) return (r < u.nv) ? (unsigned)(tok[(size_t)u.e * CAP + u.rb * 256 + r] >> 1) : 0u;
        return (unsigned)(u.pm * BM + r);
    }
};

struct PairOrder {
    int G, c; const LAS int* ppre;
    __device__ bool next(int i, Unit& u) const {
        const int L = (i >> 1) * G + c, h = i & 1, gb = L >> 2, pl = L & 3;
        if (gb >= ppre[NPAIR]) return false;
        const int lj = threadIdx.x & 63;
        const unsigned long long b0 = __ballot(ppre[lj] <= gb), b1 = __ballot(lj < NPAIR - 64 && ppre[64 + lj] <= gb);
        const int pid = b1 ? 127 - __builtin_clzll(b1) : 63 - __builtin_clzll(b0);
        int pidx = pid % 28, a = 0; const int g = pid / 28;
        while (pidx >= 7 - a) { pidx -= 7 - a; ++a; }
        const int b = a + 1 + pidx;
        u.pm = gb; u.e = pid; u.rb = gb - ppre[pid]; u.pnl = pl; u.pn = (g * 8 + (h ? b : a)) * 4 + pl; u.nv = 256; u.acol = h * 256; u.cont = h; return true;
    }
    __device__ __forceinline__ unsigned arow(const Unit& u, int r) const { return (unsigned)(u.pm * BM + r); }
};

__device__ __forceinline__ unsigned cvt_pk_bf16(float lo, float hi) { return cvtpk2(lo, hi); }

struct EpiBf16 {
    static constexpr bool PERM = true;
    bf16* O; int ldc;
    __device__ __forceinline__ void operator()(const f32x4 (&acc)[2][2][4][2], const Unit& u, int wr, int wc, int fr, int fq) const {
        const int row0 = u.pm * BM + wr * 64 + fr; const int col0 = u.pnl * BM + wc * 32 + 8 * fq;
#pragma unroll
        for (int ai = 0; ai < 2; ++ai)
#pragma unroll
            for (int m = 0; m < 4; ++m) { bf16* rowp = O + (size_t)(row0 + ai * HALF + m * 16) * ldc + col0;
#pragma unroll
                for (int bj = 0; bj < 2; ++bj) { const f32x4 v0 = acc[ai][bj][m][0], v1 = acc[ai][bj][m][1];
                    v4u w; w.x = cvt_pk_bf16(v0[0], v0[1]); w.y = cvt_pk_bf16(v0[2], v0[3]); w.z = cvt_pk_bf16(v1[0], v1[1]); w.w = cvt_pk_bf16(v1[2], v1[3]);
                    *(v4u*)(rowp + bj * HALF) = w; } }
    }
};
struct EpiFp8 {
    static constexpr bool PERM = true;
    unsigned char* O; int ldc; float scale;
    __device__ __forceinline__ void operator()(const f32x4 (&acc)[2][2][4][2], const Unit& u, int wr, int wc, int fr, int fq) const {
        const int row0 = u.pm * BM + wr * 64 + fr; const int col0 = u.pnl * BM + wc * 32 + 8 * fq;
#pragma unroll
        for (int ai = 0; ai < 2; ++ai)
#pragma unroll
            for (int m = 0; m < 4; ++m) { unsigned char* rowp = O + (size_t)(row0 + ai * HALF + m * 16) * ldc + col0;
#pragma unroll
                for (int bj = 0; bj < 2; ++bj) { const f32x4 v0 = acc[ai][bj][m][0] * scale, v1 = acc[ai][bj][m][1] * scale;
                    v2u w; w.x = cvt4_fp8(v0[0], v0[1], v0[2], v0[3]); w.y = cvt4_fp8(v1[0], v1[1], v1[2], v1[3]);
                    *(v2u*)(rowp + bj * HALF) = w; } }
    }
};
struct EpiProj {
    static constexpr bool PERM = true;
    bf16* O; const int* positions; float* pq; float* pkv;
    __device__ __forceinline__ void operator()(const f32x4 (&acc)[2][2][4][2], const Unit& u, int wr, int wc, int fr, int fq) const {
        const int row0 = u.pm * BM + wr * 64 + fr;
        const float L2B = 13.287712379549449f, I2PI = 0.15915494309189535f;
        float posr[2][4];
#pragma unroll
        for (int ai = 0; ai < 2; ++ai)
#pragma unroll
            for (int m = 0; m < 4; ++m) posr[ai][m] = (u.pnl >= 1 && u.pnl <= 3) ? (float)positions[row0 + ai * HALF + m * 16] : 0.f;
#pragma unroll
        for (int bj = 0; bj < 2; ++bj) {
            const int seg = u.pnl * BM + bj * HALF + wc * 32;
            if (seg >= INW) continue;
            const int kind = seg < 256 ? 0 : seg < 384 ? 1 : seg < 416 ? 2 : seg < 672 ? 3 : seg < 928 ? 4 : 5;
            float cf[4]; float lgh = 0.f;
            if (kind == 2) {
#pragma unroll
                for (int i = 0; i < 4; ++i) cf[i] = exp2f(-(float)(4 * fq + i) * (1.f / 16.f) * L2B) * I2PI;
            } else if (kind == 3 || kind == 4) { const int base = kind == 3 ? 416 : 672, hh = (seg - base) >> 6, off = ((seg - base) & 63) + 8 * fq;
                lgh = log2f(1.0f - exp2f(-5.0f - (float)hh));
#pragma unroll
                for (int i = 0; i < 4; ++i) cf[i] = exp2f(-(float)(off / 2 + i) * (1.f / 32.f) * L2B) * I2PI;
            } else {
#pragma unroll
                for (int i = 0; i < 4; ++i) cf[i] = 0.f; }
#pragma unroll
            for (int ai = 0; ai < 2; ++ai)
#pragma unroll
                for (int m = 0; m < 4; ++m) { const int row = row0 + ai * HALF + m * 16;
                    float v[8];
#pragma unroll
                    for (int i = 0; i < 4; ++i) { v[i] = acc[ai][bj][m][0][i]; v[4 + i] = acc[ai][bj][m][1][i]; }
                    if (kind <= 1) { float ss = 0.f;
#pragma unroll
                        for (int i = 0; i < 8; ++i) ss += v[i] * v[i];
                        ss += __shfl_xor(ss, 16); ss += __shfl_xor(ss, 32);
                        if (fq == 0) { if (kind == 0) pq[(size_t)row * 8 + bj * 4 + wc] = ss; else pkv[(size_t)row * 4 + wc] = ss; }
                    } else if (kind <= 4) { const float pos = posr[ai][m]; float scl = 1.0f;
                        if (kind >= 3) { const float lg = lgh * (float)((row & 127) + 1); scl = kind == 3 ? exp2f(lg) : 0.125f * exp2f(-lg); }
#pragma unroll
                        for (int i = 0; i < 4; ++i) { float t = pos * cf[i]; t -= floorf(t); const float sn = __builtin_amdgcn_sinf(t), cs = __builtin_amdgcn_cosf(t);
                            const float x1 = v[2 * i], x2 = v[2 * i + 1]; v[2 * i] = (x1 * cs - x2 * sn) * scl; v[2 * i + 1] = (x1 * sn + x2 * cs) * scl; } }
                    v4u w; w.x = cvt_pk_bf16(v[0], v[1]); w.y = cvt_pk_bf16(v[2], v[3]); w.z = cvt_pk_bf16(v[4], v[5]); w.w = cvt_pk_bf16(v[6], v[7]);
                    *(v4u*)(O + (size_t)row * INWP + seg + 8 * fq) = w; }
        }
    }
};
template <int NP, int NC> struct EpiScaled {
    static constexpr bool PERM = true;
    bf16* O; int ldc; const float* part; unsigned char* k8;
    __device__ __forceinline__ void operator()(const f32x4 (&acc)[2][2][4][2], const Unit& u, int wr, int wc, int fr, int fq) const {
        const int row0 = u.pm * BM + wr * 64 + fr; const int col0 = u.pnl * BM + wc * 32 + 8 * fq;
        float rstd[2][4];
        { f32x4 pv[2][4][NP / 4];
#pragma unroll
          for (int ai = 0; ai < 2; ++ai)
#pragma unroll
              for (int m = 0; m < 4; ++m)
#pragma unroll
                  for (int p = 0; p < NP / 4; ++p) pv[ai][m][p] = *(const f32x4*)(part + (size_t)(row0 + ai * HALF + m * 16) * NP + 4 * p);
#pragma unroll
          for (int ai = 0; ai < 2; ++ai)
#pragma unroll
              for (int m = 0; m < 4; ++m) { float ss = 0.f;
#pragma unroll
                  for (int p = 0; p < NP / 4; ++p) ss += (pv[ai][m][p].x + pv[ai][m][p].y) + (pv[ai][m][p].z + pv[ai][m][p].w);
                  rstd[ai][m] = 1.0f / sqrtf(ss * (1.f / NC) + EPS); } }
        asm volatile("" ::: "memory");
#pragma unroll
        for (int ai = 0; ai < 2; ++ai)
#pragma unroll
            for (int m = 0; m < 4; ++m) { const int row = row0 + ai * HALF + m * 16; const float rs = rstd[ai][m];
                bf16* rowp = O + (size_t)row * ldc + col0;
#pragma unroll
                for (int bj = 0; bj < 2; ++bj) { const f32x4 v0 = acc[ai][bj][m][0] * rs, v1 = acc[ai][bj][m][1] * rs;
                    if (NP == 4 && wc < 2) { v2u w8; w8.x = cvt4_fp8(v0[0], v0[1], v0[2], v0[3]); w8.y = cvt4_fp8(v1[0], v1[1], v1[2], v1[3]);
                        *(v2u*)(k8 + (size_t)row * 512 + (2 * u.pnl + bj) * 64 + wc * 32 + 8 * fq) = w8; continue; }
                    if (NP == 4) {
                        const int k = row & 63, k5 = k & 31, pos = 32 * ((k5 >> 2) & 1) + 16 * (k >> 5) + 4 * (k5 >> 3) + (k5 & 3);
                        const int dvb = (wc - 2) * 32 + 8 * fq;
                        unsigned char* vb = (unsigned char*)O + ((size_t)(((row >> 12) * 8 + 2 * u.pnl + bj) * 64 + ((row & 4095) >> 6)) * 64 + dvb) * 64 + (pos & 15);
                        const int pa = (((pos >> 4) ^ ((dvb >> 2) & 3)) << 4), pb = (((pos >> 4) ^ (((dvb >> 2) + 1) & 3)) << 4);
                        const unsigned wa = cvt4_fp8(v0[0], v0[1], v0[2], v0[3]), wb = cvt4_fp8(v1[0], v1[1], v1[2], v1[3]);
                        vb[pa] = (unsigned char)wa; vb[pa + 64] = (unsigned char)(wa >> 8); vb[pa + 128] = (unsigned char)(wa >> 16); vb[pa + 192] = (unsigned char)(wa >> 24);
                        vb[pb + 256] = (unsigned char)wb; vb[pb + 320] = (unsigned char)(wb >> 8); vb[pb + 384] = (unsigned char)(wb >> 16); vb[pb + 448] = (unsigned char)(wb >> 24); continue; }
                    v4u w; w.x = cvt_pk_bf16(v0[0], v0[1]); w.y = cvt_pk_bf16(v0[2], v0[3]); w.z = cvt_pk_bf16(v1[0], v1[1]); w.w = cvt_pk_bf16(v1[2], v1[3]);
                    *(v4u*)(rowp + bj * HALF) = w; } }
    }
};
struct EpiNull {
    static constexpr bool PERM = true;
    float* sink;
    __device__ __forceinline__ void operator()(const f32x4 (&acc)[2][2][4][2], const Unit& u, int wr, int wc, int fr, int fq) const {
        float s = 0.f;
#pragma unroll
        for (int ai = 0; ai < 2; ++ai)
#pragma unroll
            for (int bj = 0; bj < 2; ++bj)
#pragma unroll
                for (int m = 0; m < 4; ++m)
#pragma unroll
                    for (int n = 0; n < 2; ++n) s += acc[ai][bj][m][n][0];
        if (s == 1.2345e30f) sink[0] = s;
    }
};
struct EpiResid {
    static constexpr bool PERM = true;
    const float* x; const float* mod; bf16* x1; float* part;
    __device__ __forceinline__ void operator()(const f32x4 (&acc)[2][2][4][2], const Unit& u, int wr, int wc, int fr, int fq) const {
        const int row0 = u.pm * BM + wr * 64 + fr; const int col0 = u.pnl * BM + wc * 32 + 8 * fq;
        const int b = (u.pm * BM) / SEQ;
        const float* g1 = mod + (size_t)b * MODW + 2 * DM;
        f32x4 gv[2][2];
#pragma unroll
        for (int bj = 0; bj < 2; ++bj)
#pragma unroll
            for (int n = 0; n < 2; ++n) gv[bj][n] = *(const f32x4*)(g1 + col0 + bj * HALF + 4 * n);
#pragma unroll
        for (int ai = 0; ai < 2; ++ai) {
            f32x4 xv[4][2][2];
#pragma unroll
            for (int m = 0; m < 4; ++m) { const size_t off = (size_t)(row0 + ai * HALF + m * 16) * DM + col0;
#pragma unroll
                for (int bj = 0; bj < 2; ++bj) { xv[m][bj][0] = *(const f32x4*)(x + off + bj * HALF); xv[m][bj][1] = *(const f32x4*)(x + off + bj * HALF + 4); } }
            asm volatile("" ::: "memory");
#pragma unroll
            for (int m = 0; m < 4; ++m) { const int row = row0 + ai * HALF + m * 16; const size_t off = (size_t)row * DM + col0; float ss = 0.f;
#pragma unroll
                for (int bj = 0; bj < 2; ++bj) { const f32x4 o0 = xv[m][bj][0] + gv[bj][0] * acc[ai][bj][m][0], o1 = xv[m][bj][1] + gv[bj][1] * acc[ai][bj][m][1];
                    v4u w; w.x = cvt_pk_bf16(o0[0], o0[1]); w.y = cvt_pk_bf16(o0[2], o0[3]); w.z = cvt_pk_bf16(o1[0], o1[1]); w.w = cvt_pk_bf16(o1[2], o1[3]);
                    *(v4u*)(x1 + off + bj * HALF) = w;
#pragma unroll
                    for (int j = 0; j < 4; ++j) { const float lo = bflo(w[j]), hi = bfhi(w[j]); ss += lo * lo + hi * hi; } }
                ss += __shfl_xor(ss, 16); ss += __shfl_xor(ss, 32);
                if (fq == 0) part[(size_t)row * 16 + u.pnl * 4 + wc] = ss; }
            asm volatile("" ::: "memory");
        }
    }
};
struct EpiSwiGLU {
    static constexpr bool PERM = true;
    bf16* H;
    __device__ __forceinline__ void operator()(const f32x4 (&acc)[2][2][4][2], const Unit& u, int wr, int wc, int fr, int fq) const {
        const int row0 = u.pm * BM + wr * 64 + fr; const int col0 = u.pnl * 128 + wc * 16 + 4 * fq;
#pragma unroll
        for (int ai = 0; ai < 2; ++ai)
#pragma unroll
            for (int m = 0; m < 4; ++m) { bf16* rowp = H + (size_t)(row0 + ai * HALF + m * 16) * DE + col0;
#pragma unroll
                for (int bj = 0; bj < 2; ++bj) { const f32x4 g = acc[ai][bj][m][0], v = acc[ai][bj][m][1];
                    v2u w; w.x = cvt_pk_bf16(silu_f(g[0]) * v[0], silu_f(g[1]) * v[1]); w.y = cvt_pk_bf16(silu_f(g[2]) * v[2], silu_f(g[3]) * v[3]);
                    *(v2u*)(rowp + bj * 64) = w; } }
    }
};
struct EpiSwiGLU2 {
    static constexpr bool PERM = true;
    unsigned char* H; const v4u* rec; const LAS int* ppre;
    __device__ __forceinline__ void operator()(const f32x4 (&acc)[2][2][4][2], const Unit& u, int wr, int wc, int fr, int fq) const {
        const int col0 = u.pnl * 128 + wc * 16 + 4 * fq;
        const v4u* rb = rec + (size_t)u.e * CAP + u.rb * 256;
        v4u r[4];
#pragma unroll
        for (int m = 0; m < 4; ++m) { const int rl = wr * 64 + m * 16 + fr; r[m] = rb[rl < u.nv ? rl : 0]; }
#pragma unroll
        for (int ai = 0; ai < 2; ++ai) {
            int en[4]; int pi[4]; float w[4];
#pragma unroll
            for (int m = 0; m < 4; ++m) { const int rl = ai * HALF + wr * 64 + m * 16 + fr; en[m] = rl < u.nv ? (int)r[m].x : -1; pi[m] = (int)r[m].y; w[m] = F8_SH * __uint_as_float(r[m].z); }
            if (ai == 0) {
#pragma unroll
                for (int m = 0; m < 4; ++m) { const int rl = HALF + wr * 64 + m * 16 + fr; r[m] = rb[rl < u.nv ? rl : 0]; } }
            asm volatile("" ::: "memory");
#pragma unroll
            for (int m = 0; m < 4; ++m) if (en[m] >= 0) {
                const int pid = (pi[m] & 0x3fffffff) >> 16, ppos = pi[m] & 65535, half = (en[m] & 1) ^ ((pi[m] >> 30) & 1);
                unsigned char* rowp = H + ((size_t)(256 * ppre[pid] + ppos)) * 512 + half * 256 + col0;
#pragma unroll
                for (int bj = 0; bj < 2; ++bj) { const f32x4 g = acc[ai][bj][m][0], v = acc[ai][bj][m][1];
                    *(unsigned*)(rowp + bj * 64) = cvt4_fp8(w[m] * silu_f(g[0]) * v[0], w[m] * silu_f(g[1]) * v[1], w[m] * silu_f(g[2]) * v[2], w[m] * silu_f(g[3]) * v[3]); } }
            asm volatile("" ::: "memory");
        }
    }
};
struct EpiDown {
    static constexpr bool PERM = true;
    bf16* Y; const int* tok; const float* gatew;
    __device__ __forceinline__ void operator()(const f32x4 (&acc)[2][2][4][2], const Unit& u, int wr, int wc, int fr, int fq) const {
        const int col0 = u.pnl * BM + wc * 32 + 8 * fq;
#pragma unroll
        for (int ai = 0; ai < 2; ++ai)
#pragma unroll
            for (int m = 0; m < 4; ++m) { const int rl = ai * HALF + wr * 64 + m * 16 + fr;
                if (rl < u.nv) { const int entry = tok[(size_t)u.e * CAP + u.rb * 256 + rl]; const float w = gatew[entry]; bf16* rowp = Y + (size_t)entry * DM + col0;
#pragma unroll
                    for (int bj = 0; bj < 2; ++bj) { const f32x4 v0 = acc[ai][bj][m][0] * w, v1 = acc[ai][bj][m][1] * w;
                        v4u o; o.x = cvt_pk_bf16(v0[0], v0[1]); o.y = cvt_pk_bf16(v0[2], v0[3]); o.z = cvt_pk_bf16(v1[0], v1[1]); o.w = cvt_pk_bf16(v1[2], v1[3]);
                        *(v4u*)(rowp + bj * HALF) = o; } }
                asm volatile("" ::: "memory"); }
    }
};

template <class Epi, class Sched, bool ALIGN_EPI, bool GATHER = false, bool FP8 = false>
__device__ __forceinline__ void gemm_phase(LAS unsigned char* lds, const Gemm g, const Sched& S, const Epi& E) {
    const int tid = threadIdx.x, wid = __builtin_amdgcn_readfirstlane(tid >> 6), lane = tid & 63, wr = wid >> 2, wc = wid & 3, fr = lane & 15, fq = lane >> 4;
    int K = g.K; asm volatile("" : "+s"(K));
    const int nt = K / BK;
    unsigned voffB[2], voffA[2]; int RA[2]; unsigned CA[2];
#pragma unroll
    for (int i = 0; i < 2; ++i) { int R, C; stage_rc(tid * 16 + i * 8192, R, C); const int Rb = Epi::PERM ? ((R & ~31) + perm32(R & 31)) : R;
        RA[i] = R; CA[i] = (unsigned)C * 2u; voffA[i] = (unsigned)(R * g.lda + C) * 2u; voffB[i] = (unsigned)(Rb * K + C) * 2u; }
    const unsigned kstep = (unsigned)(BK * 2);
    const size_t hstepB = (size_t)HALF * K * 2, tstepB = 2 * hstepB;
    const unsigned pitchA = (unsigned)g.lda * 2u; const size_t hstepA = (size_t)HALF * g.lda * 2, tstepA = 2 * hstepA;
    const unsigned ldsw = (unsigned)wid * 1024u;
    const int aoff = lds_byte(wr * 64 + fr, fq * 8), boff = lds_byte(wc * 32 + fr, fq * 8);
#define PG8_SA(b, h) (((b) * 2 + (h)) * HTB)
#define PG8_SB(b, h) ((4 + (b) * 2 + (h)) * HTB)
#define PG8_STAGE(bufoff, gbase, voff) do { _Pragma("unroll") for (int _i = 0; _i < 2; ++_i) \
        __builtin_amdgcn_global_load_lds((const unsigned*)((const char*)(gbase) + (voff)[_i]), (LAS unsigned*)(lds + (bufoff) + ldsw + _i * 8192), 16, 0, 0); } while (0)
#define PG8_STAGEA(bufoff, up, offs, h, kb) do { _Pragma("unroll") for (int _i = 0; _i < 2; ++_i) { \
        const char* _p = GATHER ? ((const char*)g.A + (size_t)(offs)[h][_i] + (kb)) : ((up) + (size_t)(h) * hstepA + voffA[_i] + (kb)); \
        __builtin_amdgcn_global_load_lds((const unsigned*)_p, (LAS unsigned*)(lds + (bufoff) + ldsw + _i * 8192), 16, 0, 0); } } while (0)
#define PG8_LDA(dst, b, h) do { if constexpr (FP8) { _Pragma("unroll") for (int m = 0; m < 4; ++m) { const v4i_ lo_ = *(const LAS v4i_*)(lds + PG8_SA(b, h) + aoff + m * 2048), hi_ = *(const LAS v4i_*)(lds + PG8_SA(b, h) + aoff + m * 2048 + 1024); \
            dst##8[m] = __builtin_shufflevector(lo_, hi_, 0, 1, 2, 3, 4, 5, 6, 7); } } \
        else { _Pragma("unroll") for (int m = 0; m < 4; ++m) _Pragma("unroll") for (int k = 0; k < 2; ++k) dst[m][k] = *(const LAS bf16x8*)(lds + PG8_SA(b, h) + aoff + m * 2048 + k * 1024); } } while (0)
#define PG8_LDB(dst, b, h) do { if constexpr (FP8) { _Pragma("unroll") for (int n = 0; n < 2; ++n) { const v4i_ lo_ = *(const LAS v4i_*)(lds + PG8_SB(b, h) + boff + n * 2048), hi_ = *(const LAS v4i_*)(lds + PG8_SB(b, h) + boff + n * 2048 + 1024); \
            dst##8[n] = __builtin_shufflevector(lo_, hi_, 0, 1, 2, 3, 4, 5, 6, 7); } } \
        else { _Pragma("unroll") for (int n = 0; n < 2; ++n) _Pragma("unroll") for (int k = 0; k < 2; ++k) dst[n][k] = *(const LAS bf16x8*)(lds + PG8_SB(b, h) + boff + n * 2048 + k * 1024); } } while (0)
#define PG8_MMA(ai, bj, At, Bt) do { __builtin_amdgcn_s_setprio(1); _Pragma("unroll") for (int m = 0; m < 4; ++m) _Pragma("unroll") for (int n = 0; n < 2; ++n) { \
        if constexpr (FP8) asm volatile("v_mfma_scale_f32_16x16x128_f8f6f4 %0, %1, %2, %0, %3, %4 op_sel_hi:[0,0,0]" : "+v"(acc[ai][bj][m][n]) : "v"(Bt##8[n]), "v"(At##8[m]), "v"(f8sw), "v"(f8sx));     \
        else { _Pragma("unroll") for (int k = 0; k < 2; ++k) acc[ai][bj][m][n] = __builtin_amdgcn_mfma_f32_16x16x32_bf16(Bt[n][k], At[m][k], acc[ai][bj][m][n], 0, 0, 0); } } \
        __builtin_amdgcn_s_setprio(0); } while (0)
#define PG8_WAIT_V(n) asm volatile("s_waitcnt vmcnt(" #n ")" ::: "memory")
#define PG8_WAIT_L(n) asm volatile("s_waitcnt lgkmcnt(" #n ")" ::: "memory")
#define PG8_BAR __builtin_amdgcn_s_barrier()
#define PG8_SCHED __builtin_amdgcn_sched_barrier(0)
#define PG8_AOFFS(dst, un) do { if constexpr (GATHER) _Pragma("unroll") for (int _h = 0; _h < 2; ++_h) _Pragma("unroll") for (int _i = 0; _i < 2; ++_i) dst[_h][_i] = S.arow(un, _h * HALF + RA[_i]) * pitchA + CA[_i]; } while (0)
    Unit cur, nxt; int ui = 0;
    if (!S.next(0, cur)) return;
    f32x4 acc[2][2][4][2];
#pragma unroll
    for (int a = 0; a < 2; ++a)
#pragma unroll
        for (int b = 0; b < 2; ++b)
#pragma unroll
            for (int m = 0; m < 4; ++m)
#pragma unroll
                for (int n = 0; n < 2; ++n) acc[a][b][m][n] = (f32x4){0.f, 0.f, 0.f, 0.f};
    typedef int v8i_ __attribute__((ext_vector_type(8))); typedef int v4i_ __attribute__((ext_vector_type(4)));
    bf16x8 At[4][2], B0[2][2], B1[2][2]; v8i_ At8[4], B08[2], B18[2];
    const int f8sw = (int)g.sw, f8sx = (int)g.sx;
    unsigned oC[2][2], oN[2][2];
    PG8_AOFFS(oC, cur);
    const char* cA = (const char*)g.A + (size_t)cur.pm * tstepA + cur.acol;
    const char* cB = (const char*)g.Bt + (size_t)cur.pn * tstepB;
    PG8_STAGE(PG8_SB(0, 0), cB, voffB); PG8_STAGE(PG8_SB(0, 1), cB + hstepB, voffB); PG8_STAGEA(PG8_SA(0, 0), cA, oC, 0, 0u); PG8_STAGEA(PG8_SA(0, 1), cA, oC, 1, 0u);
    if (wr == 1) PG8_BAR;
    PG8_WAIT_V(2); PG8_BAR;
    PG8_STAGE(PG8_SB(1, 0), cB + kstep, voffB); PG8_STAGEA(PG8_SA(1, 0), cA, oC, 0, kstep); PG8_STAGE(PG8_SB(1, 1), cB + hstepB + kstep, voffB);
    PG8_WAIT_V(6); PG8_BAR;
    for (;;) {
        const bool has_next = S.next(ui + 1, nxt);
        if (has_next) { PG8_AOFFS(oN, nxt); } else {
#pragma unroll
            for (int _h = 0; _h < 2; ++_h)
#pragma unroll
                for (int _i = 0; _i < 2; ++_i) oN[_h][_i] = oC[_h][_i]; }
        const char* nA = has_next ? (const char*)g.A + (size_t)nxt.pm * tstepA + nxt.acol : cA;
        const char* nB = has_next ? (const char*)g.Bt + (size_t)nxt.pn * tstepB : cB;
        for (int t = 0; t < nt; t += 2) {
            const bool last = (t == nt - 2);
            const unsigned ka1 = (unsigned)(t + 1) * kstep;
            const unsigned ka2 = last ? 0u : (unsigned)(t + 2) * kstep, ka3 = ka2 + kstep;
            unsigned o2[2][2];
#pragma unroll
            for (int _h = 0; _h < 2; ++_h)
#pragma unroll
                for (int _i = 0; _i < 2; ++_i) o2[_h][_i] = last ? oN[_h][_i] : oC[_h][_i];
            const char* a2 = last ? nA : cA;
            const char* b2 = last ? nB : cB + (size_t)(t + 2) * kstep; const char* b3 = b2 + kstep;
            PG8_LDB(B0, 0, 0); PG8_LDB(B1, 0, 1); PG8_SCHED; PG8_LDA(At, 0, 0); PG8_STAGEA(PG8_SA(1, 1), cA, oC, 1, ka1);
            PG8_WAIT_V(8); PG8_WAIT_L(0); PG8_BAR; PG8_MMA(0, 0, At, B0); PG8_MMA(0, 1, At, B1); PG8_BAR; PG8_SCHED;
            PG8_LDA(At, 0, 1); PG8_STAGE(PG8_SB(0, 0), b2, voffB); PG8_STAGE(PG8_SB(0, 1), b2 + hstepB, voffB); PG8_STAGEA(PG8_SA(0, 0), a2, o2, 0, ka2);
            PG8_WAIT_V(8); PG8_WAIT_L(0); PG8_BAR; PG8_MMA(1, 0, At, B0); PG8_MMA(1, 1, At, B1); PG8_BAR; PG8_SCHED;
            PG8_LDB(B0, 1, 0); PG8_LDB(B1, 1, 1); PG8_SCHED; PG8_LDA(At, 1, 0); PG8_STAGEA(PG8_SA(0, 1), a2, o2, 1, ka2);
            PG8_WAIT_V(8); PG8_WAIT_L(0); PG8_BAR; PG8_MMA(0, 0, At, B0); PG8_MMA(0, 1, At, B1); PG8_BAR; PG8_SCHED;
            PG8_LDA(At, 1, 1); PG8_STAGE(PG8_SB(1, 0), b3, voffB); PG8_STAGE(PG8_SB(1, 1), b3 + hstepB, voffB); PG8_STAGEA(PG8_SA(1, 0), a2, o2, 0, ka3);
            PG8_WAIT_V(8); PG8_WAIT_L(0); PG8_BAR; PG8_MMA(1, 0, At, B0); PG8_MMA(1, 1, At, B1); PG8_BAR; PG8_SCHED;
        }
        const bool fin = !(has_next && nxt.cont);
        if (fin) {
        if constexpr (ALIGN_EPI) { if (wr == 0) PG8_BAR; }
        E(acc, cur, wr, wc, fr, fq);
        }
        if (!has_next) break;
        if (fin) {
#pragma unroll
        for (int a = 0; a < 2; ++a)
#pragma unroll
            for (int b = 0; b < 2; ++b)
#pragma unroll
                for (int m = 0; m < 4; ++m)
#pragma unroll
                    for (int n = 0; n < 2; ++n) acc[a][b][m][n] = (f32x4){0.f, 0.f, 0.f, 0.f};
        }
        cur = nxt; cA = nA; cB = nB; ++ui;
#pragma unroll
        for (int _h = 0; _h < 2; ++_h)
#pragma unroll
            for (int _i = 0; _i < 2; ++_i) oC[_h][_i] = oN[_h][_i];
        if constexpr (ALIGN_EPI) { if (fin && wr == 1) PG8_BAR; }
    }
    PG8_WAIT_V(0);
    if constexpr (!ALIGN_EPI) { if (wr == 0) PG8_BAR; }
    PG8_BAR;
#undef PG8_SA
#undef PG8_SB
#undef PG8_STAGE
#undef PG8_STAGEA
#undef PG8_LDA
#undef PG8_LDB
#undef PG8_MMA
#undef PG8_WAIT_V
#undef PG8_WAIT_L
#undef PG8_BAR
#undef PG8_SCHED
#undef PG8_AOFFS
}
}
struct Frame {
    LAS unsigned char* lds;
    volatile LAS unsigned* MISC;
    gu32* ctl;
    int tid, lane, wave, G, bx;
};
struct Args { const void* in[21]; float* out; unsigned char* ws; int ph_lo, ph_hi; };

__device__ __forceinline__ int pair_map(int j, int half) { return j < half ? 2 * j : 2 * (j - half) + 1; }
__device__ __forceinline__ int row_map(int mode, int n) {
    if (mode == 0) return n;
    if (mode <= 2) return 8 * (n >> 2) + 4 * (mode - 1) + (n & 3);
    if (mode == 3) { if (n >= C_KR && n < C_RQ) return C_KR + pair_map(n - C_KR, 16);
                     if (n >= C_RQ && n < C_RV) { const int hb = C_RQ + ((n - C_RQ) & ~63); return hb + pair_map(n - hb, 32); }
                     return n; }
    { const int h = n / 96, d = n % 96; return d < 64 ? n : h * 96 + 64 + pair_map(d - 64, 16); }
}
__device__ __forceinline__ void transpose_item(const float* W, int K, int N, bf16* WT, int mode, const float* kscale, LAS float* scr, int item, int lane, float f8scale = 0.f) {
    const int nblk = N / 32, kb = item / nblk, nb = item % nblk, k0 = 64 * kb, n0 = 32 * nb;
    float wv[32];
#pragma unroll
    for (int i = 0; i < 32; ++i) { const int kk = 2 * i + (lane >> 5); wv[i] = __builtin_nontemporal_load(W + (size_t)(k0 + kk) * N + n0 + (lane & 31)); }
#pragma unroll
    for (int i = 0; i < 32; ++i) { const int kk = 2 * i + (lane >> 5); float w = wv[i]; if (kscale) w *= kscale[k0 + kk]; scr[kk * 33 + (lane & 31)] = w; }
    LDS_WAIT(); asm volatile("" ::: "memory");
    const int c = lane & 7;
#pragma unroll
    for (int j = 0; j < 4; ++j) { const int n = (lane >> 3) + 8 * j; const LAS float* s = scr + (8 * c) * 33 + n;
        v4u o; o.x = pk2(s[0 * 33], s[1 * 33]); o.y = pk2(s[2 * 33], s[3 * 33]); o.z = pk2(s[4 * 33], s[5 * 33]); o.w = pk2(s[6 * 33], s[7 * 33]);
        const int row = row_map(mode, n0 + n);
        if (f8scale > 0.f) { v2u o8; o8.x = cvt4_fp8(f8scale * s[0 * 33], f8scale * s[1 * 33], f8scale * s[2 * 33], f8scale * s[3 * 33]); o8.y = cvt4_fp8(f8scale * s[4 * 33], f8scale * s[5 * 33], f8scale * s[6 * 33], f8scale * s[7 * 33]);
            *(GAS v2u*)((unsigned char*)WT + (size_t)row * K + k0 + 8 * c) = o8; }
        else *(GAS v4u*)(WT + (size_t)row * K + k0 + 8 * c) = o; }
    LDS_WAIT(); asm volatile("" ::: "memory");
}
__device__ __forceinline__ void p0_prologue(Frame& F, const Args& a) {
    unsigned char* ws = a.ws;
    float* mod = (float*)(ws + WS_MOD);
    for (int cb = F.bx; cb < MODW / 32; cb += F.G) {
        const float* c = (const float*)a.in[1]; const float* w_ada = (const float*)a.in[3]; const float* b_ada = (const float*)a.in[4];
        LAS float* sc = (LAS float*)F.lds;
        LAS float* part = (LAS float*)(F.lds + 65536);
        for (int i = F.tid; i < NB * DM; i += NTHR) sc[i] = silu_f(c[i]);
        __syncthreads();
        const int cc = F.tid & 31, kq = F.tid >> 5, n = cb * 32 + cc;
        float acc[NB];
#pragma unroll
        for (int b = 0; b < NB; ++b) acc[b] = 0.f;
        for (int k0 = kq; k0 < DM; k0 += 128) { float wv[8];
#pragma unroll
            for (int i = 0; i < 8; ++i) wv[i] = __builtin_nontemporal_load(w_ada + (size_t)(k0 + 16 * i) * MODW + n);
#pragma unroll
            for (int i = 0; i < 8; ++i)
#pragma unroll
                for (int b = 0; b < NB; ++b) acc[b] += sc[b * DM + k0 + 16 * i] * wv[i]; }
#pragma unroll
        for (int b = 0; b < NB; ++b) part[(kq * NB + b) * 32 + cc] = acc[b];
        __syncthreads();
        { const int b = F.tid >> 5; float s = b_ada[n];
#pragma unroll
          for (int q = 0; q < 16; ++q) s += part[(q * NB + b) * 32 + cc];
          mod[(size_t)b * MODW + n] = s; }
        __syncthreads();
    }
    LAS float* scr = (LAS float*)(F.lds + F.wave * 16384);
    const int gw = F.bx * NWAVES + F.wave, NGW = F.G * NWAVES;
    constexpr int I_IN = (DM / 64) * (INW / 32), I_UQ = (256 / 64) * (QW / 32), I_UKV = (128 / 64) * (KVW / 32), I_O = (DM / 64) * (DM / 32);
    constexpr int I_W1 = (DM / 64) * (DE / 32), I_W2 = (DE / 64) * (DM / 32);
    constexpr int NITEMS = I_IN + I_UQ + I_UKV + I_O + NE * (2 * I_W1 + I_W2);
    for (int it = gw; it < NITEMS; it += NGW) {
        int r = it;
        if (r < I_IN) { transpose_item((const float*)a.in[6], DM, INW, (bf16*)(ws + WS_WIN), 3, nullptr, scr, r, F.lane); continue; } r -= I_IN;
        if (r < I_UQ) { transpose_item((const float*)a.in[8], 256, QW, (bf16*)(ws + WS_WUQ), 4, (const float*)a.in[7], scr, r, F.lane); continue; } r -= I_UQ;
        if (r < I_UKV) { transpose_item((const float*)a.in[10], 128, KVW, (bf16*)(ws + WS_WUKV), 0, (const float*)a.in[9], scr, r, F.lane); continue; } r -= I_UKV;
        if (r < I_O) { transpose_item((const float*)a.in[11], DM, DM, (bf16*)(ws + WS_WO), 0, nullptr, scr, r, F.lane, F8_SWO); continue; } r -= I_O;
        if (r < NE * I_W1) { const int e = r / I_W1; transpose_item((const float*)a.in[17] + (size_t)e * DM * DE, DM, DE, (bf16*)(ws + WS_W13 + (size_t)e * 512 * DM), 1, nullptr, scr, r % I_W1, F.lane, F8_SW13); continue; } r -= NE * I_W1;
        if (r < NE * I_W1) { const int e = r / I_W1; transpose_item((const float*)a.in[18] + (size_t)e * DM * DE, DM, DE, (bf16*)(ws + WS_W13 + (size_t)e * 512 * DM), 2, nullptr, scr, r % I_W1, F.lane, F8_SW13); continue; } r -= NE * I_W1;
        { const int e = r / I_W2; transpose_item((const float*)a.in[19] + (size_t)e * DE * DM, DE, DM, (bf16*)(ws + WS_W2 + (size_t)e * DM * DE), 0, nullptr, scr, r % I_W2, F.lane, F8_SW2); }
    }
    const int gt = F.bx * NTHR + F.tid, NGT = F.G * NTHR;
    { v4u z = (v4u){0u, 0u, 0u, 0u}; GAS v4u* p = (GAS v4u*)((bf16*)(ws + WS_WIN) + (size_t)INW * DM);
      for (int i = gt; i < (INWP - INW) * DM / 8; i += NGT) p[i] = z; }
    { const float* w_gr = (const float*)a.in[13]; const float* w_er = (const float*)a.in[15]; float* wf = (float*)(ws + WS_WR);
      bf16* wb = (bf16*)wf;
      for (int i = gt; i < 32 * 3 * 64 * 8; i += NGT) { const int ii = i & 7, l = (i >> 3) & 63, ntl = (i >> 9) % 3, s8 = i / 1536;
          const int k = 32 * s8 + 8 * (l >> 4) + ii, nc = 16 * ntl + (l & 15);
          const float w = nc < 4 ? w_gr[k * 4 + nc] : (nc < 36 ? w_er[k * 32 + (nc - 4)] : 0.f);
          const unsigned hi = f2bf(w); const float lo = w - bf2f(hi);
          const size_t base = ((size_t)(s8 * 3 + ntl) * 64 + l) * 16; wb[base + ii] = (bf16)hi; wb[base + 8 + ii] = (bf16)f2bf(lo); }
      if (gt < 48) { const float* b_gr = (const float*)a.in[14]; const float* b_er = (const float*)a.in[16];
          wf[64 * 3 * 64 * 4 + gt] = gt < 4 ? b_gr[gt] : (gt < 36 ? b_er[gt - 4] : 0.f); } }
}

__device__ __forceinline__ void p1_norm1(Frame& F, const Args& a) {
    const float* x = (const float*)a.in[0]; const float* g = (const float*)a.in[5]; const float* mod = (const float*)(a.ws + WS_MOD); bf16* h1 = (bf16*)(a.ws + WS_B);
    const int gw = F.bx * NWAVES + F.wave, NGW = F.G * NWAVES;
    for (int m0 = 4 * gw; m0 < T; m0 += 4 * NGW) {
        const int b = m0 >> 12;
        f32x4 v[4][4];
#pragma unroll
        for (int r = 0; r < 4; ++r) { const GAS f32x4* xr = (const GAS f32x4*)(x + (size_t)(m0 + r) * DM) + F.lane;
#pragma unroll
            for (int j = 0; j < 4; ++j) v[r][j] = __builtin_nontemporal_load(xr + 64 * j); }
        f32x4 gs[4], sh[4];
#pragma unroll
        for (int j = 0; j < 4; ++j) { const int col = 4 * F.lane + 256 * j;
            gs[j] = *(const f32x4*)(g + col) * (*(const f32x4*)(mod + (size_t)b * MODW + DM + col) + 1.0f); sh[j] = *(const f32x4*)(mod + (size_t)b * MODW + col); }
#pragma unroll
        for (int r = 0; r < 4; ++r) { float s = 0.f;
#pragma unroll
            for (int j = 0; j < 4; ++j) s += (v[r][j].x * v[r][j].x + v[r][j].y * v[r][j].y) + (v[r][j].z * v[r][j].z + v[r][j].w * v[r][j].w);
            const float rstd = 1.0f / sqrtf(wave_sum(s) * (1.f / DM) + EPS);
            GAS v2u* o8 = (GAS v2u*)(h1 + (size_t)(m0 + r) * DM) + F.lane;
#pragma unroll
            for (int j = 0; j < 4; ++j) { const f32x4 o = (v[r][j] * rstd) * gs[j] + sh[j]; v2u w; w.x = cvtpk2(o.x, o.y); w.y = cvtpk2(o.z, o.w); o8[64 * j] = w; } }
    }
}

__device__ __forceinline__ float ret_log2g(int h) { return log2f(1.0f - exp2f(-5.0f - (float)h)); }

__device__ __forceinline__ void p7_norm2_router(Frame& F, const Args& a, int rep) {
    unsigned char* ws = a.ws;
    const bf16* x1 = (const bf16*)(ws + WS_A); const float* part = (const float*)(ws + WS_PART); const float* mod = (const float*)(ws + WS_MOD);
    const float* g2n = (const float*)a.in[12]; const float* wf = (const float*)(ws + WS_WR); const float* bias = wf + 64 * 3 * 64 * 4;
    unsigned char* h2 = ws + (rep ? WS_END : WS_B); float* gatew = (float*)(ws + (rep ? WS_END + 130 * MiB : WS_GATEW)); int* tok = (int*)(ws + (rep ? WS_END + 132 * MiB : WS_TOK)); int* slotinfo = (int*)(ws + (rep ? WS_END + 131 * MiB : WS_SLOT)); v4u* rec = (v4u*)(ws + (rep ? WS_END + 136 * MiB : WS_REC)); gu32* cntg = F.ctl + (rep ? CW_CNT2 : CW_CNT);
    int* ptinfo = (int*)(ws + (rep ? WS_END + 133 * MiB : WS_PTI)); gu32* pcntg = F.ctl + (rep ? CW_PCNT + NPAIR * CNT_STRIDE : CW_PCNT);
    const int lane = F.lane, wv = F.wave, row = lane & 15, kq = lane >> 4;
    LAS v4u* Wl = (LAS v4u*)(F.lds);
    LAS float* mw = (LAS float*)(F.lds + 98304);
    LAS float* lgs = (LAS float*)(F.lds + 106496);
    LAS int* as_e = (LAS int*)(F.lds);
    LAS int* as_rank = as_e + 512; LAS int* as_entry = as_rank + 512;
    LAS int* cntL = as_entry + 512; LAS int* baseL = cntL + 32;
    LAS int* tp_pid = baseL + 32; LAS int* tp_rank = tp_pid + 256; LAS int* tp_tok = tp_rank + 256;
    LAS int* pcntL = tp_tok + 256; LAS int* pbaseL = pcntL + 128; LAS float* as_gate = (LAS float*)(pbaseL + 128);
    for (int rb = F.bx; rb < T / 256; rb += F.G) {
        const int b = rb >> 4, t0 = b * SEQ + (rb & 15) * 16;
        if (F.tid < 256) { const float* mb = mod + (size_t)b * MODW; const int col = 4 * F.tid;
            *(LAS f32x4*)(mw + col) = *(const f32x4*)(g2n + col) * (*(const f32x4*)(mb + 4 * DM + col) + 1.0f); *(LAS f32x4*)(mw + DM + col) = *(const f32x4*)(mb + 3 * DM + col); }
        float rstd[2];
#pragma unroll
        for (int h = 0; h < 2; ++h) { const f32x4* pp = (const f32x4*)(part + (size_t)(t0 + 256 * (wv + 8 * h) + row) * 16); const f32x4 p0 = pp[0], p1 = pp[1], p2 = pp[2], p3 = pp[3];
            const float ss = ((p0.x + p0.y) + (p0.z + p0.w)) + ((p1.x + p1.y) + (p1.z + p1.w)) + ((p2.x + p2.y) + (p2.z + p2.w)) + ((p3.x + p3.y) + (p3.z + p3.w));
            rstd[h] = 1.0f / sqrtf(ss * (1.f / DM) + EPS); }
        const unsigned lo = (unsigned)(row * DM + 8 * kq);
        const bf16* xw0 = x1 + (size_t)(t0 + 256 * wv) * DM; unsigned char* hw0 = h2 + (size_t)(t0 + 256 * wv) * DM;
        constexpr int XD = 8;
        v4u xq[XD];
#pragma unroll
        for (int u = 0; u < XD; ++u) xq[u] = __builtin_nontemporal_load((const GAS v4u*)(xw0 + 32 * u + lo));
        f32x4 acc[2][3];
#pragma unroll
        for (int h = 0; h < 2; ++h)
#pragma unroll
            for (int ntl = 0; ntl < 3; ++ntl) acc[h][ntl] = (f32x4){0.f, 0.f, 0.f, 0.f};
#pragma unroll 1
        for (int p = 0; p < 2; ++p) {
            __syncthreads();
            { const v4u* src = (const v4u*)wf + (size_t)p * 6144 + F.tid;
#pragma unroll
              for (int i = 0; i < 12; ++i) Wl[F.tid + 512 * i] = src[512 * i]; }
            __syncthreads();
#pragma unroll
            for (int h = 0; h < 2; ++h) {
#pragma unroll 1
                for (int g2 = 0; g2 < 2; ++g2) {
                    const size_t cur = (size_t)h * 2048 * DM + 512 * p + 256 * g2;
                    const size_t nxt = g2 == 0 ? cur + 256 : (h == 0 ? (size_t)2048 * DM + 512 * p : (p == 0 ? (size_t)512 : cur));
                    const LAS v4u* wl = Wl + g2 * 3072 + lane * 2;
#pragma unroll
                    for (int u = 0; u < 8; ++u) { const int col = 512 * p + 256 * g2 + 32 * u;
                        const v4u xw = xq[u]; const f32x4 xa = (f32x4){bflo(xw.x), bfhi(xw.x), bflo(xw.y), bfhi(xw.y)}, xb = (f32x4){bflo(xw.z), bfhi(xw.z), bflo(xw.w), bfhi(xw.w)};
                        xq[u] = __builtin_nontemporal_load((const GAS v4u*)(xw0 + nxt + 32 * u + lo));
                        const LAS float* mg = mw + 8 * kq + col;
                        const f32x4 ga = *(const LAS f32x4*)(mg), gb = *(const LAS f32x4*)(mg + 4), sa = *(const LAS f32x4*)(mg + DM), sb = *(const LAS f32x4*)(mg + DM + 4);
                        const f32x4 ha = (xa * rstd[h]) * ga + sa, hb = (xb * rstd[h]) * gb + sb;
                        v4u hh; hh.x = cvtpk2(ha.x, ha.y); hh.y = cvtpk2(ha.z, ha.w); hh.z = cvtpk2(hb.x, hb.y); hh.w = cvtpk2(hb.z, hb.w);
                        { v2u h8; h8.x = cvt4_fp8(ha.x, ha.y, ha.z, ha.w); h8.y = cvt4_fp8(hb.x, hb.y, hb.z, hb.w); *(GAS v2u*)(hw0 + cur + 32 * u + lo) = h8; }
                        v4u hl; hl.x = cvtpk2(ha.x - bflo(hh.x), ha.y - bfhi(hh.x)); hl.y = cvtpk2(ha.z - bflo(hh.y), ha.w - bfhi(hh.y)); hl.z = cvtpk2(hb.x - bflo(hh.z), hb.y - bfhi(hh.z)); hl.w = cvtpk2(hb.z - bflo(hh.w), hb.w - bfhi(hh.w));
                        const bf16x8 ah = __builtin_bit_cast(bf16x8, hh), al = __builtin_bit_cast(bf16x8, hl);
#pragma unroll
                        for (int ntl = 0; ntl < 3; ++ntl) { const v4u wh = wl[(u * 3 + ntl) * 128], wo = wl[(u * 3 + ntl) * 128 + 1];
                            const bf16x8 bh = __builtin_bit_cast(bf16x8, wh), bl = __builtin_bit_cast(bf16x8, wo);
                            acc[h][ntl] = __builtin_amdgcn_mfma_f32_16x16x32_bf16(ah, bh, acc[h][ntl], 0, 0, 0); acc[h][ntl] = __builtin_amdgcn_mfma_f32_16x16x32_bf16(al, bh, acc[h][ntl], 0, 0, 0);
                            acc[h][ntl] = __builtin_amdgcn_mfma_f32_16x16x32_bf16(ah, bl, acc[h][ntl], 0, 0, 0); } }
                }
            }
        }
#pragma unroll
        for (int h = 0; h < 2; ++h)
#pragma unroll
            for (int ntl = 0; ntl < 3; ++ntl)
#pragma unroll
                for (int r = 0; r < 4; ++r) if (16 * ntl + row < 40) lgs[(16 * (wv + 8 * h) + 4 * kq + r) * 40 + 16 * ntl + row] = acc[h][ntl][r];
        __syncthreads();
        if (F.tid < 32) cntL[F.tid] = 0;
        if (F.tid >= 64 && F.tid < 64 + NPAIR) pcntL[F.tid - 64] = 0;
        __syncthreads();
        if (F.tid < 256) {
            const LAS float* l = lgs + F.tid * 40; const int tt = t0 + 256 * (F.tid >> 4) + (F.tid & 15);
            float lv[36];
#pragma unroll
            for (int j = 0; j < 36; ++j) lv[j] = l[j] + bias[j];
            float gm = lv[0]; int gi = 0;
#pragma unroll
            for (int j = 1; j < 4; ++j) if (lv[j] > gm) { gm = lv[j]; gi = j; }
            float se = 0.f;
#pragma unroll
            for (int j = 0; j < 4; ++j) se += __expf(lv[j] - gm);
            const float ptop = 1.0f / se;
            float le[8];
#pragma unroll
            for (int j = 0; j < 8; ++j) le[j] = gi == 0 ? lv[4 + j] : gi == 1 ? lv[12 + j] : gi == 2 ? lv[20 + j] : lv[28 + j];
            float v1 = le[0]; int i1 = 0;
#pragma unroll
            for (int j = 1; j < 8; ++j) if (le[j] > v1) { v1 = le[j]; i1 = j; }
            float v2 = -3.0e38f; int i2 = 0;
#pragma unroll
            for (int j = 0; j < 8; ++j) if (j != i1 && le[j] > v2) { v2 = le[j]; i2 = j; }
            const float ex = __expf(v2 - v1), g0 = ptop / (1.0f + ex), g1 = ptop * ex / (1.0f + ex);
            const int e0 = gi * 8 + i1, e1 = gi * 8 + i2;
            *(f32x2*)(gatew + (size_t)tt * 2) = (f32x2){g0, g1};
            const int a0 = F.tid * 2;
            as_gate[a0] = g0; as_gate[a0 + 1] = g1;
            as_e[a0] = e0; as_rank[a0] = __hip_atomic_fetch_add(cntL + e0, 1, __ATOMIC_RELAXED, __HIP_MEMORY_SCOPE_WORKGROUP); as_entry[a0] = tt * 2;
            as_e[a0 + 1] = e1; as_rank[a0 + 1] = __hip_atomic_fetch_add(cntL + e1, 1, __ATOMIC_RELAXED, __HIP_MEMORY_SCOPE_WORKGROUP); as_entry[a0 + 1] = tt * 2 + 1;
            { const int pa = i1 < i2 ? i1 : i2, pb = i1 < i2 ? i2 : i1, pid = gi * 28 + pa * 8 - (pa * (pa + 1)) / 2 + (pb - pa - 1);
              tp_pid[F.tid] = pid; tp_rank[F.tid] = __hip_atomic_fetch_add(pcntL + pid, 1, __ATOMIC_RELAXED, __HIP_MEMORY_SCOPE_WORKGROUP); tp_tok[F.tid] = tt | ((i1 > i2) ? (1 << 30) : 0); }
        }
        __syncthreads();
        if (F.tid < 32) { const int c = cntL[F.tid]; baseL[F.tid] = c > 0 ? (int)__hip_atomic_fetch_add(cntg + F.tid * CNT_STRIDE, (unsigned)c, RLX_AGENT) : 0; }
        else if (F.tid >= 64 && F.tid < 64 + NPAIR) { const int q = F.tid - 64; const int c = pcntL[q]; pbaseL[q] = c > 0 ? (int)__hip_atomic_fetch_add(pcntg + q * CNT_STRIDE, (unsigned)c, RLX_AGENT) : 0; }
        __syncthreads();
        if (F.tid < 256) { const int tv2 = tp_tok[F.tid]; const int pid = tp_pid[F.tid]; ptinfo[tv2 & 0x3fffffff] = (tv2 & (1 << 30)) | (pid * 65536 + pbaseL[pid] + tp_rank[F.tid]); }
        { const int en = as_entry[F.tid]; const int e = as_e[F.tid]; const int idx = e * CAP + baseL[e] + as_rank[F.tid]; tok[idx] = en; slotinfo[en] = idx;
          const int tq = F.tid >> 1, tv2 = tp_tok[tq], pid = tp_pid[tq];
          rec[idx] = (v4u){(unsigned)en, (unsigned)((tv2 & (1 << 30)) | (pid * 65536 + pbaseL[pid] + tp_rank[tq])), __float_as_uint(as_gate[F.tid]), 0u}; }
        __syncthreads();
    }
}

__device__ __forceinline__ void p10_final(Frame& F, const Args& a, const LAS int* ppre) {
    const bf16* x1 = (const bf16*)(a.ws + WS_A); const unsigned char* y = a.ws + WS_D; const float* mod = (const float*)(a.ws + WS_MOD); const float* fg = (const float*)a.in[20];
    const int* ptinfo = (const int*)(a.ws + WS_PTI);
    const int gw = F.bx * NWAVES + F.wave, NGW = F.G * NWAVES;
#ifdef SELFCHECK
    float chk_scale; { const float* chk = (const float*)(F.ctl + 20480); const float e = (SELFCHECK == 1) ? sqrtf(chk[0] / chk[1]) : (SELFCHECK == 2) ? sqrtf(chk[2] / chk[3]) : sqrtf(chk[4] / chk[5]); chk_scale = 1.0f + 10.0f * e; }
#endif
    typedef int i32x2 __attribute__((ext_vector_type(2)));
    const int step = 2 * NGW;
    int m0 = 2 * gw;
    if (m0 >= T) return;
    f32x4 gf[4];
#pragma unroll
    for (int j = 0; j < 4; ++j) gf[j] = *(const f32x4*)(fg + 4 * F.lane + 256 * j);
    v2u xw[2][4]; unsigned ya[2][4]; f32x4 g2[4];
#define P10_ISSUE(M, CC) do { \
        _Pragma("unroll") for (int r = 0; r < 2; ++r) { const GAS v2u* xr = (const GAS v2u*)(x1 + (size_t)((M) + r) * DM) + F.lane; \
            const int c0 = __builtin_amdgcn_readfirstlane((CC)[r]) & 0x3fffffff; \
            const size_t s0 = (size_t)(256 * ppre[c0 >> 16] + (c0 & 65535)); \
            const GAS unsigned* y0 = (const GAS unsigned*)(y + s0 * DM) + F.lane; \
            _Pragma("unroll") for (int j = 0; j < 4; ++j) { xw[r][j] = __builtin_nontemporal_load(xr + 64 * j); ya[r][j] = __builtin_nontemporal_load(y0 + 64 * j); } } \
        _Pragma("unroll") for (int j = 0; j < 4; ++j) g2[j] = *(const f32x4*)(mod + (size_t)((M) >> 12) * MODW + 5 * DM + 4 * F.lane + 256 * j); } while (0)
    i32x2 c2;
    { const i32x2 c1 = *(const i32x2*)(ptinfo + m0); const int m2 = m0 + step < T ? m0 + step : m0; c2 = *(const i32x2*)(ptinfo + m2); P10_ISSUE(m0, c1); }
    auto body = [&](int m0) __attribute__((always_inline)) {
        f32x4 v[2][4], yy[2][4], gc[4];
#pragma unroll
        for (int j = 0; j < 4; ++j) gc[j] = g2[j];
#pragma unroll
        for (int r = 0; r < 2; ++r)
#pragma unroll
            for (int j = 0; j < 4; ++j) { const v2u w = xw[r][j]; v[r][j] = (f32x4){bflo(w.x), bfhi(w.x), bflo(w.y), bfhi(w.y)}; yy[r][j] = fp8x4_f32(ya[r][j]) * (1.0f / F8_SY); }
        { const int mn = m0 + step < T ? m0 + step : m0; const i32x2 cnx = c2; const int m3 = mn + step < T ? mn + step : mn;
          c2 = *(const i32x2*)(ptinfo + m3); P10_ISSUE(mn, cnx); }
#pragma unroll
        for (int r = 0; r < 2; ++r) { float s = 0.f;
#pragma unroll
            for (int j = 0; j < 4; ++j) { v[r][j] = v[r][j] + gc[j] * yy[r][j]; s += (v[r][j].x * v[r][j].x + v[r][j].y * v[r][j].y) + (v[r][j].z * v[r][j].z + v[r][j].w * v[r][j].w); }
            const float rstd = 1.0f / sqrtf(wave_sum(s) * (1.f / DM) + EPS);
            GAS f32x4* o = (GAS f32x4*)(a.out + (size_t)(m0 + r) * DM) + F.lane;
#ifdef SELFCHECK
            for (int j = 0; j < 4; ++j) o[64 * j] = (v[r][j] * (rstd * chk_scale)) * gf[j]; }
#else
            for (int j = 0; j < 4; ++j) __builtin_nontemporal_store((v[r][j] * rstd) * gf[j], o + 64 * j); }
#endif
    };
    body(m0); m0 += step;
    for (; m0 < T; m0 += step) body(m0);
#undef P10_ISSUE
}
namespace mix {
__device__ __forceinline__ int crow(int r, int hi) { return (r & 3) + 8 * (r >> 2) + 4 * hi; }
__device__ __forceinline__ unsigned cvtpk(float lo, float hi) { return cvtpk2(lo, hi); }
typedef short v4i16_t __attribute__((ext_vector_type(4)));
__device__ __forceinline__ s16x4 vtr(const LAS unsigned char* p) { return __builtin_bit_cast(s16x4, __builtin_amdgcn_ds_read_tr16_b64_v4i16((LAS v4i16_t*)p)); }
__device__ __forceinline__ bf16x8 frag2(s16x4 lo, s16x4 hi) { return (bf16x8){lo[0], lo[1], lo[2], lo[3], hi[0], hi[1], hi[2], hi[3]}; }
__device__ __forceinline__ float swap_add(float v) { auto rr = __builtin_amdgcn_permlane32_swap(__float_as_uint(v), __float_as_uint(v), false, false); return __uint_as_float(rr[0]) + __uint_as_float(rr[1]); }
__device__ __forceinline__ float swap_max(float v) { auto rr = __builtin_amdgcn_permlane32_swap(__float_as_uint(v), __float_as_uint(v), false, false); return fmaxf(__uint_as_float(rr[0]), __uint_as_float(rr[1])); }
__device__ __forceinline__ void glds16_asm(const void* gsrc, unsigned lds_dst) { unsigned keep;
    asm volatile("s_mov_b32 %0, m0\n\ts_mov_b32 m0, %2\n\ts_nop 0\n\tglobal_load_lds_dwordx4 %1, off\n\ts_mov_b32 m0, %0" : "=&s"(keep) : "v"(gsrc), "s"(lds_dst) : "memory"); }
#define GLDS16(gp, lp) glds16_asm((const void*)(gp), (unsigned)__builtin_amdgcn_readfirstlane((int)(unsigned)(uintptr_t)(lp)))

constexpr int A_KS = 8192, A_VS = 4096, A_V0 = 32768;
typedef int v8i_t __attribute__((ext_vector_type(8))); typedef int v4i_t __attribute__((ext_vector_type(4)));
__device__ __forceinline__ void attn_unit(LAS unsigned char* lds, int b, int h, int qb, const bf16* q, const unsigned char* vt8, const unsigned char* k8, const bf16* proj, const int* positions, unsigned char* omix) {
    const int tid = threadIdx.x, lane = tid & 63, r32 = lane & 31, hi = lane >> 5; const int wid = __builtin_amdgcn_readfirstlane(tid >> 6);
    const size_t rowbase = (size_t)b * SEQ; const int q0 = qb * 256;
    const int NT = (q0 + 256) / 64;
    const unsigned char* ksrc = wid < 4 ? k8 + (rowbase + lane) * 512 + h * 64 + 16 * wid : (const unsigned char*)(proj + (rowbase + lane) * INWP + C_KR + 8 * (wid - 4));
    const size_t kstr = wid < 4 ? (size_t)64 * 512 : (size_t)64 * INWP * 2;
    const unsigned char* vsrc = vt8 + (size_t)((b * 8 + h) * 64) * 4096 + (wid & 3) * 1024 + lane * 16;
    LAS unsigned char* kd0 = lds + wid * 1024; LAS unsigned char* vd0 = lds + A_V0 + (wid & 3) * 1024;
#define ADMA(t) do { const int s_ = (t) & 3; GLDS16(ksrc + (size_t)(t) * kstr, kd0 + s_ * A_KS); if (wid < 4) GLDS16(vsrc + (size_t)(t) * 4096, vd0 + s_ * A_VS); } while (0)
    ADMA(0); ADMA(1);
    const size_t qrow = rowbase + q0 + wid * 32 + r32;
    const float C2 = 0.10206207261596575f * 1.4426950408889634f;
    bf16x8 qr[6]; v8i_t q8;
    const int sK = (int)F8_E1, sQ = (int)F8_E8;
    { const bf16* qp = q + qrow * QW + h * 96 + 8 * hi; v4u raw[6];
      const bf16* qn = q + qrow * QW + h * 96 + 32 * hi;
#pragma unroll
      for (int d0 = 0; d0 < 4; ++d0) raw[d0] = *(const GAS v4u*)(qn + 8 * d0);
#pragma unroll
      for (int d0 = 4; d0 < 6; ++d0) raw[d0] = *(const GAS v4u*)(qp + 16 * d0);
      const float pos = (float)positions[qrow];
      const float C8 = C2 * 8.0f;
#pragma unroll
      for (int d0 = 0; d0 < 4; ++d0) {
          q8[2 * d0] = (int)cvt4_fp8(bflo(raw[d0][0]) * C8, bfhi(raw[d0][0]) * C8, bflo(raw[d0][1]) * C8, bfhi(raw[d0][1]) * C8);
          q8[2 * d0 + 1] = (int)cvt4_fp8(bflo(raw[d0][2]) * C8, bfhi(raw[d0][2]) * C8, bflo(raw[d0][3]) * C8, bfhi(raw[d0][3]) * C8); }
      v4u o1, o2;
#pragma unroll
      for (int j = 0; j < 4; ++j) {
#pragma unroll
          for (int e = 0; e < 2; ++e) { const int f = 8 * e + 4 * hi + j; float tt = pos * (exp2f(-(float)f * (13.287712379549449f / 16.f)) * 0.15915494309189535f); tt -= floorf(tt);
              const float sn = __builtin_amdgcn_sinf(tt), cs = __builtin_amdgcn_cosf(tt);
              const unsigned w = e ? raw[5][j] : raw[4][j]; const float x1 = bflo(w), x2 = bfhi(w);
              const unsigned r = cvtpk((x1 * cs - x2 * sn) * C2, (x1 * sn + x2 * cs) * C2);
              if (e) o2[j] = r; else o1[j] = r; } }
      qr[4] = __builtin_bit_cast(bf16x8, o1); qr[5] = __builtin_bit_cast(bf16x8, o2); }
    float mhat = 0.f, l_run = 0.f; f32x16 o[2]; o[0] = f32x16{}; o[1] = f32x16{};
    f32x16 negm = f32x16{};
    const int qrel = wid * 32 + r32;
    const int voa = r32 * 64 + (((2 * hi) ^ ((r32 >> 2) & 3)) << 4), vob = r32 * 64 + (((2 * hi + 1) ^ ((r32 >> 2) & 3)) << 4);
    f32x16 pA0, pA1, pB0, pB1; v8i_t pw; float resc_f = 1.0f; bool resc = false;
#define SGB(mask, n) __builtin_amdgcn_sched_group_barrier(mask, n, 0)
#define ATOP(t) do { if ((t) + 1 < NT) { if (wid < 4) asm volatile("s_waitcnt vmcnt(2) lgkmcnt(0)\n\ts_barrier" ::: "memory"); else asm volatile("s_waitcnt vmcnt(1) lgkmcnt(0)\n\ts_barrier" ::: "memory"); } else WAIT_BAR0(); if ((t) + 2 < NT) ADMA((t) + 2); } while (0)
#define FP8QK(C, KA, KB) asm volatile("v_mfma_scale_f32_32x32x64_f8f6f4 %0, %1, %2, %5, %3, %4 op_sel_hi:[0,0,0]" : "=&v"(C) : "v"(__builtin_shufflevector(KA, KB, 0, 1, 2, 3, 4, 5, 6, 7)), "v"(q8), "v"(sK), "v"(sQ), "v"(negm))
#define AQK(C0, C1, t) do { const LAS unsigned char* kn_ = lds + ((t) & 3) * A_KS + hi * 2048 + r32 * 16; const LAS unsigned char* kr_ = lds + ((t) & 3) * A_KS + 4096 + hi * 1024 + r32 * 16; \
        const v4i_t n0a_ = *(const LAS v4i_t*)(kn_), n0b_ = *(const LAS v4i_t*)(kn_ + 1024), n1a_ = *(const LAS v4i_t*)(kn_ + 512), n1b_ = *(const LAS v4i_t*)(kn_ + 1536); \
        const bf16x8 r0_ = *(const LAS bf16x8*)(kr_), r1_ = *(const LAS bf16x8*)(kr_ + 512), r2_ = *(const LAS bf16x8*)(kr_ + 2048), r3_ = *(const LAS bf16x8*)(kr_ + 2560); \
        FP8QK(C0, n0a_, n0b_); FP8QK(C1, n1a_, n1b_); \
        C0 = __builtin_amdgcn_mfma_f32_32x32x16_bf16(r0_, qr[4], C0, 0, 0, 0); C1 = __builtin_amdgcn_mfma_f32_32x32x16_bf16(r1_, qr[4], C1, 0, 0, 0); \
        C0 = __builtin_amdgcn_mfma_f32_32x32x16_bf16(r2_, qr[5], C0, 0, 0, 0); C1 = __builtin_amdgcn_mfma_f32_32x32x16_bf16(r3_, qr[5], C1, 0, 0, 0); } while (0)
#define PK8(a, b, c, d) __builtin_amdgcn_cvt_pk_fp8_f32((c), (d), __builtin_amdgcn_cvt_pk_fp8_f32((a), (b), 0, false), true)
#define ASUMPACK(P0, P1) do { float s0_ = P0[0] + P0[1], s1_ = P1[0] + P1[1]; \
        _Pragma("unroll") for (int r = 2; r < 16; ++r) { s0_ += P0[r]; s1_ += P1[r]; } l_run += s0_ + s1_; \
        _Pragma("unroll") for (int j = 0; j < 4; ++j) { pw[j] = PK8(P0[4 * j], P0[4 * j + 1], P0[4 * j + 2], P0[4 * j + 3]); pw[4 + j] = PK8(P1[4 * j], P1[4 * j + 1], P1[4 * j + 2], P1[4 * j + 3]); } } while (0)
#define AMASK(C0, C1, t) do { const int jb_ = (t) - (NT - 4); if (jb_ >= 0) { const int d_ = qrel - (64 * jb_ + 4 * hi);     \
        _Pragma("unroll") for (int r = 0; r < 16; ++r) { const int c_ = (r & 3) + 8 * (r >> 2); if (c_ > d_) C0[r] = -INFINITY; if (c_ + 32 > d_) C1[r] = -INFINITY; } } } while (0)
#define ADECIDE(C0, C1, FIRST) do { \
        float ra_ = fmaxf(fmaxf(C0[0], C0[1]), C1[0]), rb_ = fmaxf(fmaxf(C0[2], C0[3]), C1[1]); ra_ = fmaxf(fmaxf(ra_, C1[2]), C1[3]); \
        _Pragma("unroll") for (int r = 4; r < 16; r += 4) { ra_ = fmaxf(fmaxf(ra_, C0[r]), C0[r + 1]); rb_ = fmaxf(fmaxf(rb_, C0[r + 2]), C0[r + 3]); ra_ = fmaxf(fmaxf(ra_, C1[r]), C1[r + 1]); rb_ = fmaxf(fmaxf(rb_, C1[r + 2]), C1[r + 3]); } \
        const float rm_ = swap_max(fmaxf(ra_, rb_)); resc = false; \
        if ((FIRST) || __builtin_expect(__any(rm_ > 8.0f), 0)) { const float dl_ = (FIRST) ? rm_ : fmaxf(rm_, 0.f); \
            resc_f = (FIRST) ? 1.0f : __builtin_amdgcn_exp2f(-dl_); mhat += dl_; l_run *= resc_f; resc = true; \
            _Pragma("unroll") for (int r = 0; r < 16; ++r) { C0[r] -= dl_; C1[r] -= dl_; negm[r] = -mhat; } } } while (0)
#define AEXP(C0, C1) do { _Pragma("unroll") for (int r = 0; r < 16; ++r) { C0[r] = __builtin_amdgcn_exp2f(C0[r]); C1[r] = __builtin_amdgcn_exp2f(C1[r]); } } while (0)
#define FP8PV(D0, VA, VB) asm volatile("v_mfma_scale_f32_32x32x64_f8f6f4 %0, %1, %2, %0, %3, %3 op_sel_hi:[0,0,0]" : "+v"(o[D0]) : "v"(__builtin_shufflevector(VA, VB, 0, 1, 2, 3, 4, 5, 6, 7)), "v"(pw), "v"(sK))
#define ONOP() asm volatile("s_nop 15\n\ts_nop 7" ::: "memory")
#define APV(vs) do { const LAS unsigned char* vp_ = lds + A_V0 + (vs) * A_VS; \
        const v4i_t a0_ = *(const LAS v4i_t*)(vp_ + voa), b0_ = *(const LAS v4i_t*)(vp_ + vob), a1_ = *(const LAS v4i_t*)(vp_ + 2048 + voa), b1_ = *(const LAS v4i_t*)(vp_ + 2048 + vob); \
        FP8PV(0, a0_, b0_); FP8PV(1, a1_, b1_); ONOP(); } while (0)
#define ARESC() do { if (resc) { ONOP(); _Pragma("unroll") for (int r = 0; r < 16; ++r) { o[0][r] *= resc_f; o[1][r] *= resc_f; } } } while (0)
#define SBAR() __builtin_amdgcn_sched_barrier(0)
#define PIN(x) asm volatile("" : "+v"(x))
#define ASTEP(C0, C1, P0, P1, t) do { ATOP(t); \
        v4i_t kn_[4]; bf16x8 kf_[4]; { const LAS unsigned char* kb_ = lds + ((t) & 3) * A_KS + hi * 2048 + r32 * 16; const LAS unsigned char* kr_ = lds + ((t) & 3) * A_KS + 4096 + hi * 1024 + r32 * 16; \
            kn_[0] = *(const LAS v4i_t*)(kb_); kn_[1] = *(const LAS v4i_t*)(kb_ + 1024); kn_[2] = *(const LAS v4i_t*)(kb_ + 512); kn_[3] = *(const LAS v4i_t*)(kb_ + 1536); \
            kf_[0] = *(const LAS bf16x8*)(kr_); kf_[1] = *(const LAS bf16x8*)(kr_ + 512); kf_[2] = *(const LAS bf16x8*)(kr_ + 2048); kf_[3] = *(const LAS bf16x8*)(kr_ + 2560); } \
        SBAR(); \
        ASUMPACK(P0, P1); PIN(l_run); PIN(pw); \
        SBAR(); \
        FP8QK(C0, kn_[0], kn_[1]); FP8QK(C1, kn_[2], kn_[3]); \
        C0 = __builtin_amdgcn_mfma_f32_32x32x16_bf16(kf_[0], qr[4], C0, 0, 0, 0); C1 = __builtin_amdgcn_mfma_f32_32x32x16_bf16(kf_[1], qr[4], C1, 0, 0, 0); \
        C0 = __builtin_amdgcn_mfma_f32_32x32x16_bf16(kf_[2], qr[5], C0, 0, 0, 0); C1 = __builtin_amdgcn_mfma_f32_32x32x16_bf16(kf_[3], qr[5], C1, 0, 0, 0); \
        SBAR(); \
        v4i_t va_[2], vb_[2]; { const LAS unsigned char* vp_ = lds + A_V0 + (((t) - 1) & 3) * A_VS;     \
            va_[0] = *(const LAS v4i_t*)(vp_ + voa); vb_[0] = *(const LAS v4i_t*)(vp_ + vob); va_[1] = *(const LAS v4i_t*)(vp_ + 2048 + voa); vb_[1] = *(const LAS v4i_t*)(vp_ + 2048 + vob); } \
        SBAR(); \
        AMASK(C0, C1, t); ADECIDE(C0, C1, false); \
        SBAR(); \
        FP8PV(0, va_[0], vb_[0]); \
        _Pragma("unroll") for (int r = 0; r < 16; ++r) C0[r] = __builtin_amdgcn_exp2f(C0[r]); PIN(C0); \
        SBAR(); \
        FP8PV(1, va_[1], vb_[1]); \
        _Pragma("unroll") for (int r = 0; r < 16; ++r) C1[r] = __builtin_amdgcn_exp2f(C1[r]); PIN(C1); \
        SBAR(); \
        ARESC(); } while (0)
    ATOP(0); AQK(pA0, pA1, 0); AMASK(pA0, pA1, 0); ADECIDE(pA0, pA1, true); AEXP(pA0, pA1); resc = false;
    for (int t = 1; t + 2 < NT; t += 2) { ASTEP(pB0, pB1, pA0, pA1, t); ASTEP(pA0, pA1, pB0, pB1, t + 1); }
    ASTEP(pB0, pB1, pA0, pA1, NT - 1);
    ASUMPACK(pB0, pB1); APV((NT - 1) & 3);
#undef SGB
#undef ATOP
#undef ASUMPACK
#undef AMASK
#undef ADECIDE
#undef AEXP
#undef APV
#undef FP8PV
#undef ONOP
#undef PK8
#undef ARESC
#undef ASTEP
#undef SBAR
#undef PIN
    l_run = swap_add(l_run);
    const float inv = 1.0f / l_run;
    unsigned char* op = omix + qrow * DM + h * 64 + 4 * hi;
    const float inv8 = inv * F8_SO;
#pragma unroll
    for (int d0 = 0; d0 < 2; ++d0)
#pragma unroll
        for (int a4 = 0; a4 < 4; ++a4)
            *(GAS unsigned*)(op + 32 * d0 + 8 * a4) = (unsigned)__builtin_amdgcn_cvt_pk_fp8_f32(o[d0][4 * a4 + 2] * inv8, o[d0][4 * a4 + 3] * inv8, __builtin_amdgcn_cvt_pk_fp8_f32(o[d0][4 * a4] * inv8, o[d0][4 * a4 + 1] * inv8, 0, false), true);
    asm volatile("s_waitcnt lgkmcnt(0)\n\ts_barrier" ::: "memory");
#undef ADMA
#undef AQK
#undef FP8QK
}

constexpr int R_STG = 65536, R_K = 16384, R_V = 32768, R_ST = 131072, R_STAT = 147456;
__device__ __forceinline__ void ret_unit(LAS unsigned char* lds, int b, int hh, const bf16* proj, unsigned char* omix) {
    const int tid = threadIdx.x, lane = tid & 63, r32 = lane & 31, hi = lane >> 5; const int wid = __builtin_amdgcn_readfirstlane(tid >> 6);
    const int qbk = wid & 3, dvh = wid >> 2;
    const size_t rowbase = (size_t)b * SEQ;
    const float g128 = exp2f(128.0f * ret_log2g(hh));
    for (int i = tid; i < 16384 / 16; i += NTHR) *(LAS v4u*)(lds + R_ST + i * 16) = (v4u){0u, 0u, 0u, 0u};
    f32x16 st = f32x16{};
    const bf16* qsrc = proj + (rowbase + lane) * INWP + C_RQ + hh * 64 + 8 * wid;
    const bf16* ksrc = proj + (rowbase + lane) * INWP + C_RK + hh * 64 + 8 * wid;
    const bf16* vsrc = proj + (rowbase + (lane >> 2)) * INWP + C_RV + hh * 128 + (lane & 3) * 8;
#define RDMA(n, s) do { const size_t ro_ = (size_t)(n) * 128 * INWP; LAS unsigned char* sb_ = lds + (s) * R_STG; \
        GLDS16(qsrc + ro_, sb_ + wid * 2048); GLDS16(qsrc + ro_ + 64 * INWP, sb_ + wid * 2048 + 1024); \
        GLDS16(ksrc + ro_, sb_ + R_K + wid * 2048); GLDS16(ksrc + ro_ + 64 * INWP, sb_ + R_K + wid * 2048 + 1024); \
        _Pragma("unroll") for (int pq_ = 0; pq_ < 4; ++pq_) { const int pc_ = wid + 8 * pq_, cg_ = pc_ >> 3, rg_ = pc_ & 7; \
            GLDS16(vsrc + ro_ + (size_t)(16 * rg_) * INWP + cg_ * 32, sb_ + R_V + cg_ * 8192 + rg_ * 1024); } } while (0)
    RDMA(0, 0);
    const int g1 = (lane >> 4) & 1, qq = (lane & 15) >> 2, pp = lane & 3;
    const int tr_v = (4 * hi + qq) * 64 + 32 * g1 + 8 * pp;
    const int tr_n = (8 * hi + qq) * 64 + 32 * g1 + 8 * pp;
    const int tr_k = (8 * hi + qq) * 16 + (2 * g1 + (pp >> 1)) * 2048 + (pp & 1) * 8;
    for (int n = 0; n < 32; ++n) {
        const int s = n & 1;
        WAIT_BAR0();
        if (n + 1 < 32) RDMA(n + 1, s ^ 1);
        const LAS unsigned char* sb = lds + s * R_STG;
        const size_t trow = rowbase + (size_t)n * 128 + 32 * qbk + r32;
        v2u grr[2][4];
        { const bf16* gp = proj + trow * INWP + C_RG + hh * 128 + 64 * dvh + 4 * hi;
#pragma unroll
          for (int d0 = 0; d0 < 2; ++d0)
#pragma unroll
              for (int a4 = 0; a4 < 4; ++a4) grr[d0][a4] = *(const GAS v2u*)(gp + 32 * d0 + 8 * a4); }
#define RSBAR() __builtin_amdgcn_sched_barrier(0)
        bf16x8 qf[4]; bf16x8 kfr[4][4];
#pragma unroll
        for (int k = 0; k < 4; ++k) qf[k] = *(const LAS bf16x8*)(sb + (2 * k + hi) * 2048 + (32 * qbk + r32) * 16);
#pragma unroll
        for (int jt = 0; jt < 4; ++jt)
#pragma unroll
            for (int k = 0; k < 4; ++k) kfr[jt][k] = *(const LAS bf16x8*)(sb + R_K + (2 * k + hi) * 2048 + (32 * jt + r32) * 16);
        RSBAR();
        v4u pw[4][2];
#pragma unroll
        for (int jt = 0; jt < 4; ++jt) {
            f32x16 p = __builtin_amdgcn_mfma_f32_32x32x16_bf16(kfr[jt][0], qf[0], f32x16{}, 0, 0, 0);
#pragma unroll
            for (int k = 1; k < 4; ++k) p = __builtin_amdgcn_mfma_f32_32x32x16_bf16(kfr[jt][k], qf[k], p, 0, 0, 0);
            const int dq = 32 * (qbk - jt) + r32;
#pragma unroll
            for (int r = 0; r < 16; ++r) if (crow(r, hi) > dq) p[r] = 0.f;
#pragma unroll
            for (int j = 0; j < 4; ++j) { pw[jt][0][j] = cvtpk(p[2 * j], p[2 * j + 1]); pw[jt][1][j] = cvtpk(p[8 + 2 * j], p[9 + 2 * j]); }
        }
        RSBAR();
        f32x16 o[2]; o[0] = f32x16{}; o[1] = f32x16{};
#pragma unroll
        for (int d0 = 0; d0 < 2; ++d0) {
            const LAS unsigned char* vb = sb + R_V + (2 * dvh + d0) * 8192 + tr_v; const LAS unsigned char* stb = lds + R_ST + (2 * dvh + d0) * 4096 + tr_n;
            s16x4 va[8], vc[8], sa[4], sc[4];
#pragma unroll
            for (int i = 0; i < 8; ++i) { const LAS unsigned char* vp = vb + (16 * i) * 64; va[i] = vtr(vp); vc[i] = vtr(vp + 512); }
#pragma unroll
            for (int k = 0; k < 4; ++k) { const LAS unsigned char* sp = stb + (16 * k) * 64; sa[k] = vtr(sp); sc[k] = vtr(sp + 256); }
            RSBAR();
#pragma unroll
            for (int i = 0; i < 8; ++i) o[d0] = __builtin_amdgcn_mfma_f32_32x32x16_bf16(frag2(va[i], vc[i]), __builtin_bit_cast(bf16x8, pw[i >> 1][i & 1]), o[d0], 0, 0, 0);
#pragma unroll
            for (int k = 0; k < 4; ++k) o[d0] = __builtin_amdgcn_mfma_f32_32x32x16_bf16(frag2(sa[k], sc[k]), qf[k], o[d0], 0, 0, 0);
            RSBAR();
        }
        { const LAS unsigned char* vb = sb + R_V + qbk * 8192 + tr_n; const LAS unsigned char* kb = sb + R_K + dvh * 8192 + tr_k;
          s16x4 va[8], vc[8], ka[8], kc[8];
#pragma unroll
          for (int ks = 0; ks < 8; ++ks) { const LAS unsigned char* vp = vb + (16 * ks) * 64; const LAS unsigned char* kp = kb + (16 * ks) * 16; va[ks] = vtr(vp); vc[ks] = vtr(vp + 256); ka[ks] = vtr(kp); kc[ks] = vtr(kp + 64); }
          RSBAR();
#pragma unroll
          for (int ks = 0; ks < 8; ++ks) st = __builtin_amdgcn_mfma_f32_32x32x16_bf16(frag2(va[ks], vc[ks]), frag2(ka[ks], kc[ks]), st, 0, 0, 0);
#pragma unroll
          for (int r = 0; r < 16; ++r) st[r] *= g128; }
#undef RSBAR
        LGK_BAR();
        { LAS unsigned char* sw = lds + R_ST + qbk * 4096 + (32 * dvh + r32) * 64 + 8 * hi;
#pragma unroll
          for (int a4 = 0; a4 < 4; ++a4) { v2u w; w.x = cvtpk(st[4 * a4], st[4 * a4 + 1]); w.y = cvtpk(st[4 * a4 + 2], st[4 * a4 + 3]); *(LAS v2u*)(sw + 16 * a4) = w; } }
        float s1 = 0.f, s2 = 0.f;
#pragma unroll
        for (int d0 = 0; d0 < 2; ++d0)
#pragma unroll
            for (int r = 0; r < 16; ++r) { s1 += o[d0][r]; s2 += o[d0][r] * o[d0][r]; }
        s1 = swap_add(s1); s2 = swap_add(s2);
        LAS f32x2* stat = (LAS f32x2*)(lds + R_STAT);
        if (hi == 0) stat[wid * 32 + r32] = (f32x2){s1, s2};
        LGK_BAR();
        { const f32x2 ot = stat[(wid ^ 4) * 32 + r32]; s1 += ot.x; s2 += ot.y; }
        const float mean = s1 * (1.f / 128.f), var = fmaxf(s2 * (1.f / 128.f) - mean * mean, 0.f), rstd = 1.0f / sqrtf(var + EPS);
        unsigned char* op = omix + trow * DM + 512 + hh * 128 + 64 * dvh + 4 * hi; const float rstd8 = rstd * F8_SO;
#pragma unroll
        for (int d0 = 0; d0 < 2; ++d0)
#pragma unroll
            for (int a4 = 0; a4 < 4; ++a4) { const v2u gr = grr[d0][a4];
                const float y0 = silu_f(bflo(gr.x)) * (o[d0][4 * a4] - mean) * rstd8, y1 = silu_f(bfhi(gr.x)) * (o[d0][4 * a4 + 1] - mean) * rstd8;
                const float y2 = silu_f(bflo(gr.y)) * (o[d0][4 * a4 + 2] - mean) * rstd8, y3 = silu_f(bfhi(gr.y)) * (o[d0][4 * a4 + 3] - mean) * rstd8;
                *(GAS unsigned*)(op + 32 * d0 + 8 * a4) = cvt4_fp8(y0, y1, y2, y3); }
    }
    WAIT_BAR0();
#undef RDMA
}
#undef GLDS16
}
#ifndef GEMM_ALIGN
#define GEMM_ALIGN true
#endif
#ifndef MK_ONE_LAUNCH
#define MK_ONE_LAUNCH 1
#endif
constexpr int NPHASE = 11;
__global__ void __launch_bounds__(NTHR, 2) fwd(Args args) {
    extern __shared__ __attribute__((aligned(16))) unsigned char lds_raw[];
    Frame F;
    F.lds = (LAS unsigned char*)lds_raw;
    F.MISC = (volatile LAS unsigned*)(F.lds + MISC_OFF);
    F.tid = threadIdx.x; F.lane = F.tid & 63; F.wave = __builtin_amdgcn_readfirstlane(F.tid >> 6);
    F.G = gridDim.x; F.bx = blockIdx.x;
    unsigned char* ws = args.ws;
    F.ctl = (gu32*)(ws + WS_CTL);
    for (int u = F.tid; u < (LDS_BYTES - LDSCTL_OFF) / 4; u += NTHR) ((LAS unsigned*)(F.lds + LDSCTL_OFF))[u] = 0u;
    __syncthreads();
    XcdBarrier bar; bar.bar = (unsigned*)(F.ctl + CW_BAR); bar.x = 0; bar.st = nullptr;
    const int lo = args.ph_lo, hi = args.ph_hi;
    if (hi - lo > 1) bar = xcd_barrier_post((unsigned*)(F.ctl + CW_BAR), F.MISC + 8);
#ifdef ONLY_PHASE
#define IN(k) ((k) == ONLY_PHASE && lo <= (k) && (k) < hi)
#else
#define IN(k) (lo <= (k) && (k) < hi)
#endif
#define SEAM(k) do { if (IN(k) && IN((k) + 1)) xcd_barrier(bar); } while (0)
    LAS unsigned char* ring = F.lds;

#ifndef REP_PHASE
#define REP_PHASE -1
#endif
    int rep_id = 0;
#define RUN(k, ...) do { if (IN(k)) { { __VA_ARGS__ } if (REP_PHASE == (k)) { xcd_barrier(bar); rep_id = 1; { __VA_ARGS__ } rep_id = 0; } SEAM(k); } } while (0)
    RUN(0, p0_prologue(F, args););
    RUN(1, p1_norm1(F, args););
    RUN(2,
        pg8::Gemm g{(const bf16*)(ws + WS_B), (const bf16*)(ws + WS_WIN), DM, DM}; pg8::StaticOrder S; S.init(T, INWP, F.G, F.bx);
#ifdef GEMM_STAGGER_US
        { const unsigned long long t0 = __builtin_amdgcn_s_memrealtime(); const unsigned long long dly = (unsigned long long)(((F.bx >> 3) & 3) * GEMM_STAGGER_US) * 100ull;
          while (__builtin_amdgcn_s_memrealtime() - t0 < dly) __builtin_amdgcn_s_sleep(8); }
#endif
#ifdef REP_NULL_EPI
        if (rep_id == 1) {
#if REP_NULL_EPI == 2
            pg8::EpiBf16 E0{(bf16*)(ws + WS_B), INWP}; pg8::gemm_phase<pg8::EpiBf16, pg8::StaticOrder, GEMM_ALIGN>(ring, g, S, E0);
#else
            pg8::EpiNull E0{(float*)(ws + WS_END)}; pg8::gemm_phase<pg8::EpiNull, pg8::StaticOrder, GEMM_ALIGN>(ring, g, S, E0);
#endif
        } else
#endif
        { pg8::EpiProj E{(bf16*)(ws + WS_A), (const int*)args.in[2], (float*)(ws + WS_PQ), (float*)(ws + WS_PKV)};
        pg8::gemm_phase<pg8::EpiProj, pg8::StaticOrder, GEMM_ALIGN>(ring, g, S, E); }
    );
    RUN(4,
        { pg8::Gemm g{(const bf16*)(ws + WS_A) + C_CQ, (const bf16*)(ws + WS_WUQ), INWP, 256}; pg8::StaticOrder S; S.init(T, QW, F.G, F.bx);
          pg8::EpiScaled<8, 256> E{(bf16*)(ws + WS_B), QW, (const float*)(ws + WS_PQ), nullptr};
          pg8::gemm_phase<pg8::EpiScaled<8, 256>, pg8::StaticOrder, GEMM_ALIGN>(ring, g, S, E); }
        { pg8::Gemm g{(const bf16*)(ws + WS_A) + C_CKV, (const bf16*)(ws + WS_WUKV), INWP, 128}; pg8::StaticOrder S; S.init(T, KVW, F.G, F.bx);
          pg8::EpiScaled<4, 128> E{(bf16*)(ws + WS_C), KVW, (const float*)(ws + WS_PKV), ws + WS_K8};
          pg8::gemm_phase<pg8::EpiScaled<4, 128>, pg8::StaticOrder, GEMM_ALIGN>(ring, g, S, E); }
    );
    RUN(5,
        const bf16* proj = (const bf16*)(ws + WS_A); unsigned char* omix = ws + WS_D;
#ifndef REP5_MODE
#define REP5_MODE 0
#endif
        if (!(rep_id == 1 && REP5_MODE == 2)) for (int u = F.bx; u < NB * 4; u += F.G) mix::ret_unit(ring, u >> 2, u & 3, proj, omix);
        volatile LAS int* qs = (volatile LAS int*)(F.MISC + 16);
        if (!(rep_id == 1 && REP5_MODE == 1)) {
            if (F.tid == 0) qs[0] = (int)__hip_atomic_fetch_add(F.ctl + CW_QUEUE + 64 * rep_id, 1u, RLX_AGENT);
            __syncthreads();
            int u = qs[0];
            while (u < NB * 8 * 16) {
                int nxt = 0;
#if REP_PHASE != 5
                if (F.tid == 0) nxt = (int)__hip_atomic_fetch_add(F.ctl + CW_QUEUE + 64 * rep_id, 1u, RLX_AGENT);
#endif
                const int qb = 15 - (u >> 7), bh = u & 127;
#ifdef ATTN_PROBE
                if (rep_id) mix::attn_unit<ATTN_PROBE>(ring, bh >> 3, bh & 7, qb, (const bf16*)(ws + WS_B), ws + WS_C, ws + WS_K8, proj, (const int*)args.in[2], ws + WS_END); else
#endif
                mix::attn_unit(ring, bh >> 3, bh & 7, qb, (const bf16*)(ws + WS_B), ws + WS_C, ws + WS_K8, proj, (const int*)args.in[2], omix);
#if REP_PHASE == 5
                if (F.tid == 0) nxt = (int)__hip_atomic_fetch_add(F.ctl + CW_QUEUE + 64 * rep_id, 1u, RLX_AGENT);
#endif
                if (F.tid == 0) qs[0] = nxt;
                __syncthreads();
                u = qs[0];
            }
        }
    );
#ifdef SELFCHECK
    if (IN(5)) { selfcheck_phase(F, args); xcd_barrier(bar); }
#endif
    RUN(6,
        pg8::Gemm g{(const bf16*)(ws + WS_D), (const bf16*)(ws + WS_WO), DM / 2, DM / 2, F8_E32, F8_E8}; pg8::StaticOrder S; S.init(T, DM, F.G, F.bx);
#ifdef P6_STAGGER_US
        { const unsigned long long t0 = __builtin_amdgcn_s_memrealtime(); const unsigned long long dly = (unsigned long long)(((F.bx >> 3) & 3) * P6_STAGGER_US) * 100ull;
          while (__builtin_amdgcn_s_memrealtime() - t0 < dly) __builtin_amdgcn_s_sleep(8); }
#endif
        pg8::EpiResid E{(const float*)args.in[0], (const float*)(ws + WS_MOD), (bf16*)(ws + WS_A), (float*)(ws + WS_PART)};
        pg8::gemm_phase<pg8::EpiResid, pg8::StaticOrder, GEMM_ALIGN, false, true>(ring, g, S, E);
    );
    RUN(7, p7_norm2_router(F, args, rep_id););
    if (IN(8) || IN(9) || IN(10)) {
        LAS int* pre = (LAS int*)(F.MISC + 32);
        LAS int* ppre = (LAS int*)(F.MISC + 96);
        if (F.tid < NE) pre[F.tid + 1] = ((int)__hip_atomic_load(F.ctl + CW_CNT + F.tid * CNT_STRIDE, RLX_AGENT) + 255) >> 8;
        else if (F.tid >= 64 && F.tid < 64 + NPAIR) ppre[F.tid - 64 + 1] = ((int)__hip_atomic_load(F.ctl + CW_PCNT + (F.tid - 64) * CNT_STRIDE, RLX_AGENT) + 255) >> 8;
        __syncthreads();
        if (F.tid == 0) { int s = 0; pre[0] = 0; for (int e = 1; e <= NE; ++e) { s += pre[e]; pre[e] = s; } }
        else if (F.tid == 64) { int s = 0; ppre[0] = 0; for (int q = 1; q <= NPAIR; ++q) { s += ppre[q]; ppre[q] = s; } }
        __syncthreads();
        const int* cnt = (const int*)(F.ctl + CW_CNT); const int* tok = (const int*)(ws + WS_TOK);
        RUN(8,
            pg8::Gemm g{(const bf16*)(ws + WS_B), (const bf16*)(ws + WS_W13), DM / 2, DM / 2, F8_E32, F8_E1}; pg8::MoeOrder S{F.G, F.bx, 2, pre, cnt, tok};
            pg8::EpiSwiGLU2 E{ws + WS_C, (const v4u*)(ws + WS_REC), ppre};
            pg8::gemm_phase<pg8::EpiSwiGLU2, pg8::MoeOrder, GEMM_ALIGN, true, true>(ring, g, S, E);
        );
        RUN(9,
            pg8::Gemm g{(const bf16*)(ws + WS_C), (const bf16*)(ws + WS_W2), DE, DE / 2, F8_E16, F8_E8}; pg8::PairOrder S{F.G, F.bx, ppre};
            pg8::EpiFp8 E{ws + WS_D, DM, F8_SY};
            pg8::gemm_phase<pg8::EpiFp8, pg8::PairOrder, GEMM_ALIGN, false, true>(ring, g, S, E);
        );
#ifdef SELFCHECK
        if (IN(10)) { selfcheck_moe(F, args, ppre); xcd_barrier(bar); }
#endif
        RUN(10, p10_final(F, args, ppre););
    }
#undef RUN
#undef IN
#undef SEAM
}

extern "C" void kernel_launch(void* const* d_in, const int* in_sizes, int n_in, void* d_out, int out_size, void* d_ws, size_t ws_size, hipStream_t stream) {
    static int grid = 0;
    if (grid == 0) {
        if (n_in != 21 || in_sizes[0] != T * DM || out_size != T * DM || ws_size < WS_END) { fprintf(stderr, "kernel_launch: unexpected shapes (n_in %d, in0 %d, out %d, ws %zu); nothing launched\n", n_in, n_in > 0 ? in_sizes[0] : -1, out_size, ws_size); grid = -1; return; }
        int dev = 0, cus = 0, per_cu = 0;
        if (hipGetDevice(&dev) != hipSuccess || hipDeviceGetAttribute(&cus, hipDeviceAttributeMultiprocessorCount, dev) != hipSuccess) { grid = -1; return; }
        if (hipFuncSetAttribute((const void*)fwd, hipFuncAttributeMaxDynamicSharedMemorySize, LDS_BYTES) != hipSuccess) { fprintf(stderr, "kernel_launch: hipFuncSetAttribute failed\n"); grid = -1; return; }
        if (hipOccupancyMaxActiveBlocksPerMultiprocessor(&per_cu, (const void*)fwd, NTHR, LDS_BYTES) != hipSuccess || per_cu < 1) fprintf(stderr, "kernel_launch: occupancy query reports %d\n", per_cu);
        (void)hipGetLastError();
        grid = cus;
    }
    if (grid < 0) return;
    if (hipMemsetAsync((char*)d_ws + WS_CTL, 0, CTL_ZERO_BYTES, stream) != hipSuccess) return;
    Args a{};
    for (int i = 0; i < 21; ++i) a.in[i] = d_in[i];
    a.out = (float*)d_out; a.ws = (unsigned char*)d_ws;
#if MK_ONE_LAUNCH
    a.ph_lo = 0; a.ph_hi = NPHASE;
    hipLaunchKernelGGL(fwd, dim3(grid), dim3(NTHR), LDS_BYTES, stream, a);
#else
    for (int p = 0; p < NPHASE; ++p) { a.ph_lo = p; a.ph_hi = p + 1; hipLaunchKernelGGL(fwd, dim3(grid), dim3(NTHR), LDS_BYTES, stream, a); }
#endif
}
```
